# Optimizing an MI355X kernel written in HIP

```python
import jax, jax.numpy as jnp
from jax import lax
import numpy as np

D_MODEL = 1024
BATCH = 8
SEQ = 2048
DEPTH = 1
DEC_BATCH = 128
DEC_SEQ = 1
PAST_LEN = 16384
PAGE_SIZE = 128

HGRN_HEADS = 8
HGRN_DK = 128
HGRN_F = HGRN_HEADS * HGRN_DK
HGRN_DV = D_MODEL // HGRN_HEADS
HGRN_V = HGRN_HEADS * HGRN_DV
HGRN_CHUNK = 64
LRU_WIDTH = D_MODEL
LRU_BLOCKS = 8
LRU_BW = LRU_WIDTH // LRU_BLOCKS
LRU_C = 8.0
CONV_W = 4
D_FF = 2816
EPS = 1e-6
IN_SPLITS = (HGRN_F, HGRN_F, HGRN_V, HGRN_V, LRU_WIDTH, LRU_WIDTH, D_MODEL, D_MODEL)
IN_WIDTH = HGRN_F * 2 + HGRN_V * 2 + LRU_WIDTH * 2 + D_MODEL * 2

kernel_name = "hgrn2_rglru_gated_macaron_step"


def rmsnorm(x, g):
    xf = x.astype(jnp.float32)
    y = xf * lax.rsqrt(jnp.mean(xf * xf, axis=-1, keepdims=True) + EPS)
    return (y * g.astype(jnp.float32)).astype(x.dtype)


def swiglu(x, w_gate, w_up, w_down):
    return (jax.nn.silu(x @ w_gate) * (x @ w_up)) @ w_down


def hgrn2_chunked(q, logf, k, v, s0):
    B, T, H, DK = q.shape
    DV = v.shape[-1]
    C = min(HGRN_CHUNK, T)
    pad = (-T) % C
    nc = (T + pad) // C

    def prep(a):
        a = jnp.pad(a, ((0, 0), (0, pad), (0, 0), (0, 0)))
        return a.reshape(B, nc, C, H, a.shape[-1]).transpose(1, 0, 3, 2, 4)

    qc, gc, kc, vc = prep(q), prep(logf), prep(k), prep(v)
    mask = jnp.tril(jnp.ones((C, C), dtype=bool))

    def step(S, inp):
        qi, gi, ki, vi = inp
        b = jnp.cumsum(gi, axis=2)
        bl = b[:, :, -1:, :]
        qe = qi * jnp.exp(b)
        ke = ki * jnp.exp(-b)
        inter = jnp.einsum('bhck,bhkv->bhcv', qe, S)
        A = jnp.where(mask, jnp.einsum('bhck,bhsk->bhcs', qe, ke), 0.0)
        intra = jnp.einsum('bhcs,bhsv->bhcv', A, vi)
        S_new = jnp.exp(bl[:, :, 0, :])[..., None] * S + jnp.einsum(
            'bhsk,bhsv->bhkv', ki * jnp.exp(bl - b), vi)
        return S_new, inter + intra

    s_fin, o = lax.scan(step, s0, (qc, gc, kc, vc))
    o = o.transpose(1, 0, 3, 2, 4).reshape(B, nc * C, H, DV)[:, :T]
    return o, s_fin


def causal_conv(x, buf, w, b):
    T = x.shape[1]
    xc = jnp.concatenate([buf.astype(x.dtype), x], axis=1)
    out = b
    for j in range(CONV_W):
        out = out + xc[:, j:j + T] * w[j]
    return out, xc[:, -(CONV_W - 1):]


def block_diag(x, w, b):
    B, T, D = x.shape
    xb = x.reshape(B, T, LRU_BLOCKS, LRU_BW)
    return jnp.einsum('btnc,ncd->btnd', xb, w).reshape(B, T, D) + b


def rglru(x, r, i, lam, h0):
    log_a = -LRU_C * r * jax.nn.softplus(-lam)
    a = jnp.exp(log_a)
    mult = jnp.sqrt(-jnp.expm1(2.0 * log_a))
    bterm = mult * (i * x)
    bterm = bterm.at[:, 0].add(a[:, 0] * h0)

    def combine(l, rr):
        a1, b1 = l
        a2, b2 = rr
        return a1 * a2, a2 * b1 + b2

    _, h = lax.associative_scan(combine, (a, bterm), axis=1)
    return h, h[:, -1]


def layer(x, s_hgrn, h_lru, c_conv, lb,
          n1, f1g, f1u, f1d, nmix, w_in, o_norm, conv_w, conv_b,
          w_a, b_a, w_x, b_x, lam, w_a_up, w_b_up, w_out, n3, f2g, f2u, f2d):
    f32 = jnp.float32
    B, T, _ = x.shape
    x = x + 0.5 * swiglu(rmsnorm(x, n1), f1g, f1u, f1d)
    h = rmsnorm(x, nmix)
    proj = h @ w_in
    idx = [int(v) for v in np.cumsum(IN_SPLITS)[:-1]]
    q, fpre, vin, gout, xr, yr, ga, gb = jnp.split(proj, idx, axis=-1)

    lbf = lb.astype(f32)
    f = lbf + (1.0 - lbf) * jax.nn.sigmoid(fpre.astype(f32))
    logf = jnp.log(f)
    kk = 1.0 - f
    qh = jax.nn.silu(q.astype(f32)).reshape(B, T, HGRN_HEADS, HGRN_DK)
    oA, s_new = hgrn2_chunked(qh, logf.reshape(B, T, HGRN_HEADS, HGRN_DK),
                              kk.reshape(B, T, HGRN_HEADS, HGRN_DK),
                              vin.astype(f32).reshape(B, T, HGRN_HEADS, HGRN_DV),
                              s_hgrn.astype(f32))
    oA = oA * lax.rsqrt(jnp.mean(oA * oA, axis=-1, keepdims=True) + EPS)
    oA = oA.reshape(B, T, HGRN_V) * o_norm.astype(f32) * jax.nn.silu(gout.astype(f32))
    oA = oA.astype(x.dtype)

    xc, c_new = causal_conv(xr, c_conv, conv_w, conv_b)
    r = jax.nn.sigmoid(block_diag(xc, w_a, b_a).astype(f32))
    ig = jax.nn.sigmoid(block_diag(xc, w_x, b_x).astype(f32))
    hs, h_new = rglru(xc.astype(f32), r, ig, lam.astype(f32), h_lru.astype(f32))
    oB = (hs.astype(x.dtype) * jax.nn.gelu(yr))

    m = jax.nn.sigmoid(ga) * (oA @ w_a_up) + jax.nn.sigmoid(gb) * (oB @ w_b_up)
    x = x + m @ w_out
    x = x + 0.5 * swiglu(rmsnorm(x, n3), f2g, f2u, f2d)
    return x, s_new, h_new, c_new


def setup_inputs(seed: int = 0) -> dict:
    key = jax.random.key(seed)
    ks = jax.random.split(key, 32)
    f32 = jnp.float32
    nrm = lambda k, shape, s: (jax.random.normal(k, shape, f32) * s)
    gain = lambda k, shape: 1.0 + 0.05 * jax.random.normal(k, shape, f32)
    u = jax.random.uniform(ks[20], (DEPTH, LRU_WIDTH), f32, 0.9, 0.999)
    sl = u ** (1.0 / LRU_C)
    lam = jnp.log(sl) - jnp.log1p(-sl)
    return {
        "x_prompt": nrm(ks[0], (BATCH, SEQ, D_MODEL), 1.0),
        "x_sample": nrm(ks[1], (DEC_BATCH, DEC_SEQ, D_MODEL), 1.0),
        "state_hgrn": nrm(ks[2], (DEPTH, DEC_BATCH, HGRN_HEADS, HGRN_DK, HGRN_DV), 0.5),
        "state_lru": nrm(ks[3], (DEPTH, DEC_BATCH, LRU_WIDTH), 0.5),
        "state_conv": nrm(ks[4], (DEPTH, DEC_BATCH, CONV_W - 1, LRU_WIDTH), 1.0),
        "ffn1_norm": gain(ks[5], (DEPTH, D_MODEL)),
        "ffn1_w_gate": nrm(ks[6], (DEPTH, D_MODEL, D_FF), D_MODEL ** -0.5),
        "ffn1_w_up": nrm(ks[7], (DEPTH, D_MODEL, D_FF), D_MODEL ** -0.5),
        "ffn1_w_down": nrm(ks[8], (DEPTH, D_FF, D_MODEL), D_FF ** -0.5),
        "mix_norm": gain(ks[9], (DEPTH, D_MODEL)),
        "w_in": nrm(ks[10], (DEPTH, D_MODEL, IN_WIDTH), D_MODEL ** -0.5),
        "hgrn_lower_bounds": nrm(ks[11], (DEPTH + 1, HGRN_F), 0.1),
        "hgrn_out_norm": gain(ks[12], (DEPTH, HGRN_V)),
        "conv_w": nrm(ks[13], (DEPTH, CONV_W, LRU_WIDTH), CONV_W ** -0.5),
        "conv_b": nrm(ks[14], (DEPTH, LRU_WIDTH), 0.01),
        "lru_w_a": nrm(ks[15], (DEPTH, LRU_BLOCKS, LRU_BW, LRU_BW), LRU_BW ** -0.5),
        "lru_b_a": nrm(ks[16], (DEPTH, LRU_WIDTH), 0.01),
        "lru_w_x": nrm(ks[17], (DEPTH, LRU_BLOCKS, LRU_BW, LRU_BW), LRU_BW ** -0.5),
        "lru_b_x": nrm(ks[18], (DEPTH, LRU_WIDTH), 0.01),
        "lru_lambda": lam,
        "w_a_up": nrm(ks[21], (DEPTH, HGRN_V, D_MODEL), HGRN_V ** -0.5),
        "w_b_up": nrm(ks[22], (DEPTH, LRU_WIDTH, D_MODEL), LRU_WIDTH ** -0.5),
        "w_out": nrm(ks[23], (DEPTH, D_MODEL, D_MODEL), D_MODEL ** -0.5),
        "ffn2_norm": gain(ks[24], (DEPTH, D_MODEL)),
        "ffn2_w_gate": nrm(ks[25], (DEPTH, D_MODEL, D_FF), D_MODEL ** -0.5),
        "ffn2_w_up": nrm(ks[26], (DEPTH, D_MODEL, D_FF), D_MODEL ** -0.5),
        "ffn2_w_down": nrm(ks[27], (DEPTH, D_FF, D_MODEL), D_FF ** -0.5),
        "final_norm": gain(ks[28], (D_MODEL,)),
    }


def reference(x_prompt, x_sample, state_hgrn, state_lru, state_conv,
              ffn1_norm, ffn1_w_gate, ffn1_w_up, ffn1_w_down, mix_norm, w_in,
              hgrn_lower_bounds, hgrn_out_norm, conv_w, conv_b,
              lru_w_a, lru_b_a, lru_w_x, lru_b_x, lru_lambda,
              w_a_up, w_b_up, w_out, ffn2_norm, ffn2_w_gate, ffn2_w_up, ffn2_w_down,
              final_norm):
    lb_all = jnp.cumsum(jax.nn.softmax(hgrn_lower_bounds.astype(jnp.float32), axis=0), axis=0)

    def run(x, s_in, h_in, c_in):
        s_out, h_out, c_out = [], [], []
        for l in range(DEPTH):
            x, s, h, c = layer(
                x, s_in[l], h_in[l], c_in[l], lb_all[l],
                ffn1_norm[l], ffn1_w_gate[l], ffn1_w_up[l], ffn1_w_down[l], mix_norm[l], w_in[l],
                hgrn_out_norm[l], conv_w[l], conv_b[l], lru_w_a[l], lru_b_a[l], lru_w_x[l], lru_b_x[l],
                lru_lambda[l], w_a_up[l], w_b_up[l], w_out[l],
                ffn2_norm[l], ffn2_w_gate[l], ffn2_w_up[l], ffn2_w_down[l])
            s_out.append(s)
            h_out.append(h)
            c_out.append(c)
        return rmsnorm(x, final_norm), jnp.stack(s_out), jnp.stack(h_out), jnp.stack(c_out)

    bp = x_prompt.shape[0]
    s0 = jnp.zeros((DEPTH, bp, HGRN_HEADS, HGRN_DK, HGRN_DV), jnp.float32)
    h0 = jnp.zeros((DEPTH, bp, LRU_WIDTH), jnp.float32)
    c0 = jnp.zeros((DEPTH, bp, CONV_W - 1, LRU_WIDTH), x_prompt.dtype)
    y_prompt, hgrn_p, lru_p, conv_p = run(x_prompt, s0, h0, c0)
    y_sample, hgrn_s, lru_s, conv_s = run(x_sample, state_hgrn, state_lru, state_conv)
    return (y_prompt, y_sample, hgrn_p, lru_p, conv_p, hgrn_s, lru_s, conv_s)
```

```cpp
#include <hip/hip_runtime.h>
#include <hip/hip_cooperative_groups.h>
#include <cstdio>
namespace cg = cooperative_groups;

#define LAS __attribute__((address_space(3)))
typedef unsigned short u16;
typedef short bf16x8 __attribute__((ext_vector_type(8)));
typedef float f32x4 __attribute__((ext_vector_type(4)));
typedef unsigned u32x4 __attribute__((ext_vector_type(4)));
typedef unsigned u32x2 __attribute__((ext_vector_type(2)));

constexpr int TP = 16384, TS = 128, NTOK = TP + TS, DM = 1024, DFF = 2816, SEQ = 2048;
constexpr float EPSV = 1e-6f;
constexpr int LDS_BYTES = 147456;

constexpr size_t SLOT = (size_t)TP * DM * 2;
constexpr size_t SSLOT = (size_t)256 * DM * 2;
constexpr size_t WS_WGU = 0;
constexpr size_t WS_WD = WS_WGU + (size_t)5632 * 1024 * 2;
constexpr size_t WS_WIN = WS_WD + (size_t)1024 * 2816 * 2;
constexpr size_t WS_WBD = WS_WIN + (size_t)8192 * 1024 * 2;
constexpr size_t WS_WAUP = WS_WBD + (size_t)8 * 256 * 256 * 2;
constexpr size_t WS_WBUP = WS_WAUP + (size_t)1024 * 1024 * 2;
constexpr size_t WS_WOUT = WS_WBUP + (size_t)1024 * 1024 * 2;
constexpr size_t WS_X1 = WS_WOUT + (size_t)1024 * 1024 * 2;
constexpr size_t WS_HN = WS_X1 + (size_t)16640 * DM * 4;
constexpr size_t WS_R0 = WS_HN + SLOT;
constexpr size_t WS_R1 = WS_R0 + SLOT;
constexpr size_t WS_R2 = WS_R1 + SLOT;
constexpr size_t WS_SIDE = WS_R2 + SLOT;
constexpr size_t WS_ACTS = WS_SIDE + 11 * SSLOT;
constexpr size_t WS_BL = WS_ACTS + (size_t)256 * DFF * 2;
constexpr size_t WS_AGG = WS_BL + (size_t)2048 * 128 * 4;
constexpr size_t WS_LB = WS_AGG + (size_t)256 * 1024 * 8;
constexpr size_t WS_LC = WS_LB + 4096;
constexpr size_t WS_END = WS_LC + 4096;
static_assert(WS_END <= (size_t)268435456, "workspace too large");
constexpr size_t O_YP = 0, O_YS = 16777216, O_HP = 16908288, O_LP = 17956864, O_CP = 17965056, O_HS = 17989632, O_LS = 34766848, O_CS = 34897920;

struct Params { const float* in[28]; float* out; unsigned char* ws; };
struct B16 { u16* p; u16* s; };

typedef __bf16 bf16x2_t __attribute__((ext_vector_type(2)));
typedef float f32x2_t __attribute__((ext_vector_type(2)));
__device__ __forceinline__ unsigned pk(float lo, float hi) { const f32x2_t v = {lo, hi}; const bf16x2_t b = __builtin_convertvector(v, bf16x2_t); return __builtin_bit_cast(unsigned, b); }
__device__ __forceinline__ float blo(unsigned w) { return __uint_as_float(w << 16); }
__device__ __forceinline__ float bhi(unsigned w) { return __uint_as_float(w & 0xffff0000u); }
__device__ __forceinline__ float b2f(u16 b) { return __uint_as_float(((unsigned)b) << 16); }
__device__ __forceinline__ u16 f2b(float f) { return (u16)(pk(f, 0.f) & 0xffffu); }
__device__ __forceinline__ float sigm(float x) { return 1.f / (1.f + __expf(-x)); }
__device__ __forceinline__ float silu(float x) { return x / (1.f + __expf(-x)); }
__device__ __forceinline__ float gelu_t(float x) { const float u = 0.7978845608028654f * (x + 0.044715f * x * x * x); return x / (1.f + __expf(-2.f * u)); }
__device__ __forceinline__ unsigned pkh(float lo, float hi) { const _Float16 a = (_Float16)lo, b = (_Float16)hi; return (unsigned)__builtin_bit_cast(u16, a) | ((unsigned)__builtin_bit_cast(u16, b) << 16); }
__device__ __forceinline__ float h2f(u16 h) { return (float)__builtin_bit_cast(_Float16, h); }
__device__ __forceinline__ u32x4 pack8(const float* o) { u32x4 r; r.x = pk(o[0], o[1]); r.y = pk(o[2], o[3]); r.z = pk(o[4], o[5]); r.w = pk(o[6], o[7]); return r; }
__device__ __forceinline__ void unpack8(u32x4 w, float* o) { o[0] = blo(w.x); o[1] = bhi(w.x); o[2] = blo(w.y); o[3] = bhi(w.y); o[4] = blo(w.z); o[5] = bhi(w.z); o[6] = blo(w.w); o[7] = bhi(w.w); }
__device__ __forceinline__ unsigned char* opq(unsigned char* p) { asm volatile("" : "+s"(p)); return p; }
__device__ __forceinline__ int opqv(int v) { asm volatile("" : "+v"(v)); return v; }
#define TIDX opqv((int)threadIdx.x)
struct F8 { f32x4 a, b; };
__device__ __forceinline__ F8 unpack8v(u32x4 w) { F8 r; r.a = (f32x4){blo(w.x), bhi(w.x), blo(w.y), bhi(w.y)}; r.b = (f32x4){blo(w.z), bhi(w.z), blo(w.w), bhi(w.w)}; return r; }
__device__ __forceinline__ u32x4 pack8v(f32x4 a, f32x4 b) { u32x4 r; r.x = pk(a.x, a.y); r.y = pk(a.z, a.w); r.z = pk(b.x, b.y); r.w = pk(b.z, b.w); return r; }
__device__ __forceinline__ u32x4 pack8h(f32x4 a, f32x4 b) { u32x4 r; r.x = pkh(a.x, a.y); r.y = pkh(a.z, a.w); r.z = pkh(b.x, b.y); r.w = pkh(b.z, b.w); return r; }
__device__ __forceinline__ f32x4 sig4(f32x4 v) { return (f32x4){sigm(v.x), sigm(v.y), sigm(v.z), sigm(v.w)}; }
__device__ __forceinline__ f32x4 silu4(f32x4 v) { return (f32x4){silu(v.x), silu(v.y), silu(v.z), silu(v.w)}; }
__device__ __forceinline__ f32x4 gelu4(f32x4 v) { return (f32x4){gelu_t(v.x), gelu_t(v.y), gelu_t(v.z), gelu_t(v.w)}; }
__device__ __forceinline__ f32x4 log4(f32x4 v) { return (f32x4){__logf(v.x), __logf(v.y), __logf(v.z), __logf(v.w)}; }
__device__ __forceinline__ float wave_sum(float v) {
#pragma unroll
    for (int o = 32; o >= 1; o >>= 1) v += __shfl_xor(v, o, 64);
    return v;
}

constexpr int BM = 256, BK = 64, HALF = 128, HTB = HALF * BK * 2;
__device__ __forceinline__ int lds_byte(int r, int c) { const int st = (r >> 4) * 2 + (c >> 5), rr = r & 15, cc = c & 31, ob = rr * 64 + cc * 2; return st * 1024 + (ob ^ (((ob >> 9) & 1) << 5)); }
__device__ __forceinline__ void stage_rc(int b, int& R, int& C) { const int st = b / 1024, sb = b % 1024, swz = sb ^ (((sb >> 9) & 1) << 5); R = (st >> 1) * 16 + swz / 64; C = (st & 1) * 32 + (swz % 64) / 2; }
__device__ __forceinline__ int perm32(int rho) { const int n = rho >> 4, i = rho & 15; return 8 * (i >> 2) + 4 * n + (i & 3); }

struct Unit { int pm, pn, sub; const char* a; const char* b; };

__device__ __forceinline__ bool tile_of(long L, int nM, int nN, int& pm, int& pn) {
    const int nwg = nM * nN; if (L >= nwg) return false;
    int wgid = (int)L; { const int q = nwg / 8, r = nwg % 8, xcd = wgid % 8, off = wgid / 8; wgid = (xcd < r ? xcd * (q + 1) : r * (q + 1) + (xcd - r) * q) + off; }
    const int nig = 8 * nN, gid = wgid / nig, fm = gid * 8, gsz = (nM - fm) < 8 ? (nM - fm) : 8;
    pm = fm + ((wgid % nig) % gsz); pn = (wgid % nig) / gsz; return true;
}

template <class Epi, class Sched>
__device__ __forceinline__ void gemm_phase(LAS unsigned char* lds, const int K, const int lda, const Sched& S, const Epi& E) {
    const int tid = TIDX, wid = __builtin_amdgcn_readfirstlane(tid >> 6), lane = tid & 63, wr = wid >> 2, wc = wid & 3, fr = lane & 15, fq = lane >> 4;
    const int nt = K / BK;
    unsigned voffA[2], voffB[2];
#pragma unroll
    for (int i = 0; i < 2; ++i) { int R, C; stage_rc(tid * 16 + i * 8192, R, C); const int Rb = Epi::PERM ? ((R & ~31) + perm32(R & 31)) : R;
        voffA[i] = (unsigned)(R * lda + C) * 2u; voffB[i] = (unsigned)(Rb * K + C) * 2u; }
    const size_t kstep = (size_t)(BK * 2);
    const size_t hstepA = (size_t)HALF * lda * 2, hstepB = (size_t)HALF * K * 2;
    const unsigned ldsw = (unsigned)wid * 1024u;
    const int aoff = lds_byte(wr * 64 + fr, fq * 8), boff = lds_byte(wc * 32 + fr, fq * 8);
#define G_SA(b, h) (((b) * 2 + (h)) * HTB)
#define G_SB(b, h) ((4 + (b) * 2 + (h)) * HTB)
#define G_STAGE(bufoff, gbase, voff) do { _Pragma("unroll") for (int _i = 0; _i < 2; ++_i) \
        __builtin_amdgcn_global_load_lds((const unsigned*)((const char*)(gbase) + (voff)[_i]), (LAS unsigned*)(lds + (bufoff) + ldsw + _i * 8192), 16, 0, 0); } while (0)
#define G_LDA(dst, b, h) do { _Pragma("unroll") for (int m = 0; m < 4; ++m) _Pragma("unroll") for (int k = 0; k < 2; ++k) dst[m][k] = *(const LAS bf16x8*)(lds + G_SA(b, h) + aoff + m * 2048 + k * 1024); } while (0)
#define G_LDB(dst, b, h) do { _Pragma("unroll") for (int n = 0; n < 2; ++n) _Pragma("unroll") for (int k = 0; k < 2; ++k) dst[n][k] = *(const LAS bf16x8*)(lds + G_SB(b, h) + boff + n * 2048 + k * 1024); } while (0)
#define G_MMA(ai, bj, At, Bt) do { __builtin_amdgcn_s_setprio(1); _Pragma("unroll") for (int m = 0; m < 4; ++m) _Pragma("unroll") for (int n = 0; n < 2; ++n) _Pragma("unroll") for (int k = 0; k < 2; ++k) \
        acc[ai][bj][m][n] = __builtin_amdgcn_mfma_f32_16x16x32_bf16(Bt[n][k], At[m][k], acc[ai][bj][m][n], 0, 0, 0); __builtin_amdgcn_s_setprio(0); } while (0)
#define G_WAIT_V(n) asm volatile("s_waitcnt vmcnt(" #n ")" ::: "memory")
#define G_WAIT_L(n) asm volatile("s_waitcnt lgkmcnt(" #n ")" ::: "memory")
#define G_BAR __builtin_amdgcn_s_barrier()
#define G_SCHED __builtin_amdgcn_sched_barrier(0)
    Unit cur, nxt; int ui = 0;
    if (!S.next(0, cur)) return;
    f32x4 acc[2][2][4][2];
#pragma unroll
    for (int a = 0; a < 2; ++a)
#pragma unroll
        for (int b = 0; b < 2; ++b)
#pragma unroll
            for (int m = 0; m < 4; ++m)
#pragma unroll
                for (int n = 0; n < 2; ++n) acc[a][b][m][n] = (f32x4){0.f, 0.f, 0.f, 0.f};
    bf16x8 At[4][2], B0[2][2], B1[2][2];
    const char* cA = cur.a; const char* cB = cur.b;
    G_STAGE(G_SB(0, 0), cB, voffB); G_STAGE(G_SA(0, 0), cA, voffA); G_STAGE(G_SB(0, 1), cB + hstepB, voffB); G_STAGE(G_SA(0, 1), cA + hstepA, voffA);
    if (wr == 1) G_BAR;
    G_WAIT_V(4); G_BAR;
    G_STAGE(G_SB(1, 0), cB + kstep, voffB); G_STAGE(G_SA(1, 0), cA + kstep, voffA); G_STAGE(G_SB(1, 1), cB + hstepB + kstep, voffB);
    G_WAIT_V(6); G_BAR;
    for (;;) {
        const bool has_next = S.next(ui + 1, nxt);
        const char* nA = has_next ? nxt.a : cA; const char* nB = has_next ? nxt.b : cB;
        for (int t = 0; t < nt; t += 2) {
            const bool last = (t == nt - 2);
            const char* a1 = cA + (size_t)(t + 1) * kstep;
            const char* a2 = last ? nA : cA + (size_t)(t + 2) * kstep; const char* b2 = last ? nB : cB + (size_t)(t + 2) * kstep;
            const char* a3 = a2 + kstep; const char* b3 = b2 + kstep;
            G_LDB(B0, 0, 0); G_SCHED; G_LDA(At, 0, 0); G_STAGE(G_SA(1, 1), a1 + hstepA, voffA);
            G_WAIT_L(8); G_BAR; G_WAIT_L(0); G_MMA(0, 0, At, B0); G_BAR; G_SCHED;
            G_LDB(B1, 0, 1); G_STAGE(G_SB(0, 0), b2, voffB);
            G_BAR; G_WAIT_L(0); G_MMA(0, 1, At, B1); G_BAR;
            G_LDA(At, 0, 1); G_STAGE(G_SA(0, 0), a2, voffA);
            G_BAR; G_WAIT_L(0); G_MMA(1, 0, At, B0); G_BAR; G_SCHED;
            G_STAGE(G_SB(0, 1), b2 + hstepB, voffB);
            G_WAIT_V(6); G_BAR; G_MMA(1, 1, At, B1); G_BAR;
            G_LDB(B0, 1, 0); G_SCHED; G_LDA(At, 1, 0); G_STAGE(G_SA(0, 1), a2 + hstepA, voffA);
            G_WAIT_L(8); G_BAR; G_WAIT_L(0); G_MMA(0, 0, At, B0); G_BAR; G_SCHED;
            G_LDB(B1, 1, 1); G_STAGE(G_SB(1, 0), b3, voffB);
            G_BAR; G_WAIT_L(0); G_MMA(0, 1, At, B1); G_BAR;
            G_LDA(At, 1, 1); G_STAGE(G_SA(1, 0), a3, voffA);
            G_BAR; G_WAIT_L(0); G_MMA(1, 0, At, B0); G_BAR; G_SCHED;
            G_STAGE(G_SB(1, 1), b3 + hstepB, voffB);
            G_WAIT_V(6); G_BAR; G_MMA(1, 1, At, B1); G_BAR;
        }
        E(acc, cur, wr, wc, fr, fq);
        if (!has_next) break;
#pragma unroll
        for (int a = 0; a < 2; ++a)
#pragma unroll
            for (int b = 0; b < 2; ++b)
#pragma unroll
                for (int m = 0; m < 4; ++m)
#pragma unroll
                    for (int n = 0; n < 2; ++n) acc[a][b][m][n] = (f32x4){0.f, 0.f, 0.f, 0.f};
        cur = nxt; cA = nA; cB = nB; ++ui;
    }
    G_WAIT_V(0);
    if (wr == 0) G_BAR;
    G_BAR;
#undef G_SA
#undef G_SB
#undef G_STAGE
#undef G_LDA
#undef G_LDB
#undef G_MMA
#undef G_WAIT_V
#undef G_WAIT_L
#undef G_BAR
#undef G_SCHED
}

struct SchedSimple {
    const u16* Ap; const u16* As; const u16* Bt; int lda, K, nN, G, c; int acol_per_pn;
    __device__ __forceinline__ bool next(int i, Unit& u) const {
        int pm, pn; if (!tile_of((long)i * G + c, 65, nN, pm, pn)) return false;
        u.pm = pm; u.pn = pn; u.sub = 0;
        u.a = (const char*)((pm < 64 ? Ap + (size_t)pm * 256 * lda : As) + (size_t)(pn >> 1) * acol_per_pn);
        u.b = (const char*)(Bt + (size_t)pn * 256 * K); return true;
    }
};
struct SchedMerge {
    B16 hn, oa, ob; const u16* Win; const u16* Waup; const u16* Wbup; int G, c;
    __device__ __forceinline__ bool next(int i, Unit& u) const {
        int pm, pn; if (!tile_of((long)(i >> 2) * G + c, 65, 4, pm, pn)) return false;
        const int sub = i & 3; u.pm = pm; u.pn = pn; u.sub = sub;
        const unsigned long long m1 = (sub == 1) ? ~0ull : 0ull, m3 = (sub == 3) ? ~0ull : 0ull, m0 = ~(m1 | m3);
        const u16* abp = (const u16*)(((unsigned long long)oa.p & m1) | ((unsigned long long)ob.p & m3) | ((unsigned long long)hn.p & m0));
        const u16* abs_ = (const u16*)(((unsigned long long)oa.s & m1) | ((unsigned long long)ob.s & m3) | ((unsigned long long)hn.s & m0));
        const u16* bb = (const u16*)(((unsigned long long)Waup & m1) | ((unsigned long long)Wbup & m3) | ((unsigned long long)(Win + (size_t)(sub == 0 ? 6144 : 7168) * DM) & m0));
        u.a = (const char*)(pm < 64 ? abp + (size_t)pm * 256 * DM : abs_);
        u.b = (const char*)(bb + (size_t)pn * 256 * DM); return true;
    }
};

struct EpiGU {
    static constexpr bool PERM = true; B16 act;
    __device__ __forceinline__ void operator()(const f32x4 (&acc)[2][2][4][2], const Unit& u, int wr, int wc, int fr, int fq) const {
        u16* base = (u.pm < 64 ? act.p + (size_t)u.pm * 256 * DFF : act.s) + u.pn * 128 + wc * 32 + 8 * fq;
#pragma unroll
        for (int ai = 0; ai < 2; ++ai)
#pragma unroll
            for (int m = 0; m < 4; ++m) {
                const int rt = ai * 128 + wr * 64 + m * 16 + fr; float o[8];
#pragma unroll
                for (int n = 0; n < 2; ++n)
#pragma unroll
                    for (int j = 0; j < 4; ++j) o[n * 4 + j] = silu(acc[ai][0][m][n][j]) * acc[ai][1][m][n][j];
                *(u32x4*)(base + (size_t)rt * DFF) = pack8(o);
            }
    }
};
struct EpiRes {
    static constexpr bool PERM = false; const float* rp; const float* rs; int ns; float* out; float scale;
    __device__ __forceinline__ void operator()(const f32x4 (&acc)[2][2][4][2], const Unit& u, int wr, int wc, int fr, int fq) const {
        const int col0 = u.pn * 256 + wc * 32 + 4 * fq;
#pragma unroll
        for (int ai = 0; ai < 2; ++ai)
#pragma unroll
            for (int m = 0; m < 4; ++m) {
                const int rt = ai * 128 + wr * 64 + m * 16 + fr; const int row = u.pm * 256 + rt;
                const float* r = (u.pm < 64) ? rp + (size_t)row * DM : rs + (size_t)rt * DM; const bool valid = (u.pm < 64) || (rt < ns);
                float* o = out + (size_t)row * DM;
#pragma unroll
                for (int bj = 0; bj < 2; ++bj)
#pragma unroll
                    for (int n = 0; n < 2; ++n) { const int c = col0 + bj * 128 + n * 16; f32x4 rv = (f32x4){0.f, 0.f, 0.f, 0.f}; if (valid) rv = *(const f32x4*)(r + c);
                        *(f32x4*)(o + c) = rv + scale * acc[ai][bj][m][n]; }
                asm volatile("" ::: "memory");
            }
    }
};
template <int MODE> __device__ __forceinline__ void ina_store(u16* base, const f32x4 (&acc)[2][2][4][2], const float* lbp) {
#pragma unroll
    for (int bj = 0; bj < 2; ++bj) {
        f32x4 l0 = (f32x4){0.f, 0.f, 0.f, 0.f}, l1 = l0;
        if (MODE == 1) { l0 = *(const f32x4*)(lbp + bj * 128); l1 = *(const f32x4*)(lbp + bj * 128 + 4); }
#pragma unroll
        for (int ai = 0; ai < 2; ++ai)
#pragma unroll
            for (int m = 0; m < 4; ++m) {
                u16* d = base + (size_t)(ai * 128 + m * 16) * DM + bj * 128;
                if (MODE == 1) { const f32x4 f0 = l0 + (1.f - l0) * sig4(acc[ai][bj][m][0]), f1 = l1 + (1.f - l1) * sig4(acc[ai][bj][m][1]); *(u32x4*)d = pack8h(log4(f0), log4(f1)); }
                else if (MODE == 2) *(u32x4*)d = pack8v(acc[ai][bj][m][0], acc[ai][bj][m][1]);
                else *(u32x4*)d = pack8v(silu4(acc[ai][bj][m][0]), silu4(acc[ai][bj][m][1]));
            }
    }
}
struct EpiInA {
    static constexpr bool PERM = true; B16 qs, lf, v, gs; const float* lbv;
    __device__ __forceinline__ void operator()(const f32x4 (&acc)[2][2][4][2], const Unit& u, int wr, int wc, int fr, int fq) const {
        const int seg = u.pn >> 2, cs = (u.pn & 3) * 256 + wc * 32 + 8 * fq;
        const size_t ro = cs + (size_t)(wr * 64 + fr) * DM; const size_t po = (size_t)u.pm * 256 * DM; const bool pr = u.pm < 64;
        if (seg == 0) { u16* qp = qs.p; u16* qsm = qs.s; ina_store<0>((pr ? qp + po : qsm) + ro, acc, lbv); }
        else if (seg == 1) { u16* qp = lf.p; u16* qsm = lf.s; ina_store<1>((pr ? qp + po : qsm) + ro, acc, lbv + cs); }
        else if (seg == 2) { u16* qp = v.p; u16* qsm = v.s; ina_store<2>((pr ? qp + po : qsm) + ro, acc, lbv); }
        else { u16* qp = gs.p; u16* qsm = gs.s; ina_store<0>((pr ? qp + po : qsm) + ro, acc, lbv); }
    }
};
struct EpiInB {
    static constexpr bool PERM = true; B16 xr, yg;
    __device__ __forceinline__ void operator()(const f32x4 (&acc)[2][2][4][2], const Unit& u, int wr, int wc, int fr, int fq) const {
        const int seg = u.pn >> 2, cs = (u.pn & 3) * 256 + wc * 32 + 8 * fq;
        u16* base = (u.pm < 64 ? (seg == 0 ? +xr.p : +yg.p) + (size_t)u.pm * 256 * DM : (seg == 0 ? +xr.s : +yg.s)) + cs + (size_t)(wr * 64 + fr) * DM;
        if (seg == 0) {
#pragma unroll
            for (int ai = 0; ai < 2; ++ai)
#pragma unroll
                for (int m = 0; m < 4; ++m)
#pragma unroll
                    for (int bj = 0; bj < 2; ++bj) *(u32x4*)(base + (size_t)(ai * 128 + m * 16) * DM + bj * 128) = pack8v(acc[ai][bj][m][0], acc[ai][bj][m][1]);
        } else {
#pragma unroll
            for (int ai = 0; ai < 2; ++ai)
#pragma unroll
                for (int m = 0; m < 4; ++m)
#pragma unroll
                    for (int bj = 0; bj < 2; ++bj) *(u32x4*)(base + (size_t)(ai * 128 + m * 16) * DM + bj * 128) = pack8v(gelu4(acc[ai][bj][m][0]), gelu4(acc[ai][bj][m][1]));
        }
    }
};
__device__ __forceinline__ f32x4 nexpm1_4(f32x4 x) { const f32x4 p = 1.f + x * (0.5f + x * (0.16666667f + x * (0.041666668f + x * (0.008333334f + x * 0.0013888889f)))); return -x * p; }
__device__ __forceinline__ f32x4 sqrt4(f32x4 v) { return (f32x4){sqrtf(fmaxf(v.x, 0.f)), sqrtf(fmaxf(v.y, 0.f)), sqrtf(fmaxf(v.z, 0.f)), sqrtf(fmaxf(v.w, 0.f))}; }
struct EpiBD {
    static constexpr bool PERM = true; B16 xc, bt; const float* ba; const float* bx; const float* lc;
    __device__ __forceinline__ void operator()(const f32x4 (&acc)[2][2][4][2], const Unit& u, int wr, int wc, int fr, int fq) const {
        const int ch = u.pn * 128 + wc * 32 + 8 * fq;
        u16* xb = (u.pm < 64 ? xc.p + (size_t)u.pm * 256 * DM : xc.s) + ch + (size_t)(wr * 64 + fr) * DM; u16* bb = (u.pm < 64 ? bt.p + (size_t)u.pm * 256 * DM : bt.s) + ch + (size_t)(wr * 64 + fr) * DM;
#pragma unroll
        for (int n = 0; n < 2; ++n) {
            const f32x4 cba = *(const f32x4*)(ba + ch + 4 * n), cbx = *(const f32x4*)(bx + ch + 4 * n), cl = *(const f32x4*)(lc + ch + 4 * n);
#pragma unroll
            for (int ai = 0; ai < 2; ++ai)
#pragma unroll
                for (int m = 0; m < 4; ++m) {
                    const size_t off = (size_t)(ai * 128 + m * 16) * DM + 4 * n;
                    const u32x2 xw = *(const u32x2*)(xb + off); const f32x4 xv = (f32x4){blo(xw.x), bhi(xw.x), blo(xw.y), bhi(xw.y)};
                    const f32x4 r = sig4(acc[ai][0][m][n] + cba), ig = sig4(acc[ai][1][m][n] + cbx);
                    const f32x4 la = r * cl; const f32x4 bo = sqrt4(nexpm1_4(2.f * la)) * ig * xv;
                    u32x2 o1, o2; o1.x = pk(la.x, la.y); o1.y = pk(la.z, la.w); o2.x = pk(bo.x, bo.y); o2.y = pk(bo.z, bo.w);
                    *(u32x2*)(xb + off) = o1; *(u32x2*)(bb + off) = o2;
                    if (m & 1) asm volatile("" ::: "memory");
                }
        }
    }
};
struct EpiMerge {
    static constexpr bool PERM = true; B16 gt, ta, mb;
    __device__ __forceinline__ void operator()(const f32x4 (&acc)[2][2][4][2], const Unit& u, int wr, int wc, int fr, int fq) const {
        const size_t ro = ((u.pm < 64) ? (size_t)u.pm * 256 * DM : 0) + u.pn * 256 + wc * 32 + 8 * fq + (size_t)(wr * 64 + fr) * DM;
        u16* g = (u.pm < 64 ? +gt.p : +gt.s) + ro; u16* t = (u.pm < 64 ? +ta.p : +ta.s) + ro; u16* mo = (u.pm < 64 ? +mb.p : +mb.s) + ro;
        const int sub = u.sub;
        if (sub == 0 || sub == 2) {
#pragma unroll
            for (int ai = 0; ai < 2; ++ai)
#pragma unroll
                for (int m = 0; m < 4; ++m)
#pragma unroll
                    for (int bj = 0; bj < 2; ++bj) *(u32x4*)(g + (size_t)(ai * 128 + m * 16) * DM + bj * 128) = pack8v(sig4(acc[ai][bj][m][0]), sig4(acc[ai][bj][m][1]));
        } else if (sub == 1) {
#pragma unroll
            for (int ai = 0; ai < 2; ++ai)
#pragma unroll
                for (int m = 0; m < 4; ++m)
#pragma unroll
                    for (int bj = 0; bj < 2; ++bj) { const size_t off = (size_t)(ai * 128 + m * 16) * DM + bj * 128; const F8 gv = unpack8v(*(const u32x4*)(g + off));
                        *(u32x4*)(t + off) = pack8v(gv.a * acc[ai][bj][m][0], gv.b * acc[ai][bj][m][1]); if (bj) asm volatile("" ::: "memory"); }
        } else {
#pragma unroll
            for (int ai = 0; ai < 2; ++ai)
#pragma unroll
                for (int m = 0; m < 4; ++m)
#pragma unroll
                    for (int bj = 0; bj < 2; ++bj) { const size_t off = (size_t)(ai * 128 + m * 16) * DM + bj * 128; const F8 gv = unpack8v(*(const u32x4*)(g + off)), tv = unpack8v(*(const u32x4*)(t + off));
                        *(u32x4*)(mo + off) = pack8v(tv.a + gv.a * acc[ai][bj][m][0], tv.b + gv.b * acc[ai][bj][m][1]); if (bj) asm volatile("" ::: "memory"); }
        }
    }
};

__device__ __forceinline__ void tconv_tile(const float* src, int N, int K, int kt, int nt, u16* dst, int mode, float* tile) {
    const int tid = TIDX;
    const int c4 = (tid & 15) * 4;
#pragma unroll
    for (int p = 0; p < 2; ++p) { const int r = (tid >> 4) + 32 * p; const f32x4 v = *(const f32x4*)(src + (size_t)(kt * 64 + r) * N + nt * 64 + c4);
        tile[r * 65 + c4] = v.x; tile[r * 65 + c4 + 1] = v.y; tile[r * 65 + c4 + 2] = v.z; tile[r * 65 + c4 + 3] = v.w; }
    __syncthreads();
    const int n = tid >> 3, k8 = (tid & 7) * 8; float f[8];
#pragma unroll
    for (int j = 0; j < 8; ++j) f[j] = tile[(k8 + j) * 65 + n];
    const int ng = nt * 64 + n; const int drow = mode == 0 ? ng : ((ng >> 7) * 256 + (mode == 2 ? 128 : 0) + (ng & 127));
    *(u32x4*)(dst + (size_t)drow * K + kt * 64 + k8) = pack8(f);
    __syncthreads();
}
__device__ __forceinline__ void conv_matrix(const float* src, int K, int N, u16* dst, int mode, int t, float* tile) {
    const int ntn = N / 64; tconv_tile(src, N, K, t / ntn, t % ntn, dst, mode, tile);
}
__device__ __forceinline__ void norm_rows(const float* sp, const float* ss, const float* gain, B16 dst) {
    const int lane = TIDX & 63, gw = blockIdx.x * 8 + (TIDX >> 6), nw = gridDim.x * 8;
    f32x4 g[4];
#pragma unroll
    for (int i = 0; i < 4; ++i) g[i] = *(const f32x4*)(gain + i * 256 + lane * 4);
    for (int row = gw; row < NTOK; row += nw) {
        const float* src = row < TP ? sp + (size_t)row * DM : ss + (size_t)(row - TP) * DM;
        f32x4 v[4]; float s = 0.f;
#pragma unroll
        for (int i = 0; i < 4; ++i) { v[i] = *(const f32x4*)(src + i * 256 + lane * 4); s += v[i].x * v[i].x + v[i].y * v[i].y + v[i].z * v[i].z + v[i].w * v[i].w; }
        s = wave_sum(s); const float rs = rsqrtf(s * (1.f / DM) + EPSV);
        u16* d = (row < TP ? dst.p + (size_t)row * DM : dst.s + (size_t)(row - TP) * DM);
#pragma unroll
        for (int i = 0; i < 4; ++i) { u32x2 w; w.x = pk(v[i].x * rs * g[i].x, v[i].y * rs * g[i].y); w.y = pk(v[i].z * rs * g[i].z, v[i].w * rs * g[i].w); *(u32x2*)(d + i * 256 + lane * 4) = w; }
    }
}
__device__ __forceinline__ void final_norm(const float* x, const float* gain, float* yp, float* ys) {
    const int lane = TIDX & 63, gw = blockIdx.x * 8 + (TIDX >> 6), nw = gridDim.x * 8;
    f32x4 g[4];
#pragma unroll
    for (int i = 0; i < 4; ++i) g[i] = *(const f32x4*)(gain + i * 256 + lane * 4);
    for (int row = gw; row < NTOK; row += nw) {
        const float* src = x + (size_t)row * DM;
        f32x4 v[4]; float s = 0.f;
#pragma unroll
        for (int i = 0; i < 4; ++i) { v[i] = *(const f32x4*)(src + i * 256 + lane * 4); s += v[i].x * v[i].x + v[i].y * v[i].y + v[i].z * v[i].z + v[i].w * v[i].w; }
        s = wave_sum(s); const float rs = rsqrtf(s * (1.f / DM) + EPSV);
        float* d = row < TP ? yp + (size_t)row * DM : ys + (size_t)(row - TP) * DM;
#pragma unroll
        for (int i = 0; i < 4; ++i) *(f32x4*)(d + i * 256 + lane * 4) = v[i] * rs * g[i];
    }
}

constexpr int L_BL = 0, L_TOT = 32768, L_RED = 34816, L_QE = 35328, L_KE = 52736, L_VT = 70144, L_AM = 88576, L_ST = 97792;
constexpr int QS_ = 136, VS_ = 72;

__device__ __forceinline__ void load_lf_chunk(const u16* lfp, int row0, int h, float* bL) {
    const int tid = TIDX, r = tid >> 3, seg = tid & 7;
    const u16* p = lfp + (size_t)(row0 + r) * DM + h * 128 + seg * 16;
    const u32x4 w0 = *(const u32x4*)p, w1 = *(const u32x4*)(p + 8);
    float* d = bL + r * 128 + seg * 16;
    const unsigned ws[8] = {w0.x, w0.y, w0.z, w0.w, w1.x, w1.y, w1.z, w1.w};
#pragma unroll
    for (int i = 0; i < 8; ++i) { d[2 * i] = h2f((u16)(ws[i] & 0xffffu)); d[2 * i + 1] = h2f((u16)(ws[i] >> 16)); }
}
__device__ __forceinline__ void load_vT(const u16* vp, int row0, int h, u16* vT) {
    const int tid = TIDX, s = tid >> 3, seg = tid & 7;
    const u16* p = vp + (size_t)(row0 + s) * DM + h * 128 + seg * 16;
    const u32x4 w0 = *(const u32x4*)p, w1 = *(const u32x4*)(p + 8);
    const unsigned ws[8] = {w0.x, w0.y, w0.z, w0.w, w1.x, w1.y, w1.z, w1.w};
#pragma unroll
    for (int i = 0; i < 8; ++i) { vT[(seg * 16 + 2 * i) * VS_ + s] = (u16)(ws[i] & 0xffffu); vT[(seg * 16 + 2 * i + 1) * VS_ + s] = (u16)(ws[i] >> 16); }
}

__device__ __forceinline__ void hgrn_h1(const Params& P, unsigned char* sm) {
    float* bL = (float*)(sm + L_BL); float* tot = (float*)(sm + L_TOT); u16* kdT = (u16*)(sm + L_QE); u16* vT = (u16*)(sm + L_VT);
    const u16* lfp = (const u16*)(P.ws + WS_R1); const u16* vp = (const u16*)(P.ws + WS_R2);
    u16* Sb = (u16*)(P.out + O_HS); float* BLg = (float*)(P.ws + WS_BL);
    const int tid = TIDX, lane = tid & 63, w = tid >> 6, fr = lane & 15, fq = lane >> 4;
    for (int item = blockIdx.x; item < 2048; item += gridDim.x) {
        const int h = item & 7, c = (item >> 3) & 31, b = item >> 8; const int row0 = b * SEQ + c * 64;
        const int sidx = (b * 8 + h) * 32 + c;
        load_lf_chunk(lfp, row0, h, bL); load_vT(vp, row0, h, vT);
        __syncthreads();
        const int col = tid & 127, part = tid >> 7; float lf[16]; float run = 0.f;
#pragma unroll
        for (int i = 0; i < 16; ++i) { lf[i] = bL[(part * 16 + i) * 128 + col]; run += lf[i]; }
        tot[part * 128 + col] = run;
        __syncthreads();
        float off = 0.f, bl = 0.f;
#pragma unroll
        for (int p = 0; p < 4; ++p) { const float t = tot[p * 128 + col]; bl += t; if (p < part) off += t; }
        if (part == 0) BLg[(size_t)sidx * 128 + col] = bl;
        float bc = off;
#pragma unroll
        for (int i = 0; i < 16; ++i) { bc += lf[i]; const float kd = (1.f - __expf(lf[i])) * __expf(bl - bc); kdT[col * VS_ + part * 16 + i] = f2b(kd); }
        __syncthreads();
        bf16x8 av[2];
#pragma unroll
        for (int ks = 0; ks < 2; ++ks) av[ks] = *(const bf16x8*)(vT + (16 * w + fr) * VS_ + ks * 32 + 8 * fq);
        u16* so = Sb + (size_t)sidx * 16384 + (16 * w + fr) * 128 + 4 * fq;
#pragma unroll
        for (int nt = 0; nt < 8; ++nt) {
            f32x4 acc = (f32x4){0.f, 0.f, 0.f, 0.f};
#pragma unroll
            for (int ks = 0; ks < 2; ++ks) { const bf16x8 bk = *(const bf16x8*)(kdT + (16 * nt + fr) * VS_ + ks * 32 + 8 * fq); acc = __builtin_amdgcn_mfma_f32_16x16x32_bf16(bk, av[ks], acc, 0, 0, 0); }
            u32x2 o; o.x = pk(acc.x, acc.y); o.y = pk(acc.z, acc.w); *(u32x2*)(so + 16 * nt) = o;
        }
        __syncthreads();
    }
}
__device__ __forceinline__ void hgrn_h2(const Params& P) {
    u16* Sb = (u16*)(P.out + O_HS); const float* BLg = (const float*)(P.ws + WS_BL); float* hp = P.out + O_HP;
    for (int g = blockIdx.x * 512 + TIDX; g < 64 * 2048; g += gridDim.x * 512) {
        const int bh = g >> 11, e = (g & 2047) * 8, dv = e >> 7, dk = e & 127;
        float S[8];
#pragma unroll
        for (int j = 0; j < 8; ++j) S[j] = 0.f;
        u16* sp = Sb + (size_t)bh * 32 * 16384 + e; const float* blp = BLg + (size_t)bh * 32 * 128 + dk;
#pragma unroll 4
        for (int c = 0; c < 32; ++c) {
            const u32x4 lw = *(const u32x4*)(sp + (size_t)c * 16384); const f32x4 d0 = *(const f32x4*)(blp + c * 128), d1 = *(const f32x4*)(blp + c * 128 + 4);
            float sl[8]; unpack8(lw, sl);
            *(u32x4*)(sp + (size_t)c * 16384) = pack8(S);
            const float dd[8] = {d0.x, d0.y, d0.z, d0.w, d1.x, d1.y, d1.z, d1.w};
#pragma unroll
            for (int j = 0; j < 8; ++j) S[j] = __expf(dd[j]) * S[j] + sl[j];
        }
        float* o = hp + (size_t)bh * 16384 + dv;
#pragma unroll
        for (int j = 0; j < 8; ++j) o[(size_t)(dk + j) * 128] = S[j];
    }
}
__device__ __forceinline__ void hgrn_h3(const Params& P, unsigned char* sm) {
    float* bL = (float*)(sm + L_BL); float* tot = (float*)(sm + L_TOT); float* red = (float*)(sm + L_RED);
    u16* qe = (u16*)(sm + L_QE); u16* ke = (u16*)(sm + L_KE); u16* vT = (u16*)(sm + L_VT); u16* Am = (u16*)(sm + L_AM); u16* ST = (u16*)(sm + L_ST);
    const u16* qsp = (const u16*)(P.ws + WS_R0); const u16* lfp = (const u16*)(P.ws + WS_R1); const u16* vp = (const u16*)(P.ws + WS_R2);
    u16* gsp = (u16*)(P.out + O_YP);
    const u16* Sb = (const u16*)(P.out + O_HS); const float* onorm = P.in[12];
    const int tid = TIDX, lane = tid & 63, w = tid >> 6, fr = lane & 15, fq = lane >> 4;
    for (int item = blockIdx.x; item < 2048; item += gridDim.x) {
        const int h = item & 7, c = (item >> 3) & 31, b = item >> 8; const int row0 = b * SEQ + c * 64;
        const int sidx = (b * 8 + h) * 32 + c;
        load_lf_chunk(lfp, row0, h, bL); load_vT(vp, row0, h, vT);
        { const u16* sp = Sb + (size_t)sidx * 16384;
#pragma unroll
          for (int p = 0; p < 4; ++p) { const int idx = tid + 512 * p, dv = idx >> 4, k8 = (idx & 15) * 8; *(u32x4*)(ST + dv * QS_ + k8) = *(const u32x4*)(sp + dv * 128 + k8); } }
        __syncthreads();
        const int col = tid & 127, part = tid >> 7; float lf[16]; float run = 0.f;
#pragma unroll
        for (int i = 0; i < 16; ++i) { lf[i] = bL[(part * 16 + i) * 128 + col]; run += lf[i]; }
        tot[part * 128 + col] = run;
        __syncthreads();
        float off = 0.f;
#pragma unroll
        for (int p = 0; p < 4; ++p) { const float t = tot[p * 128 + col]; if (p < part) off += t; }
        float bc = off; const u16* qp = qsp + (size_t)(row0 + part * 16) * DM + h * 128 + col;
#pragma unroll
        for (int i = 0; i < 16; ++i) { bc += lf[i]; const float q = b2f(qp[(size_t)i * DM]);
            qe[(part * 16 + i) * QS_ + col] = f2b(q * __expf(bc)); ke[(part * 16 + i) * QS_ + col] = f2b((1.f - __expf(lf[i])) * __expf(-bc)); }
        __syncthreads();
        {
            const int mt = w & 3;
            bf16x8 aq[4];
#pragma unroll
            for (int ks = 0; ks < 4; ++ks) aq[ks] = *(const bf16x8*)(qe + (16 * mt + fr) * QS_ + ks * 32 + 8 * fq);
#pragma unroll
            for (int t = 0; t < 2; ++t) { const int nt = (w >> 2) * 2 + t; f32x4 acc = (f32x4){0.f, 0.f, 0.f, 0.f};
#pragma unroll
                for (int ks = 0; ks < 4; ++ks) { const bf16x8 bk = *(const bf16x8*)(ke + (16 * nt + fr) * QS_ + ks * 32 + 8 * fq); acc = __builtin_amdgcn_mfma_f32_16x16x32_bf16(bk, aq[ks], acc, 0, 0, 0); }
                const int cr = 16 * mt + fr, s0 = 16 * nt + 4 * fq;
                u32x2 o; o.x = pk(cr >= s0 ? acc.x : 0.f, cr >= s0 + 1 ? acc.y : 0.f); o.y = pk(cr >= s0 + 2 ? acc.z : 0.f, cr >= s0 + 3 ? acc.w : 0.f);
                *(u32x2*)(Am + cr * VS_ + s0) = o; }
        }
        __syncthreads();
        {
            const int mt = w & 3, nh = w >> 2;
            bf16x8 aq[4], aa[2];
#pragma unroll
            for (int ks = 0; ks < 4; ++ks) aq[ks] = *(const bf16x8*)(qe + (16 * mt + fr) * QS_ + ks * 32 + 8 * fq);
#pragma unroll
            for (int ks = 0; ks < 2; ++ks) aa[ks] = *(const bf16x8*)(Am + (16 * mt + fr) * VS_ + ks * 32 + 8 * fq);
            f32x4 acc[4]; float ssq = 0.f;
#pragma unroll
            for (int t = 0; t < 4; ++t) { const int dt = nh * 4 + t; acc[t] = (f32x4){0.f, 0.f, 0.f, 0.f};
#pragma unroll
                for (int ks = 0; ks < 4; ++ks) { const bf16x8 bk = *(const bf16x8*)(ST + (16 * dt + fr) * QS_ + ks * 32 + 8 * fq); acc[t] = __builtin_amdgcn_mfma_f32_16x16x32_bf16(bk, aq[ks], acc[t], 0, 0, 0); }
#pragma unroll
                for (int ks = 0; ks < 2; ++ks) { const bf16x8 bk = *(const bf16x8*)(vT + (16 * dt + fr) * VS_ + ks * 32 + 8 * fq); acc[t] = __builtin_amdgcn_mfma_f32_16x16x32_bf16(bk, aa[ks], acc[t], 0, 0, 0); }
                ssq += acc[t].x * acc[t].x + acc[t].y * acc[t].y + acc[t].z * acc[t].z + acc[t].w * acc[t].w; }
            ssq += __shfl_xor(ssq, 16, 64); ssq += __shfl_xor(ssq, 32, 64);
            if (fq == 0) red[(16 * mt + fr) * 2 + nh] = ssq;
            __syncthreads();
            const int cr = 16 * mt + fr; const float rinv = rsqrtf((red[cr * 2] + red[cr * 2 + 1]) * (1.f / 128.f) + EPSV);
            u16* gp = gsp + (size_t)(row0 + cr) * DM + h * 128;
#pragma unroll
            for (int t = 0; t < 4; ++t) { const int dv = 16 * (nh * 4 + t) + 4 * fq; const u32x2 gw = *(const u32x2*)(gp + dv); const f32x4 on = *(const f32x4*)(onorm + h * 128 + dv);
                u32x2 o; o.x = pk(acc[t].x * rinv * on.x * blo(gw.x), acc[t].y * rinv * on.y * bhi(gw.x)); o.y = pk(acc[t].z * rinv * on.z * blo(gw.y), acc[t].w * rinv * on.w * bhi(gw.y));
                *(u32x2*)(gp + dv) = o; }
        }
        __syncthreads();
    }
}
__device__ __forceinline__ void hgrn_sample(const Params& P, unsigned char* sm) {
    float* red = (float*)sm;
    float* sq = red + 16 * 128;
    float* sf = sq + 128; float* sk = sf + 128; float* sv = sk + 128; float* so = sv + 128; float* sr = so + 128;
    const u16* qss = (const u16*)(P.ws + WS_SIDE + 1 * SSLOT); const u16* lfs = (const u16*)(P.ws + WS_SIDE + 2 * SSLOT); const u16* vs = (const u16*)(P.ws + WS_SIDE + 3 * SSLOT);
    u16* gss = (u16*)(P.ws + WS_SIDE + 4 * SSLOT);
    const float* S0 = P.in[2]; float* Sn = P.out + O_HS; const float* onorm = P.in[12];
    const int tid = TIDX;
    for (int item = blockIdx.x; item < 1024; item += gridDim.x) {
        const int b = item >> 3, h = item & 7;
        if (tid < 128) { const int c = h * 128 + tid; const float lfv = h2f(lfs[(size_t)b * DM + c]); const float f = __expf(lfv);
            sq[tid] = b2f(qss[(size_t)b * DM + c]); sf[tid] = f; sk[tid] = 1.f - f; sv[tid] = b2f(vs[(size_t)b * DM + c]); }
        __syncthreads();
        const int dv4 = (tid & 31) * 4, dkg = tid >> 5;
        const f32x4 vv = *(const f32x4*)(sv + dv4); f32x4 oacc = (f32x4){0.f, 0.f, 0.f, 0.f};
        const size_t base = ((size_t)(b * 8 + h)) * 16384;
#pragma unroll
        for (int i = 0; i < 8; ++i) { const int dk = dkg * 8 + i; const f32x4 s0 = *(const f32x4*)(S0 + base + dk * 128 + dv4);
            const f32x4 sn = sf[dk] * s0 + sk[dk] * vv; *(f32x4*)(Sn + base + dk * 128 + dv4) = sn; oacc += sq[dk] * sn; }
        *(f32x4*)(red + dkg * 128 + dv4) = oacc;
        __syncthreads();
        if (tid < 128) { float o = 0.f;
#pragma unroll
            for (int g = 0; g < 16; ++g) o += red[g * 128 + tid];
            so[tid] = o; const float s2 = wave_sum(o * o); if ((tid & 63) == 0) sr[tid >> 6] = s2; }
        __syncthreads();
        if (tid < 128) { const float rinv = rsqrtf((sr[0] + sr[1]) * (1.f / 128.f) + EPSV); const int c = h * 128 + tid;
            const float g = b2f(gss[(size_t)b * DM + c]); gss[(size_t)b * DM + c] = f2b(so[tid] * rinv * onorm[c] * g); }
        __syncthreads();
    }
}
__device__ __forceinline__ void conv_phase(const Params& P) {
    const u16* xrp = (const u16*)(P.ws + WS_R0); const u16* xrs = (const u16*)(P.ws + WS_SIDE + 5 * SSLOT);
    u16* xcp = (u16*)(P.ws + WS_R2); u16* xcs = (u16*)(P.ws + WS_SIDE + 7 * SSLOT);
    const float* cw = P.in[13]; const float* cb = P.in[14]; const float* sc = P.in[4];
    float* cpo = P.out + O_CP; float* cso = P.out + O_CS;
    const int tid = TIDX, ch = (tid & 127) * 8;
    float w0[8], w1[8], w2[8], w3[8], bb[8];
#pragma unroll
    for (int j = 0; j < 8; ++j) { w0[j] = cw[ch + j]; w1[j] = cw[1024 + ch + j]; w2[j] = cw[2048 + ch + j]; w3[j] = cw[3072 + ch + j]; bb[j] = cb[ch + j]; }
    for (int rg = blockIdx.x; rg < NTOK / 4; rg += gridDim.x) {
        const int row = rg * 4 + (tid >> 7);
        float x0[8], x1[8], x2[8], x3[8];
        if (row < TP) {
            const int t = row & (SEQ - 1); const u16* p = xrp + (size_t)row * DM + ch;
            unpack8(*(const u32x4*)p, x0);
            if (t >= 1) unpack8(*(const u32x4*)(p - DM), x1); else { for (int j = 0; j < 8; ++j) x1[j] = 0.f; }
            if (t >= 2) unpack8(*(const u32x4*)(p - 2 * DM), x2); else { for (int j = 0; j < 8; ++j) x2[j] = 0.f; }
            if (t >= 3) unpack8(*(const u32x4*)(p - 3 * DM), x3); else { for (int j = 0; j < 8; ++j) x3[j] = 0.f; }
            if (t >= SEQ - 3) { float* o = cpo + ((size_t)(row >> 11) * 3 + (t - (SEQ - 3))) * DM + ch; *(f32x4*)o = (f32x4){x0[0], x0[1], x0[2], x0[3]}; *(f32x4*)(o + 4) = (f32x4){x0[4], x0[5], x0[6], x0[7]}; }
        } else {
            const int b = row - TP; unpack8(*(const u32x4*)(xrs + (size_t)b * DM + ch), x0);
            const float* s = sc + (size_t)b * 3 * DM + ch;
#pragma unroll
            for (int j = 0; j < 8; ++j) { x3[j] = s[j]; x2[j] = s[DM + j]; x1[j] = s[2 * DM + j]; }
            float* o = cso + (size_t)b * 3 * DM + ch;
#pragma unroll
            for (int j = 0; j < 8; ++j) { o[j] = x2[j]; o[DM + j] = x1[j]; o[2 * DM + j] = x0[j]; }
        }
        float y[8];
#pragma unroll
        for (int j = 0; j < 8; ++j) y[j] = bb[j] + w3[j] * x0[j] + w2[j] * x1[j] + w1[j] * x2[j] + w0[j] * x3[j];
        u16* d = row < TP ? xcp + (size_t)row * DM + ch : xcs + (size_t)(row - TP) * DM + ch;
        *(u32x4*)d = pack8(y);
    }
}
__device__ __forceinline__ void lru_pass1(const Params& P) {
    const unsigned* la = (const unsigned*)(P.ws + WS_R2); const unsigned* bt = (const unsigned*)(P.ws + WS_R0); f32x4* agg = (f32x4*)(P.ws + WS_AGG);
    const int cp = TIDX;
    for (int item = blockIdx.x; item < 256; item += gridDim.x) {
        const size_t r0 = (size_t)item * 64;
        float P0 = 1.f, P1 = 1.f, H0 = 0.f, H1 = 0.f;
#pragma unroll 8
        for (int r = 0; r < 64; ++r) { const unsigned lw = la[(r0 + r) * 512 + cp], bw = bt[(r0 + r) * 512 + cp];
            const float a0 = __expf(blo(lw)), a1 = __expf(bhi(lw)); H0 = a0 * H0 + blo(bw); H1 = a1 * H1 + bhi(bw); P0 *= a0; P1 *= a1; }
        agg[(size_t)item * 512 + cp] = (f32x4){P0, H0, P1, H1};
    }
}
__device__ __forceinline__ void lru_pass2(const Params& P) {
    const unsigned* la = (const unsigned*)(P.ws + WS_R2); const unsigned* bt = (const unsigned*)(P.ws + WS_R0); unsigned* yg = (unsigned*)(P.ws + WS_R1); const f32x4* agg = (const f32x4*)(P.ws + WS_AGG);
    float* lpo = P.out + O_LP;
    const int cp = TIDX;
    for (int item = blockIdx.x; item < 256; item += gridDim.x) {
        const int b = item >> 5, c = item & 31; const size_t r0 = (size_t)item * 64;
        float h0 = 0.f, h1 = 0.f;
        for (int cc = 0; cc < c; ++cc) { const f32x4 g = agg[(size_t)(b * 32 + cc) * 512 + cp]; h0 = g.x * h0 + g.y; h1 = g.z * h1 + g.w; }
#pragma unroll 8
        for (int r = 0; r < 64; ++r) { const size_t ix = (r0 + r) * 512 + cp; const unsigned lw = la[ix], bw = bt[ix], yw = yg[ix];
            h0 = __expf(blo(lw)) * h0 + blo(bw); h1 = __expf(bhi(lw)) * h1 + bhi(bw); yg[ix] = pk(h0 * blo(yw), h1 * bhi(yw)); }
        if (c == 31) { lpo[b * DM + 2 * cp] = h0; lpo[b * DM + 2 * cp + 1] = h1; }
    }
    const unsigned* las = (const unsigned*)(P.ws + WS_SIDE + 7 * SSLOT); const unsigned* bts = (const unsigned*)(P.ws + WS_SIDE + 5 * SSLOT); unsigned* ygs = (unsigned*)(P.ws + WS_SIDE + 6 * SSLOT);
    const float* hl = P.in[3]; float* lso = P.out + O_LS;
    for (int b = blockIdx.x; b < TS; b += gridDim.x) {
        const size_t ix = (size_t)b * 512 + cp; const unsigned lw = las[ix], bw = bts[ix], yw = ygs[ix];
        const float h0 = __expf(blo(lw)) * hl[b * DM + 2 * cp] + blo(bw), h1 = __expf(bhi(lw)) * hl[b * DM + 2 * cp + 1] + bhi(bw);
        ygs[ix] = pk(h0 * blo(yw), h1 * bhi(yw)); lso[b * DM + 2 * cp] = h0; lso[b * DM + 2 * cp + 1] = h1;
    }
}

#define GSYNC() do { asm volatile("s_waitcnt vmcnt(0) lgkmcnt(0)" ::: "memory"); __builtin_amdgcn_fence(__ATOMIC_RELEASE, "agent"); grid.sync(); __builtin_amdgcn_fence(__ATOMIC_ACQUIRE, "agent"); } while (0)
#ifndef STOP_AT
#define STOP_AT 99
#endif
__device__ __forceinline__ void dumpcp(const unsigned char* src, unsigned char* dst, size_t bytes) {
    for (size_t i = ((size_t)blockIdx.x * 512 + threadIdx.x) * 16; i < bytes; i += (size_t)gridDim.x * 512 * 16) *(u32x4*)(dst + i) = *(const u32x4*)(src + i);
}
#define STOPCHK(n) do { if (STOP_AT == (n)) { if ((n) == 4) { dumpcp(P.ws + WS_R0, (unsigned char*)(P.out + O_HS), 2 * SLOT); dumpcp(P.ws + WS_R2, (unsigned char*)P.out + SLOT, SLOT); }  if ((n) == 2 || (n) == 14) { DEF_PTRS final_norm(X1, P.in[27], P.out + O_YP, P.out + O_YS); } return; } } while (0)
#define DEF_PTRS \
    unsigned char* ws = opq(P.ws); unsigned char* ob = opq((unsigned char*)P.out); (void)ob; \
    u16* Wgu = (u16*)(ws + WS_WGU); u16* Wd = (u16*)(ws + WS_WD); u16* Win = (u16*)(ws + WS_WIN); u16* Wbd = (u16*)(ws + WS_WBD); \
    u16* Waup = (u16*)(ws + WS_WAUP); u16* Wbup = (u16*)(ws + WS_WBUP); u16* Wout = (u16*)(ws + WS_WOUT); \
    float* X1 = (float*)(ws + WS_X1); float* LBv = (float*)(ws + WS_LB); float* LCv = (float*)(ws + WS_LC); \
    const B16 HN = {(u16*)(ws + WS_HN), (u16*)(ws + WS_SIDE + 0 * SSLOT)}; \
    const B16 QS = {(u16*)(ws + WS_R0), (u16*)(ws + WS_SIDE + 1 * SSLOT)}; \
    const B16 LF = {(u16*)(ws + WS_R1), (u16*)(ws + WS_SIDE + 2 * SSLOT)}; \
    const B16 VV = {(u16*)(ws + WS_R2), (u16*)(ws + WS_SIDE + 3 * SSLOT)}; \
    const B16 GS = {(u16*)(ob + O_YP * 4), (u16*)(ws + WS_SIDE + 4 * SSLOT)}; \
    const B16 XR = {(u16*)(ws + WS_R0), (u16*)(ws + WS_SIDE + 5 * SSLOT)}; \
    const B16 YG = {(u16*)(ws + WS_R1), (u16*)(ws + WS_SIDE + 6 * SSLOT)}; \
    const B16 XC = {(u16*)(ws + WS_R2), (u16*)(ws + WS_SIDE + 7 * SSLOT)}; \
    const B16 TA = {(u16*)(ws + WS_R0), (u16*)(ws + WS_SIDE + 8 * SSLOT)}; \
    const B16 GT = {(u16*)(ws + WS_R2), (u16*)(ws + WS_SIDE + 9 * SSLOT)}; \
    const B16 MB = {(u16*)(ob + O_YP * 4) + (size_t)TP * DM, (u16*)(ws + WS_SIDE + 10 * SSLOT)}; \
    const B16 ACT = {(u16*)(ws + WS_R0), (u16*)(ws + WS_ACTS)}; \
    (void)Wgu; (void)Wd; (void)Win; (void)Wbd; (void)Waup; (void)Wbup; (void)Wout; (void)X1; (void)LBv; (void)LCv; \
    (void)HN; (void)QS; (void)LF; (void)VV; (void)GS; (void)XR; (void)YG; (void)XC; (void)TA; (void)GT; (void)MB; (void)ACT;

__global__ void __launch_bounds__(512, 2) mega(Params P) {
    extern __shared__ __attribute__((aligned(16))) unsigned char shm[];
    cg::grid_group grid = cg::this_grid();
    LAS unsigned char* lds = (LAS unsigned char*)shm;
    const int G = gridDim.x, cblk = blockIdx.x;

    {
        DEF_PTRS
        float* tile = (float*)shm;
        for (int t = cblk; t < 4928; t += G) {
            if (t < 704) conv_matrix(P.in[6], 1024, 2816, Wgu, 1, t, tile);
            else if (t < 1408) conv_matrix(P.in[7], 1024, 2816, Wgu, 2, t - 704, tile);
            else if (t < 2112) conv_matrix(P.in[8], 2816, 1024, Wd, 0, t - 1408, tile);
            else if (t < 4160) conv_matrix(P.in[10], 1024, 8192, Win, 0, t - 2112, tile);
            else if (t < 4416) conv_matrix(P.in[20], 1024, 1024, Waup, 0, t - 4160, tile);
            else if (t < 4672) conv_matrix(P.in[21], 1024, 1024, Wbup, 0, t - 4416, tile);
            else conv_matrix(P.in[22], 1024, 1024, Wout, 0, t - 4672, tile);
        }
        for (int idx = cblk * 512 + TIDX; idx < 8 * 256 * 256; idx += G * 512) {
            const int n = idx >> 16, row = (idx >> 8) & 255, kk = idx & 255, bj = row >> 7, d = row & 127;
            float v = 0.f; if ((kk >> 7) == (n & 1)) v = (bj ? P.in[17] : P.in[15])[(size_t)n * 16384 + (kk & 127) * 128 + d];
            Wbd[idx] = f2b(v);
        }
        if (cblk == 0) { for (int c = TIDX; c < 1024; c += 512) { LBv[c] = 1.f / (1.f + __expf(P.in[11][1024 + c] - P.in[11][c])); LCv[c] = -8.f * log1pf(__expf(-P.in[19][c])); } }
        norm_rows(P.in[0], P.in[1], P.in[5], HN);
    }
    GSYNC(); STOPCHK(0);
    { DEF_PTRS SchedSimple S{HN.p, HN.s, Wgu, DM, DM, 22, G, cblk, 0}; EpiGU E{ACT}; gemm_phase(lds, DM, DM, S, E); }
    GSYNC(); STOPCHK(1);
    { DEF_PTRS SchedSimple S{ACT.p, ACT.s, Wd, DFF, DFF, 4, G, cblk, 0}; EpiRes E{P.in[0], P.in[1], TS, X1, 0.5f}; gemm_phase(lds, DFF, DFF, S, E); }
    GSYNC(); STOPCHK(2);
    {
        DEF_PTRS
        float* tile = (float*)shm;
        for (int t = cblk; t < 2112; t += G) {
            if (t < 704) conv_matrix(P.in[24], 1024, 2816, Wgu, 1, t, tile);
            else if (t < 1408) conv_matrix(P.in[25], 1024, 2816, Wgu, 2, t - 704, tile);
            else conv_matrix(P.in[26], 2816, 1024, Wd, 0, t - 1408, tile);
        }
        norm_rows(X1, X1 + (size_t)TP * DM, P.in[9], HN);
    }
    GSYNC(); STOPCHK(3);
    { DEF_PTRS SchedSimple S{HN.p, HN.s, Win, DM, DM, 16, G, cblk, 0}; EpiInA E{QS, LF, VV, GS, LBv}; gemm_phase(lds, DM, DM, S, E); }
    GSYNC(); STOPCHK(4);
    hgrn_h1(P, shm);
    GSYNC(); STOPCHK(5);
    hgrn_h2(P);
    GSYNC(); STOPCHK(6);
    hgrn_h3(P, shm);
    GSYNC(); STOPCHK(7);
    { DEF_PTRS SchedSimple S{HN.p, HN.s, Win + (size_t)4096 * DM, DM, DM, 8, G, cblk, 0}; EpiInB E{XR, YG}; gemm_phase(lds, DM, DM, S, E); }
    GSYNC(); STOPCHK(8);
    conv_phase(P); hgrn_sample(P, shm);
    GSYNC(); STOPCHK(9);
    { DEF_PTRS SchedSimple S{XC.p, XC.s, Wbd, DM, 256, 8, G, cblk, 256}; EpiBD E{XC, XR, P.in[16], P.in[18], LCv}; gemm_phase(lds, 256, DM, S, E); }
    GSYNC(); STOPCHK(10);
    lru_pass1(P);
    GSYNC(); STOPCHK(11);
    lru_pass2(P);
    GSYNC(); STOPCHK(12);
    { DEF_PTRS SchedMerge S{HN, GS, YG, Win, Waup, Wbup, G, cblk}; EpiMerge E{GT, TA, MB}; gemm_phase(lds, DM, DM, S, E); }
    GSYNC(); STOPCHK(13);
    { DEF_PTRS SchedSimple S{MB.p, MB.s, Wout, DM, DM, 4, G, cblk, 0}; EpiRes E{X1, X1 + (size_t)TP * DM, 256, X1, 1.0f}; gemm_phase(lds, DM, DM, S, E); }
    GSYNC(); STOPCHK(14);
    { DEF_PTRS norm_rows(X1, X1 + (size_t)TP * DM, P.in[23], HN); }
    GSYNC(); STOPCHK(15);
    { DEF_PTRS SchedSimple S{HN.p, HN.s, Wgu, DM, DM, 22, G, cblk, 0}; EpiGU E{ACT}; gemm_phase(lds, DM, DM, S, E); }
    GSYNC(); STOPCHK(16);
    { DEF_PTRS SchedSimple S{ACT.p, ACT.s, Wd, DFF, DFF, 4, G, cblk, 0}; EpiRes E{X1, X1 + (size_t)TP * DM, 256, X1, 0.5f}; gemm_phase(lds, DFF, DFF, S, E); }
    GSYNC(); STOPCHK(17);
    { DEF_PTRS final_norm(X1, P.in[27], P.out + O_YP, P.out + O_YS); }
}

extern "C" void kernel_launch(void* const* d_in, const int* in_sizes, int n_in, void* d_out, int out_size, void* d_ws, size_t ws_size, hipStream_t stream) {
    static int grid = 0;
    if (grid == 0) {
        int dev = 0, cus = 0, per_cu = 0;
        if (n_in != 28 || ws_size < WS_END) { fprintf(stderr, "kernel_launch: unexpected n_in %d / ws_size %zu (need %zu)\n", n_in, ws_size, (size_t)WS_END); grid = -1; return; }
        (void)hipGetDevice(&dev); (void)hipDeviceGetAttribute(&cus, hipDeviceAttributeMultiprocessorCount, dev);
        if (hipFuncSetAttribute((const void*)mega, hipFuncAttributeMaxDynamicSharedMemorySize, LDS_BYTES) != hipSuccess) { fprintf(stderr, "kernel_launch: hipFuncSetAttribute failed\n"); grid = -1; return; }
        if (hipOccupancyMaxActiveBlocksPerMultiprocessor(&per_cu, (const void*)mega, 512, LDS_BYTES) != hipSuccess || per_cu < 1) { fprintf(stderr, "kernel_launch: occupancy query gave %d\n", per_cu); per_cu = 1; (void)hipGetLastError(); }
        grid = cus * 1;
    }
    if (grid < 0) return;
    Params p{};
    for (int i = 0; i < 28; ++i) p.in[i] = (const float*)d_in[i];
    p.out = (float*)d_out; p.ws = (unsigned char*)d_ws;
    void* args[] = {&p};
    hipError_t e = hipLaunchCooperativeKernel((void*)mega, dim3(grid), dim3(512), args, LDS_BYTES, stream);
    if (e != hipSuccess) fprintf(stderr, "cooperative launch failed: %s (grid %d)\n", hipGetErrorString(e), grid);
}
```

```cpp
#include <hip/hip_runtime.h>
#include <hip/hip_cooperative_groups.h>
#include <cstdio>
namespace cg = cooperative_groups;

#define LAS __attribute__((address_space(3)))
typedef unsigned short u16;
typedef short bf16x8 __attribute__((ext_vector_type(8)));
typedef float f32x4 __attribute__((ext_vector_type(4)));
typedef unsigned u32x4 __attribute__((ext_vector_type(4)));
typedef unsigned u32x2 __attribute__((ext_vector_type(2)));

constexpr int TP = 16384, TS = 128, NTOK = TP + TS, DM = 1024, DFF = 2816, SEQ = 2048;
constexpr float EPSV = 1e-6f;
constexpr int LDS_BYTES = 147456;

constexpr size_t SLOT = (size_t)TP * DM * 2;
constexpr size_t SSLOT = (size_t)256 * DM * 2;
constexpr size_t WS_WGU = 0;
constexpr size_t WS_WD = WS_WGU + (size_t)5632 * 1024 * 2;
constexpr size_t WS_WIN = WS_WD + (size_t)1024 * 2816 * 2;
constexpr size_t WS_WBD = WS_WIN + (size_t)8192 * 1024 * 2;
constexpr size_t WS_WAUP = WS_WBD + (size_t)8 * 256 * 256 * 2;
constexpr size_t WS_WBUP = WS_WAUP + (size_t)1024 * 1024 * 2;
constexpr size_t WS_WOUT = WS_WBUP + (size_t)1024 * 1024 * 2;
constexpr size_t WS_X1 = WS_WOUT + (size_t)1024 * 1024 * 2;
constexpr size_t WS_HN = WS_X1 + (size_t)16640 * DM * 4;
constexpr size_t WS_R0 = WS_HN + SLOT;
constexpr size_t WS_R1 = WS_R0 + SLOT;
constexpr size_t WS_R2 = WS_R1 + SLOT;
constexpr size_t WS_SIDE = WS_R2 + SLOT;
constexpr size_t WS_ACTS = WS_SIDE + 11 * SSLOT;
constexpr size_t WS_BL = WS_ACTS + (size_t)256 * DFF * 2;
constexpr size_t WS_AGG = WS_BL + (size_t)2048 * 128 * 4;
constexpr size_t WS_LB = WS_AGG + (size_t)256 * 1024 * 8;
constexpr size_t WS_LC = WS_LB + 4096;
constexpr size_t WS_END = WS_LC + 4096;
static_assert(WS_END <= (size_t)268435456, "workspace too large");
constexpr size_t O_YP = 0, O_YS = 16777216, O_HP = 16908288, O_LP = 17956864, O_CP = 17965056, O_HS = 17989632, O_LS = 34766848, O_CS = 34897920;

struct Params { const float* in[28]; float* out; unsigned char* ws; };
struct B16 { u16* p; u16* s; };

typedef __bf16 bf16x2_t __attribute__((ext_vector_type(2)));
typedef float f32x2_t __attribute__((ext_vector_type(2)));
__device__ __forceinline__ unsigned pk(float lo, float hi) { const f32x2_t v = {lo, hi}; const bf16x2_t b = __builtin_convertvector(v, bf16x2_t); return __builtin_bit_cast(unsigned, b); }
__device__ __forceinline__ float blo(unsigned w) { return __uint_as_float(w << 16); }
__device__ __forceinline__ float bhi(unsigned w) { return __uint_as_float(w & 0xffff0000u); }
__device__ __forceinline__ float b2f(u16 b) { return __uint_as_float(((unsigned)b) << 16); }
__device__ __forceinline__ u16 f2b(float f) { return (u16)(pk(f, 0.f) & 0xffffu); }
__device__ __forceinline__ float sigm(float x) { return 1.f / (1.f + __expf(-x)); }
__device__ __forceinline__ float silu(float x) { return x / (1.f + __expf(-x)); }
__device__ __forceinline__ float gelu_t(float x) { const float u = 0.7978845608028654f * (x + 0.044715f * x * x * x); return x / (1.f + __expf(-2.f * u)); }
__device__ __forceinline__ unsigned pkh(float lo, float hi) { const _Float16 a = (_Float16)lo, b = (_Float16)hi; return (unsigned)__builtin_bit_cast(u16, a) | ((unsigned)__builtin_bit_cast(u16, b) << 16); }
__device__ __forceinline__ float h2f(u16 h) { return (float)__builtin_bit_cast(_Float16, h); }
__device__ __forceinline__ u32x4 pack8(const float* o) { u32x4 r; r.x = pk(o[0], o[1]); r.y = pk(o[2], o[3]); r.z = pk(o[4], o[5]); r.w = pk(o[6], o[7]); return r; }
__device__ __forceinline__ void unpack8(u32x4 w, float* o) { o[0] = blo(w.x); o[1] = bhi(w.x); o[2] = blo(w.y); o[3] = bhi(w.y); o[4] = blo(w.z); o[5] = bhi(w.z); o[6] = blo(w.w); o[7] = bhi(w.w); }
__device__ __forceinline__ unsigned char* opq(unsigned char* p) { asm volatile("" : "+s"(p)); return p; }
__device__ __forceinline__ int opqv(int v) { asm volatile("" : "+v"(v)); return v; }
#define TIDX opqv((int)threadIdx.x)
struct F8 { f32x4 a, b; };
__device__ __forceinline__ F8 unpack8v(u32x4 w) { F8 r; r.a = (f32x4){blo(w.x), bhi(w.x), blo(w.y), bhi(w.y)}; r.b = (f32x4){blo(w.z), bhi(w.z), blo(w.w), bhi(w.w)}; return r; }
__device__ __forceinline__ u32x4 pack8v(f32x4 a, f32x4 b) { u32x4 r; r.x = pk(a.x, a.y); r.y = pk(a.z, a.w); r.z = pk(b.x, b.y); r.w = pk(b.z, b.w); return r; }
__device__ __forceinline__ u32x4 pack8h(f32x4 a, f32x4 b) { u32x4 r; r.x = pkh(a.x, a.y); r.y = pkh(a.z, a.w); r.z = pkh(b.x, b.y); r.w = pkh(b.z, b.w); return r; }
__device__ __forceinline__ f32x4 sig4(f32x4 v) { return (f32x4){sigm(v.x), sigm(v.y), sigm(v.z), sigm(v.w)}; }
__device__ __forceinline__ f32x4 silu4(f32x4 v) { return (f32x4){silu(v.x), silu(v.y), silu(v.z), silu(v.w)}; }
__device__ __forceinline__ f32x4 gelu4(f32x4 v) { return (f32x4){gelu_t(v.x), gelu_t(v.y), gelu_t(v.z), gelu_t(v.w)}; }
__device__ __forceinline__ f32x4 log4(f32x4 v) { return (f32x4){__logf(v.x), __logf(v.y), __logf(v.z), __logf(v.w)}; }
__device__ __forceinline__ float wave_sum(float v) {
#pragma unroll
    for (int o = 32; o >= 1; o >>= 1) v += __shfl_xor(v, o, 64);
    return v;
}

constexpr int BM = 256, BK = 64, HALF = 128, HTB = HALF * BK * 2;
__device__ __forceinline__ int lds_byte(int r, int c) { const int st = (r >> 4) * 2 + (c >> 5), rr = r & 15, cc = c & 31, ob = rr * 64 + cc * 2; return st * 1024 + (ob ^ (((ob >> 9) & 1) << 5)); }
__device__ __forceinline__ void stage_rc(int b, int& R, int& C) { const int st = b / 1024, sb = b % 1024, swz = sb ^ (((sb >> 9) & 1) << 5); R = (st >> 1) * 16 + swz / 64; C = (st & 1) * 32 + (swz % 64) / 2; }
__device__ __forceinline__ int perm32(int rho) { const int n = rho >> 4, i = rho & 15; return 8 * (i >> 2) + 4 * n + (i & 3); }

struct Unit { int pm, pn, sub; const char* a; const char* b; };

__device__ __forceinline__ bool tile_of(long L, int nM, int nN, int& pm, int& pn) {
    const int nwg = nM * nN; if (L >= nwg) return false;
    int wgid = (int)L; { const int q = nwg / 8, r = nwg % 8, xcd = wgid % 8, off = wgid / 8; wgid = (xcd < r ? xcd * (q + 1) : r * (q + 1) + (xcd - r) * q) + off; }
    const int nig = 8 * nN, gid = wgid / nig, fm = gid * 8, gsz = (nM - fm) < 8 ? (nM - fm) : 8;
    pm = fm + ((wgid % nig) % gsz); pn = (wgid % nig) / gsz; return true;
}

template <class Epi, class Sched>
__device__ __forceinline__ void gemm_phase(LAS unsigned char* lds, const int K, const int lda, const Sched& S, const Epi& E) {
    const int tid = TIDX, wid = __builtin_amdgcn_readfirstlane(tid >> 6), lane = tid & 63, wr = wid >> 2, wc = wid & 3, fr = lane & 15, fq = lane >> 4;
    const int nt = K / BK;
    unsigned voffA[2], voffB[2];
#pragma unroll
    for (int i = 0; i < 2; ++i) { int R, C; stage_rc(tid * 16 + i * 8192, R, C); const int Rb = Epi::PERM ? ((R & ~31) + perm32(R & 31)) : R;
        voffA[i] = (unsigned)(R * lda + C) * 2u; voffB[i] = (unsigned)(Rb * K + C) * 2u; }
    const size_t kstep = (size_t)(BK * 2);
    const size_t hstepA = (size_t)HALF * lda * 2, hstepB = (size_t)HALF * K * 2;
    const unsigned ldsw = (unsigned)wid * 1024u;
    const int aoff = lds_byte(wr * 64 + fr, fq * 8), boff = lds_byte(wc * 32 + fr, fq * 8);
#define G_SA(b, h) (((b) * 2 + (h)) * HTB)
#define G_SB(b, h) ((4 + (b) * 2 + (h)) * HTB)
#define G_STAGE(bufoff, gbase, voff) do { _Pragma("unroll") for (int _i = 0; _i < 2; ++_i) \
        __builtin_amdgcn_global_load_lds((const unsigned*)((const char*)(gbase) + (voff)[_i]), (LAS unsigned*)(lds + (bufoff) + ldsw + _i * 8192), 16, 0, 0); } while (0)
#define G_LDA(dst, b, h) do { _Pragma("unroll") for (int m = 0; m < 4; ++m) _Pragma("unroll") for (int k = 0; k < 2; ++k) dst[m][k] = *(const LAS bf16x8*)(lds + G_SA(b, h) + aoff + m * 2048 + k * 1024); } while (0)
#define G_LDB(dst, b, h) do { _Pragma("unroll") for (int n = 0; n < 2; ++n) _Pragma("unroll") for (int k = 0; k < 2; ++k) dst[n][k] = *(const LAS bf16x8*)(lds + G_SB(b, h) + boff + n * 2048 + k * 1024); } while (0)
#define G_MMA(ai, bj, At, Bt) do { __builtin_amdgcn_s_setprio(1); _Pragma("unroll") for (int m = 0; m < 4; ++m) _Pragma("unroll") for (int n = 0; n < 2; ++n) _Pragma("unroll") for (int k = 0; k < 2; ++k) \
        acc[ai][bj][m][n] = __builtin_amdgcn_mfma_f32_16x16x32_bf16(Bt[n][k], At[m][k], acc[ai][bj][m][n], 0, 0, 0); __builtin_amdgcn_s_setprio(0); } while (0)
#define G_WAIT_V(n) asm volatile("s_waitcnt vmcnt(" #n ")" ::: "memory")
#define G_WAIT_L(n) asm volatile("s_waitcnt lgkmcnt(" #n ")" ::: "memory")
#define G_BAR __builtin_amdgcn_s_barrier()
#define G_SCHED __builtin_amdgcn_sched_barrier(0)
    Unit cur, nxt; int ui = 0;
    if (!S.next(0, cur)) return;
    f32x4 acc[2][2][4][2];
#pragma unroll
    for (int a = 0; a < 2; ++a)
#pragma unroll
        for (int b = 0; b < 2; ++b)
#pragma unroll
            for (int m = 0; m < 4; ++m)
#pragma unroll
                for (int n = 0; n < 2; ++n) acc[a][b][m][n] = (f32x4){0.f, 0.f, 0.f, 0.f};
    bf16x8 At[4][2], B0[2][2], B1[2][2];
    const char* cA = cur.a; const char* cB = cur.b;
    G_STAGE(G_SB(0, 0), cB, voffB); G_STAGE(G_SA(0, 0), cA, voffA); G_STAGE(G_SB(0, 1), cB + hstepB, voffB); G_STAGE(G_SA(0, 1), cA + hstepA, voffA);
    if (wr == 1) G_BAR;
    G_WAIT_V(4); G_BAR;
    G_STAGE(G_SB(1, 0), cB + kstep, voffB); G_STAGE(G_SA(1, 0), cA + kstep, voffA); G_STAGE(G_SB(1, 1), cB + hstepB + kstep, voffB);
    G_WAIT_V(6); G_BAR;
    for (;;) {
        const bool has_next = S.next(ui + 1, nxt);
        const char* nA = has_next ? nxt.a : cA; const char* nB = has_next ? nxt.b : cB;
        for (int t = 0; t < nt; t += 2) {
            const bool last = (t == nt - 2);
            const char* a1 = cA + (size_t)(t + 1) * kstep;
            const char* a2 = last ? nA : cA + (size_t)(t + 2) * kstep; const char* b2 = last ? nB : cB + (size_t)(t + 2) * kstep;
            const char* a3 = a2 + kstep; const char* b3 = b2 + kstep;
            G_LDB(B0, 0, 0); G_SCHED; G_LDA(At, 0, 0); G_STAGE(G_SA(1, 1), a1 + hstepA, voffA);
            G_WAIT_L(8); G_BAR; G_WAIT_L(0); G_MMA(0, 0, At, B0); G_BAR; G_SCHED;
            G_LDB(B1, 0, 1); G_STAGE(G_SB(0, 0), b2, voffB);
            G_BAR; G_WAIT_L(0); G_MMA(0, 1, At, B1); G_BAR;
            G_LDA(At, 0, 1); G_STAGE(G_SA(0, 0), a2, voffA);
            G_BAR; G_WAIT_L(0); G_MMA(1, 0, At, B0); G_BAR; G_SCHED;
            G_STAGE(G_SB(0, 1), b2 + hstepB, voffB);
            G_WAIT_V(6); G_BAR; G_MMA(1, 1, At, B1); G_BAR;
            G_LDB(B0, 1, 0); G_SCHED; G_LDA(At, 1, 0); G_STAGE(G_SA(0, 1), a2 + hstepA, voffA);
            G_WAIT_L(8); G_BAR; G_WAIT_L(0); G_MMA(0, 0, At, B0); G_BAR; G_SCHED;
            G_LDB(B1, 1, 1); G_STAGE(G_SB(1, 0), b3, voffB);
            G_BAR; G_WAIT_L(0); G_MMA(0, 1, At, B1); G_BAR;
            G_LDA(At, 1, 1); G_STAGE(G_SA(1, 0), a3, voffA);
            G_BAR; G_WAIT_L(0); G_MMA(1, 0, At, B0); G_BAR; G_SCHED;
            G_STAGE(G_SB(1, 1), b3 + hstepB, voffB);
            G_WAIT_V(6); G_BAR; G_MMA(1, 1, At, B1); G_BAR;
        }
        E(acc, cur, wr, wc, fr, fq);
        if (!has_next) break;
#pragma unroll
        for (int a = 0; a < 2; ++a)
#pragma unroll
            for (int b = 0; b < 2; ++b)
#pragma unroll
                for (int m = 0; m < 4; ++m)
#pragma unroll
                    for (int n = 0; n < 2; ++n) acc[a][b][m][n] = (f32x4){0.f, 0.f, 0.f, 0.f};
        cur = nxt; cA = nA; cB = nB; ++ui;
    }
    G_WAIT_V(0);
    if (wr == 0) G_BAR;
    G_BAR;
#undef G_SA
#undef G_SB
#undef G_STAGE
#undef G_LDA
#undef G_LDB
#undef G_MMA
#undef G_WAIT_V
#undef G_WAIT_L
#undef G_BAR
#undef G_SCHED
}

struct SchedSimple {
    const u16* Ap; const u16* As; const u16* Bt; int lda, K, nN, G, c; int acol_per_pn;
    __device__ __forceinline__ bool next(int i, Unit& u) const {
        int pm, pn; if (!tile_of((long)i * G + c, 65, nN, pm, pn)) return false;
        u.pm = pm; u.pn = pn; u.sub = 0;
        u.a = (const char*)((pm < 64 ? Ap + (size_t)pm * 256 * lda : As) + (size_t)(pn >> 1) * acol_per_pn);
        u.b = (const char*)(Bt + (size_t)pn * 256 * K); return true;
    }
};
struct SchedMerge {
    B16 hn, oa, ob; const u16* Win; const u16* Waup; const u16* Wbup; int G, c;
    __device__ __forceinline__ bool next(int i, Unit& u) const {
        int pm, pn; if (!tile_of((long)(i >> 2) * G + c, 65, 4, pm, pn)) return false;
        const int sub = i & 3; u.pm = pm; u.pn = pn; u.sub = sub;
        const unsigned long long m1 = (sub == 1) ? ~0ull : 0ull, m3 = (sub == 3) ? ~0ull : 0ull, m0 = ~(m1 | m3);
        const u16* abp = (const u16*)(((unsigned long long)oa.p & m1) | ((unsigned long long)ob.p & m3) | ((unsigned long long)hn.p & m0));
        const u16* abs_ = (const u16*)(((unsigned long long)oa.s & m1) | ((unsigned long long)ob.s & m3) | ((unsigned long long)hn.s & m0));
        const u16* bb = (const u16*)(((unsigned long long)Waup & m1) | ((unsigned long long)Wbup & m3) | ((unsigned long long)(Win + (size_t)(sub == 0 ? 6144 : 7168) * DM) & m0));
        u.a = (const char*)(pm < 64 ? abp + (size_t)pm * 256 * DM : abs_);
        u.b = (const char*)(bb + (size_t)pn * 256 * DM); return true;
    }
};

struct EpiGU {
    static constexpr bool PERM = true; B16 act;
    __device__ __forceinline__ void operator()(const f32x4 (&acc)[2][2][4][2], const Unit& u, int wr, int wc, int fr, int fq) const {
        u16* base = (u.pm < 64 ? act.p + (size_t)u.pm * 256 * DFF : act.s) + u.pn * 128 + wc * 32 + 8 * fq;
#pragma unroll
        for (int ai = 0; ai < 2; ++ai)
#pragma unroll
            for (int m = 0; m < 4; ++m) {
                const int rt = ai * 128 + wr * 64 + m * 16 + fr; float o[8];
#pragma unroll
                for (int n = 0; n < 2; ++n)
#pragma unroll
                    for (int j = 0; j < 4; ++j) o[n * 4 + j] = silu(acc[ai][0][m][n][j]) * acc[ai][1][m][n][j];
                *(u32x4*)(base + (size_t)rt * DFF) = pack8(o);
            }
    }
};
struct EpiRes {
    static constexpr bool PERM = false; const float* rp; const float* rs; int ns; float* out; float scale;
    __device__ __forceinline__ void operator()(const f32x4 (&acc)[2][2][4][2], const Unit& u, int wr, int wc, int fr, int fq) const {
        const int col0 = u.pn * 256 + wc * 32 + 4 * fq;
#pragma unroll
        for (int ai = 0; ai < 2; ++ai)
#pragma unroll
            for (int m = 0; m < 4; ++m) {
                const int rt = ai * 128 + wr * 64 + m * 16 + fr; const int row = u.pm * 256 + rt;
                const float* r = (u.pm < 64) ? rp + (size_t)row * DM : rs + (size_t)rt * DM; const bool valid = (u.pm < 64) || (rt < ns);
                float* o = out + (size_t)row * DM;
#pragma unroll
                for (int bj = 0; bj < 2; ++bj)
#pragma unroll
                    for (int n = 0; n < 2; ++n) { const int c = col0 + bj * 128 + n * 16; f32x4 rv = (f32x4){0.f, 0.f, 0.f, 0.f}; if (valid) rv = *(const f32x4*)(r + c);
                        *(f32x4*)(o + c) = rv + scale * acc[ai][bj][m][n]; }
                asm volatile("" ::: "memory");
            }
    }
};
template <int MODE> __device__ __forceinline__ void ina_store(u16* base, const f32x4 (&acc)[2][2][4][2], const float* lbp) {
#pragma unroll
    for (int bj = 0; bj < 2; ++bj) {
        f32x4 l0 = (f32x4){0.f, 0.f, 0.f, 0.f}, l1 = l0;
        if (MODE == 1) { l0 = *(const f32x4*)(lbp + bj * 128); l1 = *(const f32x4*)(lbp + bj * 128 + 4); }
#pragma unroll
        for (int ai = 0; ai < 2; ++ai)
#pragma unroll
            for (int m = 0; m < 4; ++m) {
                u16* d = base + (size_t)(ai * 128 + m * 16) * DM + bj * 128;
                if (MODE == 1) { const f32x4 f0 = l0 + (1.f - l0) * sig4(acc[ai][bj][m][0]), f1 = l1 + (1.f - l1) * sig4(acc[ai][bj][m][1]); *(u32x4*)d = pack8h(log4(f0), log4(f1)); }
                else if (MODE == 2) *(u32x4*)d = pack8v(acc[ai][bj][m][0], acc[ai][bj][m][1]);
                else *(u32x4*)d = pack8v(silu4(acc[ai][bj][m][0]), silu4(acc[ai][bj][m][1]));
            }
    }
}
struct EpiInA {
    static constexpr bool PERM = true; B16 qs, lf, v, gs; const float* lbv;
    __device__ __forceinline__ void operator()(const f32x4 (&acc)[2][2][4][2], const Unit& u, int wr, int wc, int fr, int fq) const {
        const int seg = u.pn >> 2, cs = (u.pn & 3) * 256 + wc * 32 + 8 * fq;
        const size_t ro = cs + (size_t)(wr * 64 + fr) * DM; const size_t po = (size_t)u.pm * 256 * DM; const bool pr = u.pm < 64;
        if (seg == 0) { u16* qp = qs.p; u16* qsm = qs.s; ina_store<0>((pr ? qp + po : qsm) + ro, acc, lbv); }
        else if (seg == 1) { u16* qp = lf.p; u16* qsm = lf.s; ina_store<1>((pr ? qp + po : qsm) + ro, acc, lbv + cs); }
        else if (seg == 2) { u16* qp = v.p; u16* qsm = v.s; ina_store<2>((pr ? qp + po : qsm) + ro, acc, lbv); }
        else { u16* qp = gs.p; u16* qsm = gs.s; ina_store<0>((pr ? qp + po : qsm) + ro, acc, lbv); }
    }
};
struct EpiInB {
    static constexpr bool PERM = true; B16 xr, yg;
    __device__ __forceinline__ void operator()(const f32x4 (&acc)[2][2][4][2], const Unit& u, int wr, int wc, int fr, int fq) const {
        const int seg = u.pn >> 2, cs = (u.pn & 3) * 256 + wc * 32 + 8 * fq;
        u16* base = (u.pm < 64 ? (seg == 0 ? +xr.p : +yg.p) + (size_t)u.pm * 256 * DM : (seg == 0 ? +xr.s : +yg.s)) + cs + (size_t)(wr * 64 + fr) * DM;
        if (seg == 0) {
#pragma unroll
            for (int ai = 0; ai < 2; ++ai)
#pragma unroll
                for (int m = 0; m < 4; ++m)
#pragma unroll
                    for (int bj = 0; bj < 2; ++bj) *(u32x4*)(base + (size_t)(ai * 128 + m * 16) * DM + bj * 128) = pack8v(acc[ai][bj][m][0], acc[ai][bj][m][1]);
        } else {
#pragma unroll
            for (int ai = 0; ai < 2; ++ai)
#pragma unroll
                for (int m = 0; m < 4; ++m)
#pragma unroll
                    for (int bj = 0; bj < 2; ++bj) *(u32x4*)(base + (size_t)(ai * 128 + m * 16) * DM + bj * 128) = pack8v(gelu4(acc[ai][bj][m][0]), gelu4(acc[ai][bj][m][1]));
        }
    }
};
__device__ __forceinline__ f32x4 nexpm1_4(f32x4 x) { const f32x4 p = 1.f + x * (0.5f + x * (0.16666667f + x * (0.041666668f + x * (0.008333334f + x * 0.0013888889f)))); return -x * p; }
__device__ __forceinline__ f32x4 sqrt4(f32x4 v) { return (f32x4){sqrtf(fmaxf(v.x, 0.f)), sqrtf(fmaxf(v.y, 0.f)), sqrtf(fmaxf(v.z, 0.f)), sqrtf(fmaxf(v.w, 0.f))}; }
struct EpiBD {
    static constexpr bool PERM = true; B16 xc, bt; const float* ba; const float* bx; const float* lc;
    __device__ __forceinline__ void operator()(const f32x4 (&acc)[2][2][4][2], const Unit& u, int wr, int wc, int fr, int fq) const {
        const int ch = u.pn * 128 + wc * 32 + 8 * fq;
        u16* xb = (u.pm < 64 ? xc.p + (size_t)u.pm * 256 * DM : xc.s) + ch + (size_t)(wr * 64 + fr) * DM; u16* bb = (u.pm < 64 ? bt.p + (size_t)u.pm * 256 * DM : bt.s) + ch + (size_t)(wr * 64 + fr) * DM;
#pragma unroll
        for (int n = 0; n < 2; ++n) {
            const f32x4 cba = *(const f32x4*)(ba + ch + 4 * n), cbx = *(const f32x4*)(bx + ch + 4 * n), cl = *(const f32x4*)(lc + ch + 4 * n);
#pragma unroll
            for (int ai = 0; ai < 2; ++ai)
#pragma unroll
                for (int m = 0; m < 4; ++m) {
                    const size_t off = (size_t)(ai * 128 + m * 16) * DM + 4 * n;
                    const u32x2 xw = *(const u32x2*)(xb + off); const f32x4 xv = (f32x4){blo(xw.x), bhi(xw.x), blo(xw.y), bhi(xw.y)};
                    const f32x4 r = sig4(acc[ai][0][m][n] + cba), ig = sig4(acc[ai][1][m][n] + cbx);
                    const f32x4 la = r * cl; const f32x4 bo = sqrt4(nexpm1_4(2.f * la)) * ig * xv;
                    u32x2 o1, o2; o1.x = pk(la.x, la.y); o1.y = pk(la.z, la.w); o2.x = pk(bo.x, bo.y); o2.y = pk(bo.z, bo.w);
                    *(u32x2*)(xb + off) = o1; *(u32x2*)(bb + off) = o2;
                    if (m & 1) asm volatile("" ::: "memory");
                }
        }
    }
};
struct EpiMerge {
    static constexpr bool PERM = true; B16 gt, ta, mb;
    __device__ __forceinline__ void operator()(const f32x4 (&acc)[2][2][4][2], const Unit& u, int wr, int wc, int fr, int fq) const {
        const size_t ro = ((u.pm < 64) ? (size_t)u.pm * 256 * DM : 0) + u.pn * 256 + wc * 32 + 8 * fq + (size_t)(wr * 64 + fr) * DM;
        u16* g = (u.pm < 64 ? +gt.p : +gt.s) + ro; u16* t = (u.pm < 64 ? +ta.p : +ta.s) + ro; u16* mo = (u.pm < 64 ? +mb.p : +mb.s) + ro;
        const int sub = u.sub;
        if (sub == 0 || sub == 2) {
#pragma unroll
            for (int ai = 0; ai < 2; ++ai)
#pragma unroll
                for (int m = 0; m < 4; ++m)
#pragma unroll
                    for (int bj = 0; bj < 2; ++bj) *(u32x4*)(g + (size_t)(ai * 128 + m * 16) * DM + bj * 128) = pack8v(sig4(acc[ai][bj][m][0]), sig4(acc[ai][bj][m][1]));
        } else if (sub == 1) {
#pragma unroll
            for (int ai = 0; ai < 2; ++ai)
#pragma unroll
                for (int m = 0; m < 4; ++m)
#pragma unroll
                    for (int bj = 0; bj < 2; ++bj) { const size_t off = (size_t)(ai * 128 + m * 16) * DM + bj * 128; const F8 gv = unpack8v(*(const u32x4*)(g + off));
                        *(u32x4*)(t + off) = pack8v(gv.a * acc[ai][bj][m][0], gv.b * acc[ai][bj][m][1]); if (bj) asm volatile("" ::: "memory"); }
        } else {
#pragma unroll
            for (int ai = 0; ai < 2; ++ai)
#pragma unroll
                for (int m = 0; m < 4; ++m)
#pragma unroll
                    for (int bj = 0; bj < 2; ++bj) { const size_t off = (size_t)(ai * 128 + m * 16) * DM + bj * 128; const F8 gv = unpack8v(*(const u32x4*)(g + off)), tv = unpack8v(*(const u32x4*)(t + off));
                        *(u32x4*)(mo + off) = pack8v(tv.a + gv.a * acc[ai][bj][m][0], tv.b + gv.b * acc[ai][bj][m][1]); if (bj) asm volatile("" ::: "memory"); }
        }
    }
};

__device__ __forceinline__ void tconv_tile(const float* src, int N, int K, int kt, int nt, u16* dst, int mode, float* tile) {
    const int tid = TIDX;
    const int c4 = (tid & 15) * 4;
#pragma unroll
    for (int p = 0; p < 2; ++p) { const int r = (tid >> 4) + 32 * p; const f32x4 v = *(const f32x4*)(src + (size_t)(kt * 64 + r) * N + nt * 64 + c4);
        tile[r * 65 + c4] = v.x; tile[r * 65 + c4 + 1] = v.y; tile[r * 65 + c4 + 2] = v.z; tile[r * 65 + c4 + 3] = v.w; }
    __syncthreads();
    const int n = tid >> 3, k8 = (tid & 7) * 8; float f[8];
#pragma unroll
    for (int j = 0; j < 8; ++j) f[j] = tile[(k8 + j) * 65 + n];
    const int ng = nt * 64 + n; const int drow = mode == 0 ? ng : ((ng >> 7) * 256 + (mode == 2 ? 128 : 0) + (ng & 127));
    *(u32x4*)(dst + (size_t)drow * K + kt * 64 + k8) = pack8(f);
    __syncthreads();
}
__device__ __forceinline__ void conv_matrix(const float* src, int K, int N, u16* dst, int mode, int t, float* tile) {
    const int ntn = N / 64; tconv_tile(src, N, K, t / ntn, t % ntn, dst, mode, tile);
}
__device__ __forceinline__ void norm_rows(const float* sp, const float* ss, const float* gain, B16 dst) {
    const int lane = TIDX & 63, gw = blockIdx.x * 8 + (TIDX >> 6), nw = gridDim.x * 8;
    f32x4 g[4];
#pragma unroll
    for (int i = 0; i < 4; ++i) g[i] = *(const f32x4*)(gain + i * 256 + lane * 4);
    for (int row = gw; row < NTOK; row += nw) {
        const float* src = row < TP ? sp + (size_t)row * DM : ss + (size_t)(row - TP) * DM;
        f32x4 v[4]; float s = 0.f;
#pragma unroll
        for (int i = 0; i < 4; ++i) { v[i] = *(const f32x4*)(src + i * 256 + lane * 4); s += v[i].x * v[i].x + v[i].y * v[i].y + v[i].z * v[i].z + v[i].w * v[i].w; }
        s = wave_sum(s); const float rs = rsqrtf(s * (1.f / DM) + EPSV);
        u16* d = (row < TP ? dst.p + (size_t)row * DM : dst.s + (size_t)(row - TP) * DM);
#pragma unroll
        for (int i = 0; i < 4; ++i) { u32x2 w; w.x = pk(v[i].x * rs * g[i].x, v[i].y * rs * g[i].y); w.y = pk(v[i].z * rs * g[i].z, v[i].w * rs * g[i].w); *(u32x2*)(d + i * 256 + lane * 4) = w; }
    }
}
__device__ __forceinline__ void final_norm(const float* x, const float* gain, float* yp, float* ys) {
    const int lane = TIDX & 63, gw = blockIdx.x * 8 + (TIDX >> 6), nw = gridDim.x * 8;
    f32x4 g[4];
#pragma unroll
    for (int i = 0; i < 4; ++i) g[i] = *(const f32x4*)(gain + i * 256 + lane * 4);
    for (int row = gw; row < NTOK; row += nw) {
        const float* src = x + (size_t)row * DM;
        f32x4 v[4]; float s = 0.f;
#pragma unroll
        for (int i = 0; i < 4; ++i) { v[i] = *(const f32x4*)(src + i * 256 + lane * 4); s += v[i].x * v[i].x + v[i].y * v[i].y + v[i].z * v[i].z + v[i].w * v[i].w; }
        s = wave_sum(s); const float rs = rsqrtf(s * (1.f / DM) + EPSV);
        float* d = row < TP ? yp + (size_t)row * DM : ys + (size_t)(row - TP) * DM;
#pragma unroll
        for (int i = 0; i < 4; ++i) *(f32x4*)(d + i * 256 + lane * 4) = v[i] * rs * g[i];
    }
}

constexpr int L_BL = 0, L_TOT = 32768, L_RED = 34816, L_QE = 35328, L_KE = 52736, L_VT = 70144, L_AM = 88576, L_ST = 97792;
constexpr int QS_ = 136, VS_ = 72;

__device__ __forceinline__ void load_lf_chunk(const u16* lfp, int row0, int h, float* bL) {
    const int tid = TIDX, r = tid >> 3, seg = tid & 7;
    const u16* p = lfp + (size_t)(row0 + r) * DM + h * 128 + seg * 16;
    const u32x4 w0 = *(const u32x4*)p, w1 = *(const u32x4*)(p + 8);
    float* d = bL + r * 128 + seg * 16;
    const unsigned ws[8] = {w0.x, w0.y, w0.z, w0.w, w1.x, w1.y, w1.z, w1.w};
#pragma unroll
    for (int i = 0; i < 8; ++i) { d[2 * i] = h2f((u16)(ws[i] & 0xffffu)); d[2 * i + 1] = h2f((u16)(ws[i] >> 16)); }
}
__device__ __forceinline__ void load_vT(const u16* vp, int row0, int h, u16* vT) {
    const int tid = TIDX, s = tid >> 3, seg = tid & 7;
    const u16* p = vp + (size_t)(row0 + s) * DM + h * 128 + seg * 16;
    const u32x4 w0 = *(const u32x4*)p, w1 = *(const u32x4*)(p + 8);
    const unsigned ws[8] = {w0.x, w0.y, w0.z, w0.w, w1.x, w1.y, w1.z, w1.w};
#pragma unroll
    for (int i = 0; i < 8; ++i) { vT[(seg * 16 + 2 * i) * VS_ + s] = (u16)(ws[i] & 0xffffu); vT[(seg * 16 + 2 * i + 1) * VS_ + s] = (u16)(ws[i] >> 16); }
}

__device__ __forceinline__ void hgrn_h1(const Params& P, unsigned char* sm) {
    float* bL = (float*)(sm + L_BL); float* tot = (float*)(sm + L_TOT); u16* kdT = (u16*)(sm + L_QE); u16* vT = (u16*)(sm + L_VT);
    const u16* lfp = (const u16*)(P.ws + WS_R1); const u16* vp = (const u16*)(P.ws + WS_R2);
    u16* Sb = (u16*)(P.out + O_HS); float* BLg = (float*)(P.ws + WS_BL);
    const int tid = TIDX, lane = tid & 63, w = tid >> 6, fr = lane & 15, fq = lane >> 4;
    for (int item = blockIdx.x; item < 2048; item += gridDim.x) {
        const int h = item & 7, c = (item >> 3) & 31, b = item >> 8; const int row0 = b * SEQ + c * 64;
        const int sidx = (b * 8 + h) * 32 + c;
        load_lf_chunk(lfp, row0, h, bL); load_vT(vp, row0, h, vT);
        __syncthreads();
        const int col = tid & 127, part = tid >> 7; float lf[16]; float run = 0.f;
#pragma unroll
        for (int i = 0; i < 16; ++i) { lf[i] = bL[(part * 16 + i) * 128 + col]; run += lf[i]; }
        tot[part * 128 + col] = run;
        __syncthreads();
        float off = 0.f, bl = 0.f;
#pragma unroll
        for (int p = 0; p < 4; ++p) { const float t = tot[p * 128 + col]; bl += t; if (p < part) off += t; }
        if (part == 0) BLg[(size_t)sidx * 128 + col] = bl;
        float bc = off;
#pragma unroll
        for (int i = 0; i < 16; ++i) { bc += lf[i]; const float kd = (1.f - __expf(lf[i])) * __expf(bl - bc); kdT[col * VS_ + part * 16 + i] = f2b(kd); }
        __syncthreads();
        bf16x8 av[2];
#pragma unroll
        for (int ks = 0; ks < 2; ++ks) av[ks] = *(const bf16x8*)(vT + (16 * w + fr) * VS_ + ks * 32 + 8 * fq);
        u16* so = Sb + (size_t)sidx * 16384 + (16 * w + fr) * 128 + 4 * fq;
#pragma unroll
        for (int nt = 0; nt < 8; ++nt) {
            f32x4 acc = (f32x4){0.f, 0.f, 0.f, 0.f};
#pragma unroll
            for (int ks = 0; ks < 2; ++ks) { const bf16x8 bk = *(const bf16x8*)(kdT + (16 * nt + fr) * VS_ + ks * 32 + 8 * fq); acc = __builtin_amdgcn_mfma_f32_16x16x32_bf16(bk, av[ks], acc, 0, 0, 0); }
            u32x2 o; o.x = pk(acc.x, acc.y); o.y = pk(acc.z, acc.w); *(u32x2*)(so + 16 * nt) = o;
        }
        __syncthreads();
    }
}
__device__ __forceinline__ void hgrn_h2(const Params& P) {
    u16* Sb = (u16*)(P.out + O_HS); const float* BLg = (const float*)(P.ws + WS_BL); float* hp = P.out + O_HP;
    for (int g = blockIdx.x * 512 + TIDX; g < 64 * 2048; g += gridDim.x * 512) {
        const int bh = g >> 11, e = (g & 2047) * 8, dv = e >> 7, dk = e & 127;
        float S[8];
#pragma unroll
        for (int j = 0; j < 8; ++j) S[j] = 0.f;
        u16* sp = Sb + (size_t)bh * 32 * 16384 + e; const float* blp = BLg + (size_t)bh * 32 * 128 + dk;
#pragma unroll 4
        for (int c = 0; c < 32; ++c) {
            const u32x4 lw = *(const u32x4*)(sp + (size_t)c * 16384); const f32x4 d0 = *(const f32x4*)(blp + c * 128), d1 = *(const f32x4*)(blp + c * 128 + 4);
            float sl[8]; unpack8(lw, sl);
            *(u32x4*)(sp + (size_t)c * 16384) = pack8(S);
            const float dd[8] = {d0.x, d0.y, d0.z, d0.w, d1.x, d1.y, d1.z, d1.w};
#pragma unroll
            for (int j = 0; j < 8; ++j) S[j] = __expf(dd[j]) * S[j] + sl[j];
        }
        float* o = hp + (size_t)bh * 16384 + dv;
#pragma unroll
        for (int j = 0; j < 8; ++j) o[(size_t)(dk + j) * 128] = S[j];
    }
}
__device__ __forceinline__ void hgrn_h3(const Params& P, unsigned char* sm) {
    float* bL = (float*)(sm + L_BL); float* tot = (float*)(sm + L_TOT); float* red = (float*)(sm + L_RED);
    u16* qe = (u16*)(sm + L_QE); u16* ke = (u16*)(sm + L_KE); u16* vT = (u16*)(sm + L_VT); u16* Am = (u16*)(sm + L_AM); u16* ST = (u16*)(sm + L_ST);
    const u16* qsp = (const u16*)(P.ws + WS_R0); const u16* lfp = (const u16*)(P.ws + WS_R1); const u16* vp = (const u16*)(P.ws + WS_R2);
    u16* gsp = (u16*)(P.out + O_YP);
    const u16* Sb = (const u16*)(P.out + O_HS); const float* onorm = P.in[12];
    const int tid = TIDX, lane = tid & 63, w = tid >> 6, fr = lane & 15, fq = lane >> 4;
    for (int item = blockIdx.x; item < 2048; item += gridDim.x) {
        const int h = item & 7, c = (item >> 3) & 31, b = item >> 8; const int row0 = b * SEQ + c * 64;
        const int sidx = (b * 8 + h) * 32 + c;
        load_lf_chunk(lfp, row0, h, bL); load_vT(vp, row0, h, vT);
        { const u16* sp = Sb + (size_t)sidx * 16384;
#pragma unroll
          for (int p = 0; p < 4; ++p) { const int idx = tid + 512 * p, dv = idx >> 4, k8 = (idx & 15) * 8; *(u32x4*)(ST + dv * QS_ + k8) = *(const u32x4*)(sp + dv * 128 + k8); } }
        __syncthreads();
        const int col = tid & 127, part = tid >> 7; float lf[16]; float run = 0.f;
#pragma unroll
        for (int i = 0; i < 16; ++i) { lf[i] = bL[(part * 16 + i) * 128 + col]; run += lf[i]; }
        tot[part * 128 + col] = run;
        __syncthreads();
        float off = 0.f;
#pragma unroll
        for (int p = 0; p < 4; ++p) { const float t = tot[p * 128 + col]; if (p < part) off += t; }
        float bc = off; const u16* qp = qsp + (size_t)(row0 + part * 16) * DM + h * 128 + col;
#pragma unroll
        for (int i = 0; i < 16; ++i) { bc += lf[i]; const float q = b2f(qp[(size_t)i * DM]);
            qe[(part * 16 + i) * QS_ + col] = f2b(q * __expf(bc)); ke[(part * 16 + i) * QS_ + col] = f2b((1.f - __expf(lf[i])) * __expf(-bc)); }
        __syncthreads();
        {
            const int mt = w & 3;
            bf16x8 aq[4];
#pragma unroll
            for (int ks = 0; ks < 4; ++ks) aq[ks] = *(const bf16x8*)(qe + (16 * mt + fr) * QS_ + ks * 32 + 8 * fq);
#pragma unroll
            for (int t = 0; t < 2; ++t) { const int nt = (w >> 2) * 2 + t; f32x4 acc = (f32x4){0.f, 0.f, 0.f, 0.f};
#pragma unroll
                for (int ks = 0; ks < 4; ++ks) { const bf16x8 bk = *(const bf16x8*)(ke + (16 * nt + fr) * QS_ + ks * 32 + 8 * fq); acc = __builtin_amdgcn_mfma_f32_16x16x32_bf16(bk, aq[ks], acc, 0, 0, 0); }
                const int cr = 16 * mt + fr, s0 = 16 * nt + 4 * fq;
                u32x2 o; o.x = pk(cr >= s0 ? acc.x : 0.f, cr >= s0 + 1 ? acc.y : 0.f); o.y = pk(cr >= s0 + 2 ? acc.z : 0.f, cr >= s0 + 3 ? acc.w : 0.f);
                *(u32x2*)(Am + cr * VS_ + s0) = o; }
        }
        __syncthreads();
        {
            const int mt = w & 3, nh = w >> 2;
            bf16x8 aq[4], aa[2];
#pragma unroll
            for (int ks = 0; ks < 4; ++ks) aq[ks] = *(const bf16x8*)(qe + (16 * mt + fr) * QS_ + ks * 32 + 8 * fq);
#pragma unroll
            for (int ks = 0; ks < 2; ++ks) aa[ks] = *(const bf16x8*)(Am + (16 * mt + fr) * VS_ + ks * 32 + 8 * fq);
            f32x4 acc[4]; float ssq = 0.f;
#pragma unroll
            for (int t = 0; t < 4; ++t) { const int dt = nh * 4 + t; acc[t] = (f32x4){0.f, 0.f, 0.f, 0.f};
#pragma unroll
                for (int ks = 0; ks < 4; ++ks) { const bf16x8 bk = *(const bf16x8*)(ST + (16 * dt + fr) * QS_ + ks * 32 + 8 * fq); acc[t] = __builtin_amdgcn_mfma_f32_16x16x32_bf16(bk, aq[ks], acc[t], 0, 0, 0); }
#pragma unroll
                for (int ks = 0; ks < 2; ++ks) { const bf16x8 bk = *(const bf16x8*)(vT + (16 * dt + fr) * VS_ + ks * 32 + 8 * fq); acc[t] = __builtin_amdgcn_mfma_f32_16x16x32_bf16(bk, aa[ks], acc[t], 0, 0, 0); }
                ssq += acc[t].x * acc[t].x + acc[t].y * acc[t].y + acc[t].z * acc[t].z + acc[t].w * acc[t].w; }
            ssq += __shfl_xor(ssq, 16, 64); ssq += __shfl_xor(ssq, 32, 64);
            if (fq == 0) red[(16 * mt + fr) * 2 + nh] = ssq;
            __syncthreads();
            const int cr = 16 * mt + fr; const float rinv = rsqrtf((red[cr * 2] + red[cr * 2 + 1]) * (1.f / 128.f) + EPSV);
            u16* gp = gsp + (size_t)(row0 + cr) * DM + h * 128;
#pragma unroll
            for (int t = 0; t < 4; ++t) { const int dv = 16 * (nh * 4 + t) + 4 * fq; const u32x2 gw = *(const u32x2*)(gp + dv); const f32x4 on = *(const f32x4*)(onorm + h * 128 + dv);
                u32x2 o; o.x = pk(acc[t].x * rinv * on.x * blo(gw.x), acc[t].y * rinv * on.y * bhi(gw.x)); o.y = pk(acc[t].z * rinv * on.z * blo(gw.y), acc[t].w * rinv * on.w * bhi(gw.y));
                *(u32x2*)(gp + dv) = o; }
        }
        __syncthreads();
    }
}
__device__ __forceinline__ void hgrn_sample(const Params& P, unsigned char* sm) {
    float* red = (float*)sm;
    float* sq = red + 16 * 128;
    float* sf = sq + 128; float* sk = sf + 128; float* sv = sk + 128; float* so = sv + 128; float* sr = so + 128;
    const u16* qss = (const u16*)(P.ws + WS_SIDE + 1 * SSLOT); const u16* lfs = (const u16*)(P.ws + WS_SIDE + 2 * SSLOT); const u16* vs = (const u16*)(P.ws + WS_SIDE + 3 * SSLOT);
    u16* gss = (u16*)(P.ws + WS_SIDE + 4 * SSLOT);
    const float* S0 = P.in[2]; float* Sn = P.out + O_HS; const float* onorm = P.in[12];
    const int tid = TIDX;
    for (int item = blockIdx.x; item < 1024; item += gridDim.x) {
        const int b = item >> 3, h = item & 7;
        if (tid < 128) { const int c = h * 128 + tid; const float lfv = h2f(lfs[(size_t)b * DM + c]); const float f = __expf(lfv);
            sq[tid] = b2f(qss[(size_t)b * DM + c]); sf[tid] = f; sk[tid] = 1.f - f; sv[tid] = b2f(vs[(size_t)b * DM + c]); }
        __syncthreads();
        const int dv4 = (tid & 31) * 4, dkg = tid >> 5;
        const f32x4 vv = *(const f32x4*)(sv + dv4); f32x4 oacc = (f32x4){0.f, 0.f, 0.f, 0.f};
        const size_t base = ((size_t)(b * 8 + h)) * 16384;
#pragma unroll
        for (int i = 0; i < 8; ++i) { const int dk = dkg * 8 + i; const f32x4 s0 = *(const f32x4*)(S0 + base + dk * 128 + dv4);
            const f32x4 sn = sf[dk] * s0 + sk[dk] * vv; *(f32x4*)(Sn + base + dk * 128 + dv4) = sn; oacc += sq[dk] * sn; }
        *(f32x4*)(red + dkg * 128 + dv4) = oacc;
        __syncthreads();
        if (tid < 128) { float o = 0.f;
#pragma unroll
            for (int g = 0; g < 16; ++g) o += red[g * 128 + tid];
            so[tid] = o; const float s2 = wave_sum(o * o); if ((tid & 63) == 0) sr[tid >> 6] = s2; }
        __syncthreads();
        if (tid < 128) { const float rinv = rsqrtf((sr[0] + sr[1]) * (1.f / 128.f) + EPSV); const int c = h * 128 + tid;
            const float g = b2f(gss[(size_t)b * DM + c]); gss[(size_t)b * DM + c] = f2b(so[tid] * rinv * onorm[c] * g); }
        __syncthreads();
    }
}
__device__ __forceinline__ void conv_phase(const Params& P) {
    const u16* xrp = (const u16*)(P.ws + WS_R0); const u16* xrs = (const u16*)(P.ws + WS_SIDE + 5 * SSLOT);
    u16* xcp = (u16*)(P.ws + WS_R2); u16* xcs = (u16*)(P.ws + WS_SIDE + 7 * SSLOT);
    const float* cw = P.in[13]; const float* cb = P.in[14]; const float* sc = P.in[4];
    float* cpo = P.out + O_CP; float* cso = P.out + O_CS;
    const int tid = TIDX, ch = (tid & 127) * 8;
    float w0[8], w1[8], w2[8], w3[8], bb[8];
#pragma unroll
    for (int j = 0; j < 8; ++j) { w0[j] = cw[ch + j]; w1[j] = cw[1024 + ch + j]; w2[j] = cw[2048 + ch + j]; w3[j] = cw[3072 + ch + j]; bb[j] = cb[ch + j]; }
    for (int rg = blockIdx.x; rg < NTOK / 4; rg += gridDim.x) {
        const int row = rg * 4 + (tid >> 7);
        float x0[8], x1[8], x2[8], x3[8];
        if (row < TP) {
            const int t = row & (SEQ - 1); const u16* p = xrp + (size_t)row * DM + ch;
            unpack8(*(const u32x4*)p, x0);
            if (t >= 1) unpack8(*(const u32x4*)(p - DM), x1); else { for (int j = 0; j < 8; ++j) x1[j] = 0.f; }
            if (t >= 2) unpack8(*(const u32x4*)(p - 2 * DM), x2); else { for (int j = 0; j < 8; ++j) x2[j] = 0.f; }
            if (t >= 3) unpack8(*(const u32x4*)(p - 3 * DM), x3); else { for (int j = 0; j < 8; ++j) x3[j] = 0.f; }
            if (t >= SEQ - 3) { float* o = cpo + ((size_t)(row >> 11) * 3 + (t - (SEQ - 3))) * DM + ch; *(f32x4*)o = (f32x4){x0[0], x0[1], x0[2], x0[3]}; *(f32x4*)(o + 4) = (f32x4){x0[4], x0[5], x0[6], x0[7]}; }
        } else {
            const int b = row - TP; unpack8(*(const u32x4*)(xrs + (size_t)b * DM + ch), x0);
            const float* s = sc + (size_t)b * 3 * DM + ch;
#pragma unroll
            for (int j = 0; j < 8; ++j) { x3[j] = s[j]; x2[j] = s[DM + j]; x1[j] = s[2 * DM + j]; }
            float* o = cso + (size_t)b * 3 * DM + ch;
#pragma unroll
            for (int j = 0; j < 8; ++j) { o[j] = x2[j]; o[DM + j] = x1[j]; o[2 * DM + j] = x0[j]; }
        }
        float y[8];
#pragma unroll
        for (int j = 0; j < 8; ++j) y[j] = bb[j] + w3[j] * x0[j] + w2[j] * x1[j] + w1[j] * x2[j] + w0[j] * x3[j];
        u16* d = row < TP ? xcp + (size_t)row * DM + ch : xcs + (size_t)(row - TP) * DM + ch;
        *(u32x4*)d = pack8(y);
    }
}
__device__ __forceinline__ void lru_pass1(const Params& P) {
    const unsigned* la = (const unsigned*)(P.ws + WS_R2); const unsigned* bt = (const unsigned*)(P.ws + WS_R0); f32x4* agg = (f32x4*)(P.ws + WS_AGG);
    const int cp = TIDX;
    for (int item = blockIdx.x; item < 256; item += gridDim.x) {
        const size_t r0 = (size_t)item * 64;
        float P0 = 1.f, P1 = 1.f, H0 = 0.f, H1 = 0.f;
#pragma unroll 8
        for (int r = 0; r < 64; ++r) { const unsigned lw = la[(r0 + r) * 512 + cp], bw = bt[(r0 + r) * 512 + cp];
            const float a0 = __expf(blo(lw)), a1 = __expf(bhi(lw)); H0 = a0 * H0 + blo(bw); H1 = a1 * H1 + bhi(bw); P0 *= a0; P1 *= a1; }
        agg[(size_t)item * 512 + cp] = (f32x4){P0, H0, P1, H1};
    }
}
__device__ __forceinline__ void lru_pass2(const Params& P) {
    const unsigned* la = (const unsigned*)(P.ws + WS_R2); const unsigned* bt = (const unsigned*)(P.ws + WS_R0); unsigned* yg = (unsigned*)(P.ws + WS_R1); const f32x4* agg = (const f32x4*)(P.ws + WS_AGG);
    float* lpo = P.out + O_LP;
    const int cp = TIDX;
    for (int item = blockIdx.x; item < 256; item += gridDim.x) {
        const int b = item >> 5, c = item & 31; const size_t r0 = (size_t)item * 64;
        float h0 = 0.f, h1 = 0.f;
        for (int cc = 0; cc < c; ++cc) { const f32x4 g = agg[(size_t)(b * 32 + cc) * 512 + cp]; h0 = g.x * h0 + g.y; h1 = g.z * h1 + g.w; }
#pragma unroll 8
        for (int r = 0; r < 64; ++r) { const size_t ix = (r0 + r) * 512 + cp; const unsigned lw = la[ix], bw = bt[ix], yw = yg[ix];
            h0 = __expf(blo(lw)) * h0 + blo(bw); h1 = __expf(bhi(lw)) * h1 + bhi(bw); yg[ix] = pk(h0 * blo(yw), h1 * bhi(yw)); }
        if (c == 31) { lpo[b * DM + 2 * cp] = h0; lpo[b * DM + 2 * cp + 1] = h1; }
    }
    const unsigned* las = (const unsigned*)(P.ws + WS_SIDE + 7 * SSLOT); const unsigned* bts = (const unsigned*)(P.ws + WS_SIDE + 5 * SSLOT); unsigned* ygs = (unsigned*)(P.ws + WS_SIDE + 6 * SSLOT);
    const float* hl = P.in[3]; float* lso = P.out + O_LS;
    for (int b = blockIdx.x; b < TS; b += gridDim.x) {
        const size_t ix = (size_t)b * 512 + cp; const unsigned lw = las[ix], bw = bts[ix], yw = ygs[ix];
        const float h0 = __expf(blo(lw)) * hl[b * DM + 2 * cp] + blo(bw), h1 = __expf(bhi(lw)) * hl[b * DM + 2 * cp + 1] + bhi(bw);
        ygs[ix] = pk(h0 * blo(yw), h1 * bhi(yw)); lso[b * DM + 2 * cp] = h0; lso[b * DM + 2 * cp + 1] = h1;
    }
}

#define GSYNC() do { asm volatile("s_waitcnt vmcnt(0) lgkmcnt(0)" ::: "memory"); grid.sync(); } while (0)
#ifndef STOP_AT
#define STOP_AT 99
#endif
__device__ __forceinline__ void dumpcp(const unsigned char* src, unsigned char* dst, size_t bytes) {
    for (size_t i = ((size_t)blockIdx.x * 512 + threadIdx.x) * 16; i < bytes; i += (size_t)gridDim.x * 512 * 16) *(u32x4*)(dst + i) = *(const u32x4*)(src + i);
}
#define STOPCHK(n) do { if (STOP_AT == (n)) { if ((n) == 4) { dumpcp(P.ws + WS_R0, (unsigned char*)(P.out + O_HS), 2 * SLOT); dumpcp(P.ws + WS_R2, (unsigned char*)P.out + SLOT, SLOT); }  if ((n) == 2 || (n) == 14) { DEF_PTRS final_norm(X1, P.in[27], P.out + O_YP, P.out + O_YS); } return; } } while (0)
#define DEF_PTRS \
    unsigned char* ws = opq(P.ws); unsigned char* ob = opq((unsigned char*)P.out); (void)ob; \
    u16* Wgu = (u16*)(ws + WS_WGU); u16* Wd = (u16*)(ws + WS_WD); u16* Win = (u16*)(ws + WS_WIN); u16* Wbd = (u16*)(ws + WS_WBD); \
    u16* Waup = (u16*)(ws + WS_WAUP); u16* Wbup = (u16*)(ws + WS_WBUP); u16* Wout = (u16*)(ws + WS_WOUT); \
    float* X1 = (float*)(ws + WS_X1); float* LBv = (float*)(ws + WS_LB); float* LCv = (float*)(ws + WS_LC); \
    const B16 HN = {(u16*)(ws + WS_HN), (u16*)(ws + WS_SIDE + 0 * SSLOT)}; \
    const B16 QS = {(u16*)(ws + WS_R0), (u16*)(ws + WS_SIDE + 1 * SSLOT)}; \
    const B16 LF = {(u16*)(ws + WS_R1), (u16*)(ws + WS_SIDE + 2 * SSLOT)}; \
    const B16 VV = {(u16*)(ws + WS_R2), (u16*)(ws + WS_SIDE + 3 * SSLOT)}; \
    const B16 GS = {(u16*)(ob + O_YP * 4), (u16*)(ws + WS_SIDE + 4 * SSLOT)}; \
    const B16 XR = {(u16*)(ws + WS_R0), (u16*)(ws + WS_SIDE + 5 * SSLOT)}; \
    const B16 YG = {(u16*)(ws + WS_R1), (u16*)(ws + WS_SIDE + 6 * SSLOT)}; \
    const B16 XC = {(u16*)(ws + WS_R2), (u16*)(ws + WS_SIDE + 7 * SSLOT)}; \
    const B16 TA = {(u16*)(ws + WS_R0), (u16*)(ws + WS_SIDE + 8 * SSLOT)}; \
    const B16 GT = {(u16*)(ws + WS_R2), (u16*)(ws + WS_SIDE + 9 * SSLOT)}; \
    const B16 MB = {(u16*)(ob + O_YP * 4) + (size_t)TP * DM, (u16*)(ws + WS_SIDE + 10 * SSLOT)}; \
    const B16 ACT = {(u16*)(ws + WS_R0), (u16*)(ws + WS_ACTS)}; \
    (void)Wgu; (void)Wd; (void)Win; (void)Wbd; (void)Waup; (void)Wbup; (void)Wout; (void)X1; (void)LBv; (void)LCv; \
    (void)HN; (void)QS; (void)LF; (void)VV; (void)GS; (void)XR; (void)YG; (void)XC; (void)TA; (void)GT; (void)MB; (void)ACT;

__global__ void __launch_bounds__(512, 2) mega(Params P) {
    extern __shared__ __attribute__((aligned(16))) unsigned char shm[];
    cg::grid_group grid = cg::this_grid();
    LAS unsigned char* lds = (LAS unsigned char*)shm;
    const int G = gridDim.x, cblk = blockIdx.x;

    {
        DEF_PTRS
        float* tile = (float*)shm;
        for (int t = cblk; t < 4928; t += G) {
            if (t < 704) conv_matrix(P.in[6], 1024, 2816, Wgu, 1, t, tile);
            else if (t < 1408) conv_matrix(P.in[7], 1024, 2816, Wgu, 2, t - 704, tile);
            else if (t < 2112) conv_matrix(P.in[8], 2816, 1024, Wd, 0, t - 1408, tile);
            else if (t < 4160) conv_matrix(P.in[10], 1024, 8192, Win, 0, t - 2112, tile);
            else if (t < 4416) conv_matrix(P.in[20], 1024, 1024, Waup, 0, t - 4160, tile);
            else if (t < 4672) conv_matrix(P.in[21], 1024, 1024, Wbup, 0, t - 4416, tile);
            else conv_matrix(P.in[22], 1024, 1024, Wout, 0, t - 4672, tile);
        }
        for (int idx = cblk * 512 + TIDX; idx < 8 * 256 * 256; idx += G * 512) {
            const int n = idx >> 16, row = (idx >> 8) & 255, kk = idx & 255, bj = row >> 7, d = row & 127;
            float v = 0.f; if ((kk >> 7) == (n & 1)) v = (bj ? P.in[17] : P.in[15])[(size_t)n * 16384 + (kk & 127) * 128 + d];
            Wbd[idx] = f2b(v);
        }
        if (cblk == 0) { for (int c = TIDX; c < 1024; c += 512) { LBv[c] = 1.f / (1.f + __expf(P.in[11][1024 + c] - P.in[11][c])); LCv[c] = -8.f * log1pf(__expf(-P.in[19][c])); } }
        norm_rows(P.in[0], P.in[1], P.in[5], HN);
    }
    GSYNC(); STOPCHK(0);
    { DEF_PTRS SchedSimple S{HN.p, HN.s, Wgu, DM, DM, 22, G, cblk, 0}; EpiGU E{ACT}; gemm_phase(lds, DM, DM, S, E); }
    GSYNC(); STOPCHK(1);
    { DEF_PTRS SchedSimple S{ACT.p, ACT.s, Wd, DFF, DFF, 4, G, cblk, 0}; EpiRes E{P.in[0], P.in[1], TS, X1, 0.5f}; gemm_phase(lds, DFF, DFF, S, E); }
    GSYNC(); STOPCHK(2);
    {
        DEF_PTRS
        float* tile = (float*)shm;
        for (int t = cblk; t < 2112; t += G) {
            if (t < 704) conv_matrix(P.in[24], 1024, 2816, Wgu, 1, t, tile);
            else if (t < 1408) conv_matrix(P.in[25], 1024, 2816, Wgu, 2, t - 704, tile);
            else conv_matrix(P.in[26], 2816, 1024, Wd, 0, t - 1408, tile);
        }
        norm_rows(X1, X1 + (size_t)TP * DM, P.in[9], HN);
    }
    GSYNC(); STOPCHK(3);
    { DEF_PTRS SchedSimple S{HN.p, HN.s, Win, DM, DM, 16, G, cblk, 0}; EpiInA E{QS, LF, VV, GS, LBv}; gemm_phase(lds, DM, DM, S, E); }
    GSYNC(); STOPCHK(4);
    hgrn_h1(P, shm);
    GSYNC(); STOPCHK(5);
    hgrn_h2(P);
    GSYNC(); STOPCHK(6);
    hgrn_h3(P, shm);
    GSYNC(); STOPCHK(7);
    { DEF_PTRS SchedSimple S{HN.p, HN.s, Win + (size_t)4096 * DM, DM, DM, 8, G, cblk, 0}; EpiInB E{XR, YG}; gemm_phase(lds, DM, DM, S, E); }
    GSYNC(); STOPCHK(8);
    conv_phase(P); hgrn_sample(P, shm);
    GSYNC(); STOPCHK(9);
    { DEF_PTRS SchedSimple S{XC.p, XC.s, Wbd, DM, 256, 8, G, cblk, 256}; EpiBD E{XC, XR, P.in[16], P.in[18], LCv}; gemm_phase(lds, 256, DM, S, E); }
    GSYNC(); STOPCHK(10);
    lru_pass1(P);
    GSYNC(); STOPCHK(11);
    lru_pass2(P);
    GSYNC(); STOPCHK(12);
    { DEF_PTRS SchedMerge S{HN, GS, YG, Win, Waup, Wbup, G, cblk}; EpiMerge E{GT, TA, MB}; gemm_phase(lds, DM, DM, S, E); }
    GSYNC(); STOPCHK(13);
    { DEF_PTRS SchedSimple S{MB.p, MB.s, Wout, DM, DM, 4, G, cblk, 0}; EpiRes E{X1, X1 + (size_t)TP * DM, 256, X1, 1.0f}; gemm_phase(lds, DM, DM, S, E); }
    GSYNC(); STOPCHK(14);
    { DEF_PTRS norm_rows(X1, X1 + (size_t)TP * DM, P.in[23], HN); }
    GSYNC(); STOPCHK(15);
    { DEF_PTRS SchedSimple S{HN.p, HN.s, Wgu, DM, DM, 22, G, cblk, 0}; EpiGU E{ACT}; gemm_phase(lds, DM, DM, S, E); }
    GSYNC(); STOPCHK(16);
    { DEF_PTRS SchedSimple S{ACT.p, ACT.s, Wd, DFF, DFF, 4, G, cblk, 0}; EpiRes E{X1, X1 + (size_t)TP * DM, 256, X1, 0.5f}; gemm_phase(lds, DFF, DFF, S, E); }
    GSYNC(); STOPCHK(17);
    { DEF_PTRS final_norm(X1, P.in[27], P.out + O_YP, P.out + O_YS); }
}

extern "C" void kernel_launch(void* const* d_in, const int* in_sizes, int n_in, void* d_out, int out_size, void* d_ws, size_t ws_size, hipStream_t stream) {
    static int grid = 0;
    if (grid == 0) {
        int dev = 0, cus = 0, per_cu = 0;
        if (n_in != 28 || ws_size < WS_END) { fprintf(stderr, "kernel_launch: unexpected n_in %d / ws_size %zu (need %zu)\n", n_in, ws_size, (size_t)WS_END); grid = -1; return; }
        (void)hipGetDevice(&dev); (void)hipDeviceGetAttribute(&cus, hipDeviceAttributeMultiprocessorCount, dev);
        if (hipFuncSetAttribute((const void*)mega, hipFuncAttributeMaxDynamicSharedMemorySize, LDS_BYTES) != hipSuccess) { fprintf(stderr, "kernel_launch: hipFuncSetAttribute failed\n"); grid = -1; return; }
        if (hipOccupancyMaxActiveBlocksPerMultiprocessor(&per_cu, (const void*)mega, 512, LDS_BYTES) != hipSuccess || per_cu < 1) { fprintf(stderr, "kernel_launch: occupancy query gave %d\n", per_cu); per_cu = 1; (void)hipGetLastError(); }
        grid = cus * 1;
    }
    if (grid < 0) return;
    Params p{};
    for (int i = 0; i < 28; ++i) p.in[i] = (const float*)d_in[i];
    p.out = (float*)d_out; p.ws = (unsigned char*)d_ws;
    void* args[] = {&p};
    hipError_t e = hipLaunchCooperativeKernel((void*)mega, dim3(grid), dim3(512), args, LDS_BYTES, stream);
    if (e != hipSuccess) fprintf(stderr, "cooperative launch failed: %s (grid %d)\n", hipGetErrorString(e), grid);
}
```

```cpp
#include <hip/hip_runtime.h>
#include <hip/hip_cooperative_groups.h>
#include <cstdio>
namespace cg = cooperative_groups;

#define LAS __attribute__((address_space(3)))
typedef unsigned short u16;
typedef short bf16x8 __attribute__((ext_vector_type(8)));
typedef float f32x4 __attribute__((ext_vector_type(4)));
typedef unsigned u32x4 __attribute__((ext_vector_type(4)));
typedef unsigned u32x2 __attribute__((ext_vector_type(2)));

constexpr int TP = 16384, TS = 128, NTOK = TP + TS, DM = 1024, DFF = 2816, SEQ = 2048;
constexpr float EPSV = 1e-6f;
constexpr int LDS_BYTES = 147456;

constexpr size_t SLOT = (size_t)TP * DM * 2;
constexpr size_t SSLOT = (size_t)256 * DM * 2;
constexpr size_t WS_WGU = 0;
constexpr size_t WS_WD = WS_WGU + (size_t)5632 * 1024 * 2;
constexpr size_t WS_WIN = WS_WD + (size_t)1024 * 2816 * 2;
constexpr size_t WS_WBD = WS_WIN + (size_t)8192 * 1024 * 2;
constexpr size_t WS_WAUP = WS_WBD + (size_t)8 * 256 * 256 * 2;
constexpr size_t WS_WBUP = WS_WAUP + (size_t)1024 * 1024 * 2;
constexpr size_t WS_WOUT = WS_WBUP + (size_t)1024 * 1024 * 2;
constexpr size_t WS_X1 = WS_WOUT + (size_t)1024 * 1024 * 2;
constexpr size_t WS_HN = WS_X1 + (size_t)16640 * DM * 4;
constexpr size_t WS_R0 = WS_HN + SLOT;
constexpr size_t WS_R1 = WS_R0 + SLOT;
constexpr size_t WS_R2 = WS_R1 + SLOT;
constexpr size_t WS_SIDE = WS_R2 + SLOT;
constexpr size_t WS_ACTS = WS_SIDE + 11 * SSLOT;
constexpr size_t WS_BL = WS_ACTS + (size_t)256 * DFF * 2;
constexpr size_t WS_AGG = WS_BL + (size_t)2048 * 128 * 4;
constexpr size_t WS_LB = WS_AGG + (size_t)256 * 1024 * 8;
constexpr size_t WS_LC = WS_LB + 4096;
constexpr size_t WS_BAR = WS_LC + 4096;
constexpr size_t WS_END = WS_BAR + 16384;
static_assert(WS_END <= (size_t)268435456, "workspace too large");
constexpr size_t O_YP = 0, O_YS = 16777216, O_HP = 16908288, O_LP = 17956864, O_CP = 17965056, O_HS = 17989632, O_LS = 34766848, O_CS = 34897920;

struct Params { const float* in[28]; float* out; unsigned char* ws; };
struct B16 { u16* p; u16* s; };

typedef __bf16 bf16x2_t __attribute__((ext_vector_type(2)));
typedef float f32x2_t __attribute__((ext_vector_type(2)));
__device__ __forceinline__ unsigned pk(float lo, float hi) { const f32x2_t v = {lo, hi}; const bf16x2_t b = __builtin_convertvector(v, bf16x2_t); return __builtin_bit_cast(unsigned, b); }
__device__ __forceinline__ float blo(unsigned w) { return __uint_as_float(w << 16); }
__device__ __forceinline__ float bhi(unsigned w) { return __uint_as_float(w & 0xffff0000u); }
__device__ __forceinline__ float b2f(u16 b) { return __uint_as_float(((unsigned)b) << 16); }
__device__ __forceinline__ u16 f2b(float f) { return (u16)(pk(f, 0.f) & 0xffffu); }
__device__ __forceinline__ float sigm(float x) { return 1.f / (1.f + __expf(-x)); }
__device__ __forceinline__ float silu(float x) { return x / (1.f + __expf(-x)); }
__device__ __forceinline__ float gelu_t(float x) { const float u = 0.7978845608028654f * (x + 0.044715f * x * x * x); return x / (1.f + __expf(-2.f * u)); }
__device__ __forceinline__ unsigned pkh(float lo, float hi) { const _Float16 a = (_Float16)lo, b = (_Float16)hi; return (unsigned)__builtin_bit_cast(u16, a) | ((unsigned)__builtin_bit_cast(u16, b) << 16); }
__device__ __forceinline__ float h2f(u16 h) { return (float)__builtin_bit_cast(_Float16, h); }
__device__ __forceinline__ u32x4 pack8(const float* o) { u32x4 r; r.x = pk(o[0], o[1]); r.y = pk(o[2], o[3]); r.z = pk(o[4], o[5]); r.w = pk(o[6], o[7]); return r; }
__device__ __forceinline__ void unpack8(u32x4 w, float* o) { o[0] = blo(w.x); o[1] = bhi(w.x); o[2] = blo(w.y); o[3] = bhi(w.y); o[4] = blo(w.z); o[5] = bhi(w.z); o[6] = blo(w.w); o[7] = bhi(w.w); }
__device__ __forceinline__ unsigned char* opq(unsigned char* p) { asm volatile("" : "+s"(p)); return p; }
__device__ __forceinline__ int opqv(int v) { asm volatile("" : "+v"(v)); return v; }
#define TIDX opqv((int)threadIdx.x)
struct F8 { f32x4 a, b; };
__device__ __forceinline__ F8 unpack8v(u32x4 w) { F8 r; r.a = (f32x4){blo(w.x), bhi(w.x), blo(w.y), bhi(w.y)}; r.b = (f32x4){blo(w.z), bhi(w.z), blo(w.w), bhi(w.w)}; return r; }
__device__ __forceinline__ u32x4 pack8v(f32x4 a, f32x4 b) { u32x4 r; r.x = pk(a.x, a.y); r.y = pk(a.z, a.w); r.z = pk(b.x, b.y); r.w = pk(b.z, b.w); return r; }
__device__ __forceinline__ u32x4 pack8h(f32x4 a, f32x4 b) { u32x4 r; r.x = pkh(a.x, a.y); r.y = pkh(a.z, a.w); r.z = pkh(b.x, b.y); r.w = pkh(b.z, b.w); return r; }
__device__ __forceinline__ f32x4 sig4(f32x4 v) { return (f32x4){sigm(v.x), sigm(v.y), sigm(v.z), sigm(v.w)}; }
__device__ __forceinline__ f32x4 silu4(f32x4 v) { return (f32x4){silu(v.x), silu(v.y), silu(v.z), silu(v.w)}; }
__device__ __forceinline__ f32x4 gelu4(f32x4 v) { return (f32x4){gelu_t(v.x), gelu_t(v.y), gelu_t(v.z), gelu_t(v.w)}; }
__device__ __forceinline__ f32x4 log4(f32x4 v) { return (f32x4){__logf(v.x), __logf(v.y), __logf(v.z), __logf(v.w)}; }
__device__ __forceinline__ float wave_sum(float v) {
#pragma unroll
    for (int o = 32; o >= 1; o >>= 1) v += __shfl_xor(v, o, 64);
    return v;
}

constexpr int BM = 256, BK = 64, HALF = 128, HTB = HALF * BK * 2;
__device__ __forceinline__ int lds_byte(int r, int c) { const int st = (r >> 4) * 2 + (c >> 5), rr = r & 15, cc = c & 31, ob = rr * 64 + cc * 2; return st * 1024 + (ob ^ (((ob >> 9) & 1) << 5)); }
__device__ __forceinline__ void stage_rc(int b, int& R, int& C) { const int st = b / 1024, sb = b % 1024, swz = sb ^ (((sb >> 9) & 1) << 5); R = (st >> 1) * 16 + swz / 64; C = (st & 1) * 32 + (swz % 64) / 2; }
__device__ __forceinline__ int perm32(int rho) { const int n = rho >> 4, i = rho & 15; return 8 * (i >> 2) + 4 * n + (i & 3); }

struct Unit { int pm, pn, sub; const char* a; const char* b; };

__device__ __forceinline__ bool tile_of(long L, int nM, int nN, int& pm, int& pn) {
    const int nwg = nM * nN; if (L >= nwg) return false;
    int wgid = (int)L; { const int q = nwg / 8, r = nwg % 8, xcd = wgid % 8, off = wgid / 8; wgid = (xcd < r ? xcd * (q + 1) : r * (q + 1) + (xcd - r) * q) + off; }
    const int nig = 8 * nN, gid = wgid / nig, fm = gid * 8, gsz = (nM - fm) < 8 ? (nM - fm) : 8;
    pm = fm + ((wgid % nig) % gsz); pn = (wgid % nig) / gsz; return true;
}

template <class Epi, class Sched>
__device__ __forceinline__ void gemm_phase(LAS unsigned char* lds, const int K, const int lda, const Sched& S, const Epi& E) {
    const int tid = TIDX, wid = __builtin_amdgcn_readfirstlane(tid >> 6), lane = tid & 63, wr = wid >> 2, wc = wid & 3, fr = lane & 15, fq = lane >> 4;
    const int nt = K / BK;
    unsigned voffA[2], voffB[2];
#pragma unroll
    for (int i = 0; i < 2; ++i) { int R, C; stage_rc(tid * 16 + i * 8192, R, C); const int Rb = Epi::PERM ? ((R & ~31) + perm32(R & 31)) : R;
        voffA[i] = (unsigned)(R * lda + C) * 2u; voffB[i] = (unsigned)(Rb * K + C) * 2u; }
    const size_t kstep = (size_t)(BK * 2);
    const size_t hstepA = (size_t)HALF * lda * 2, hstepB = (size_t)HALF * K * 2;
    const unsigned ldsw = (unsigned)wid * 1024u;
    const int aoff = lds_byte(wr * 64 + fr, fq * 8), boff = lds_byte(wc * 32 + fr, fq * 8);
#define G_SA(b, h) (((b) * 2 + (h)) * HTB)
#define G_SB(b, h) ((4 + (b) * 2 + (h)) * HTB)
#define G_STAGE(bufoff, gbase, voff) do { _Pragma("unroll") for (int _i = 0; _i < 2; ++_i) \
        __builtin_amdgcn_global_load_lds((const unsigned*)((const char*)(gbase) + (voff)[_i]), (LAS unsigned*)(lds + (bufoff) + ldsw + _i * 8192), 16, 0, 0); } while (0)
#define G_LDA(dst, b, h) do { _Pragma("unroll") for (int m = 0; m < 4; ++m) _Pragma("unroll") for (int k = 0; k < 2; ++k) dst[m][k] = *(const LAS bf16x8*)(lds + G_SA(b, h) + aoff + m * 2048 + k * 1024); } while (0)
#define G_LDB(dst, b, h) do { _Pragma("unroll") for (int n = 0; n < 2; ++n) _Pragma("unroll") for (int k = 0; k < 2; ++k) dst[n][k] = *(const LAS bf16x8*)(lds + G_SB(b, h) + boff + n * 2048 + k * 1024); } while (0)
#define G_MMA(ai, bj, At, Bt) do { __builtin_amdgcn_s_setprio(1); _Pragma("unroll") for (int m = 0; m < 4; ++m) _Pragma("unroll") for (int n = 0; n < 2; ++n) _Pragma("unroll") for (int k = 0; k < 2; ++k) \
        acc[ai][bj][m][n] = __builtin_amdgcn_mfma_f32_16x16x32_bf16(Bt[n][k], At[m][k], acc[ai][bj][m][n], 0, 0, 0); __builtin_amdgcn_s_setprio(0); } while (0)
#define G_WAIT_V(n) asm volatile("s_waitcnt vmcnt(" #n ")" ::: "memory")
#define G_WAIT_L(n) asm volatile("s_waitcnt lgkmcnt(" #n ")" ::: "memory")
#define G_BAR __builtin_amdgcn_s_barrier()
#define G_SCHED __builtin_amdgcn_sched_barrier(0)
    Unit cur, nxt; int ui = 0;
    if (!S.next(0, cur)) return;
    f32x4 acc[2][2][4][2];
#pragma unroll
    for (int a = 0; a < 2; ++a)
#pragma unroll
        for (int b = 0; b < 2; ++b)
#pragma unroll
            for (int m = 0; m < 4; ++m)
#pragma unroll
                for (int n = 0; n < 2; ++n) acc[a][b][m][n] = (f32x4){0.f, 0.f, 0.f, 0.f};
    bf16x8 At[4][2], B0[2][2], B1[2][2];
    const char* cA = cur.a; const char* cB = cur.b;
    G_STAGE(G_SB(0, 0), cB, voffB); G_STAGE(G_SA(0, 0), cA, voffA); G_STAGE(G_SB(0, 1), cB + hstepB, voffB); G_STAGE(G_SA(0, 1), cA + hstepA, voffA);
    if (wr == 1) G_BAR;
    G_WAIT_V(4); G_BAR;
    G_STAGE(G_SB(1, 0), cB + kstep, voffB); G_STAGE(G_SA(1, 0), cA + kstep, voffA); G_STAGE(G_SB(1, 1), cB + hstepB + kstep, voffB);
    G_WAIT_V(6); G_BAR;
    for (;;) {
        const bool has_next = S.next(ui + 1, nxt);
        const char* nA = has_next ? nxt.a : cA; const char* nB = has_next ? nxt.b : cB;
        for (int t = 0; t < nt; t += 2) {
            const bool last = (t == nt - 2);
            const char* a1 = cA + (size_t)(t + 1) * kstep;
            const char* a2 = last ? nA : cA + (size_t)(t + 2) * kstep; const char* b2 = last ? nB : cB + (size_t)(t + 2) * kstep;
            const char* a3 = a2 + kstep; const char* b3 = b2 + kstep;
            G_LDB(B0, 0, 0); G_SCHED; G_LDA(At, 0, 0); G_STAGE(G_SA(1, 1), a1 + hstepA, voffA);
            G_WAIT_L(8); G_BAR; G_WAIT_L(0); G_MMA(0, 0, At, B0); G_BAR; G_SCHED;
            G_LDB(B1, 0, 1); G_STAGE(G_SB(0, 0), b2, voffB);
            G_BAR; G_WAIT_L(0); G_MMA(0, 1, At, B1); G_BAR;
            G_LDA(At, 0, 1); G_STAGE(G_SA(0, 0), a2, voffA);
            G_BAR; G_WAIT_L(0); G_MMA(1, 0, At, B0); G_BAR; G_SCHED;
            G_STAGE(G_SB(0, 1), b2 + hstepB, voffB);
            G_WAIT_V(6); G_BAR; G_MMA(1, 1, At, B1); G_BAR;
            G_LDB(B0, 1, 0); G_SCHED; G_LDA(At, 1, 0); G_STAGE(G_SA(0, 1), a2 + hstepA, voffA);
            G_WAIT_L(8); G_BAR; G_WAIT_L(0); G_MMA(0, 0, At, B0); G_BAR; G_SCHED;
            G_LDB(B1, 1, 1); G_STAGE(G_SB(1, 0), b3, voffB);
            G_BAR; G_WAIT_L(0); G_MMA(0, 1, At, B1); G_BAR;
            G_LDA(At, 1, 1); G_STAGE(G_SA(1, 0), a3, voffA);
            G_BAR; G_WAIT_L(0); G_MMA(1, 0, At, B0); G_BAR; G_SCHED;
            G_STAGE(G_SB(1, 1), b3 + hstepB, voffB);
            G_WAIT_V(6); G_BAR; G_MMA(1, 1, At, B1); G_BAR;
        }
        E(acc, cur, wr, wc, fr, fq);
        if (!has_next) break;
#pragma unroll
        for (int a = 0; a < 2; ++a)
#pragma unroll
            for (int b = 0; b < 2; ++b)
#pragma unroll
                for (int m = 0; m < 4; ++m)
#pragma unroll
                    for (int n = 0; n < 2; ++n) acc[a][b][m][n] = (f32x4){0.f, 0.f, 0.f, 0.f};
        cur = nxt; cA = nA; cB = nB; ++ui;
    }
    G_WAIT_V(0);
    if (wr == 0) G_BAR;
    G_BAR;
#undef G_SA
#undef G_SB
#undef G_STAGE
#undef G_LDA
#undef G_LDB
#undef G_MMA
#undef G_WAIT_V
#undef G_WAIT_L
#undef G_BAR
#undef G_SCHED
}

struct SchedSimple {
    const u16* Ap; const u16* As; const u16* Bt; int lda, K, nN, G, c; int acol_per_pn;
    __device__ __forceinline__ bool next(int i, Unit& u) const {
        int pm, pn; if (!tile_of((long)i * G + c, 65, nN, pm, pn)) return false;
        u.pm = pm; u.pn = pn; u.sub = 0;
        u.a = (const char*)((pm < 64 ? Ap + (size_t)pm * 256 * lda : As) + (size_t)(pn >> 1) * acol_per_pn);
        u.b = (const char*)(Bt + (size_t)pn * 256 * K); return true;
    }
};
struct SchedMerge {
    B16 hn, oa, ob; const u16* Win; const u16* Waup; const u16* Wbup; int G, c;
    __device__ __forceinline__ bool next(int i, Unit& u) const {
        int pm, pn; if (!tile_of((long)(i >> 2) * G + c, 65, 4, pm, pn)) return false;
        const int sub = i & 3; u.pm = pm; u.pn = pn; u.sub = sub;
        const unsigned long long m1 = (sub == 1) ? ~0ull : 0ull, m3 = (sub == 3) ? ~0ull : 0ull, m0 = ~(m1 | m3);
        const u16* abp = (const u16*)(((unsigned long long)oa.p & m1) | ((unsigned long long)ob.p & m3) | ((unsigned long long)hn.p & m0));
        const u16* abs_ = (const u16*)(((unsigned long long)oa.s & m1) | ((unsigned long long)ob.s & m3) | ((unsigned long long)hn.s & m0));
        const u16* bb = (const u16*)(((unsigned long long)Waup & m1) | ((unsigned long long)Wbup & m3) | ((unsigned long long)(Win + (size_t)(sub == 0 ? 6144 : 7168) * DM) & m0));
        u.a = (const char*)(pm < 64 ? abp + (size_t)pm * 256 * DM : abs_);
        u.b = (const char*)(bb + (size_t)pn * 256 * DM); return true;
    }
};

struct EpiGU {
    static constexpr bool PERM = true; B16 act;
    __device__ __forceinline__ void operator()(const f32x4 (&acc)[2][2][4][2], const Unit& u, int wr, int wc, int fr, int fq) const {
        u16* base = (u.pm < 64 ? act.p + (size_t)u.pm * 256 * DFF : act.s) + u.pn * 128 + wc * 32 + 8 * fq;
#pragma unroll
        for (int ai = 0; ai < 2; ++ai)
#pragma unroll
            for (int m = 0; m < 4; ++m) {
                const int rt = ai * 128 + wr * 64 + m * 16 + fr; float o[8];
#pragma unroll
                for (int n = 0; n < 2; ++n)
#pragma unroll
                    for (int j = 0; j < 4; ++j) o[n * 4 + j] = silu(acc[ai][0][m][n][j]) * acc[ai][1][m][n][j];
                *(u32x4*)(base + (size_t)rt * DFF) = pack8(o);
            }
    }
};
struct EpiRes {
    static constexpr bool PERM = false; const float* rp; const float* rs; int ns; float* out; float scale;
    __device__ __forceinline__ void operator()(const f32x4 (&acc)[2][2][4][2], const Unit& u, int wr, int wc, int fr, int fq) const {
        const int col0 = u.pn * 256 + wc * 32 + 4 * fq;
#pragma unroll
        for (int ai = 0; ai < 2; ++ai)
#pragma unroll
            for (int m = 0; m < 4; ++m) {
                const int rt = ai * 128 + wr * 64 + m * 16 + fr; const int row = u.pm * 256 + rt;
                const float* r = (u.pm < 64) ? rp + (size_t)row * DM : rs + (size_t)rt * DM; const bool valid = (u.pm < 64) || (rt < ns);
                float* o = out + (size_t)row * DM;
#pragma unroll
                for (int bj = 0; bj < 2; ++bj)
#pragma unroll
                    for (int n = 0; n < 2; ++n) { const int c = col0 + bj * 128 + n * 16; f32x4 rv = (f32x4){0.f, 0.f, 0.f, 0.f}; if (valid) rv = *(const f32x4*)(r + c);
                        *(f32x4*)(o + c) = rv + scale * acc[ai][bj][m][n]; }
                asm volatile("" ::: "memory");
            }
    }
};
template <int MODE> __device__ __forceinline__ void ina_store(u16* base, const f32x4 (&acc)[2][2][4][2], const float* lbp) {
#pragma unroll
    for (int bj = 0; bj < 2; ++bj) {
        f32x4 l0 = (f32x4){0.f, 0.f, 0.f, 0.f}, l1 = l0;
        if (MODE == 1) { l0 = *(const f32x4*)(lbp + bj * 128); l1 = *(const f32x4*)(lbp + bj * 128 + 4); }
#pragma unroll
        for (int ai = 0; ai < 2; ++ai)
#pragma unroll
            for (int m = 0; m < 4; ++m) {
                u16* d = base + (size_t)(ai * 128 + m * 16) * DM + bj * 128;
                if (MODE == 1) { const f32x4 f0 = l0 + (1.f - l0) * sig4(acc[ai][bj][m][0]), f1 = l1 + (1.f - l1) * sig4(acc[ai][bj][m][1]); *(u32x4*)d = pack8h(log4(f0), log4(f1)); }
                else if (MODE == 2) *(u32x4*)d = pack8v(acc[ai][bj][m][0], acc[ai][bj][m][1]);
                else *(u32x4*)d = pack8v(silu4(acc[ai][bj][m][0]), silu4(acc[ai][bj][m][1]));
            }
    }
}
struct EpiInA {
    static constexpr bool PERM = true; B16 qs, lf, v, gs; const float* lbv;
    __device__ __forceinline__ void operator()(const f32x4 (&acc)[2][2][4][2], const Unit& u, int wr, int wc, int fr, int fq) const {
        const int seg = u.pn >> 2, cs = (u.pn & 3) * 256 + wc * 32 + 8 * fq;
        const size_t ro = cs + (size_t)(wr * 64 + fr) * DM; const size_t po = (size_t)u.pm * 256 * DM; const bool pr = u.pm < 64;
        if (seg == 0) { u16* qp = qs.p; u16* qsm = qs.s; ina_store<0>((pr ? qp + po : qsm) + ro, acc, lbv); }
        else if (seg == 1) { u16* qp = lf.p; u16* qsm = lf.s; ina_store<1>((pr ? qp + po : qsm) + ro, acc, lbv + cs); }
        else if (seg == 2) { u16* qp = v.p; u16* qsm = v.s; ina_store<2>((pr ? qp + po : qsm) + ro, acc, lbv); }
        else { u16* qp = gs.p; u16* qsm = gs.s; ina_store<0>((pr ? qp + po : qsm) + ro, acc, lbv); }
    }
};
struct EpiInB {
    static constexpr bool PERM = true; B16 xr, yg;
    __device__ __forceinline__ void operator()(const f32x4 (&acc)[2][2][4][2], const Unit& u, int wr, int wc, int fr, int fq) const {
        const int seg = u.pn >> 2, cs = (u.pn & 3) * 256 + wc * 32 + 8 * fq;
        u16* base = (u.pm < 64 ? (seg == 0 ? +xr.p : +yg.p) + (size_t)u.pm * 256 * DM : (seg == 0 ? +xr.s : +yg.s)) + cs + (size_t)(wr * 64 + fr) * DM;
        if (seg == 0) {
#pragma unroll
            for (int ai = 0; ai < 2; ++ai)
#pragma unroll
                for (int m = 0; m < 4; ++m)
#pragma unroll
                    for (int bj = 0; bj < 2; ++bj) *(u32x4*)(base + (size_t)(ai * 128 + m * 16) * DM + bj * 128) = pack8v(acc[ai][bj][m][0], acc[ai][bj][m][1]);
        } else {
#pragma unroll
            for (int ai = 0; ai < 2; ++ai)
#pragma unroll
                for (int m = 0; m < 4; ++m)
#pragma unroll
                    for (int bj = 0; bj < 2; ++bj) *(u32x4*)(base + (size_t)(ai * 128 + m * 16) * DM + bj * 128) = pack8v(gelu4(acc[ai][bj][m][0]), gelu4(acc[ai][bj][m][1]));
        }
    }
};
__device__ __forceinline__ f32x4 nexpm1_4(f32x4 x) { const f32x4 p = 1.f + x * (0.5f + x * (0.16666667f + x * (0.041666668f + x * (0.008333334f + x * 0.0013888889f)))); return -x * p; }
__device__ __forceinline__ f32x4 sqrt4(f32x4 v) { return (f32x4){sqrtf(fmaxf(v.x, 0.f)), sqrtf(fmaxf(v.y, 0.f)), sqrtf(fmaxf(v.z, 0.f)), sqrtf(fmaxf(v.w, 0.f))}; }
struct EpiBD {
    static constexpr bool PERM = true; B16 xc, bt; const float* ba; const float* bx; const float* lc;
    __device__ __forceinline__ void operator()(const f32x4 (&acc)[2][2][4][2], const Unit& u, int wr, int wc, int fr, int fq) const {
        const int ch = u.pn * 128 + wc * 32 + 8 * fq;
        u16* xb = (u.pm < 64 ? xc.p + (size_t)u.pm * 256 * DM : xc.s) + ch + (size_t)(wr * 64 + fr) * DM; u16* bb = (u.pm < 64 ? bt.p + (size_t)u.pm * 256 * DM : bt.s) + ch + (size_t)(wr * 64 + fr) * DM;
#pragma unroll
        for (int n = 0; n < 2; ++n) {
            const f32x4 cba = *(const f32x4*)(ba + ch + 4 * n), cbx = *(const f32x4*)(bx + ch + 4 * n), cl = *(const f32x4*)(lc + ch + 4 * n);
#pragma unroll
            for (int ai = 0; ai < 2; ++ai)
#pragma unroll
                for (int m = 0; m < 4; ++m) {
                    const size_t off = (size_t)(ai * 128 + m * 16) * DM + 4 * n;
                    const u32x2 xw = *(const u32x2*)(xb + off); const f32x4 xv = (f32x4){blo(xw.x), bhi(xw.x), blo(xw.y), bhi(xw.y)};
                    const f32x4 r = sig4(acc[ai][0][m][n] + cba), ig = sig4(acc[ai][1][m][n] + cbx);
                    const f32x4 la = r * cl; const f32x4 bo = sqrt4(nexpm1_4(2.f * la)) * ig * xv;
                    u32x2 o1, o2; o1.x = pk(la.x, la.y); o1.y = pk(la.z, la.w); o2.x = pk(bo.x, bo.y); o2.y = pk(bo.z, bo.w);
                    *(u32x2*)(xb + off) = o1; *(u32x2*)(bb + off) = o2;
                    if (m & 1) asm volatile("" ::: "memory");
                }
        }
    }
};
struct EpiMerge {
    static constexpr bool PERM = true; B16 gt, ta, mb;
    __device__ __forceinline__ void operator()(const f32x4 (&acc)[2][2][4][2], const Unit& u, int wr, int wc, int fr, int fq) const {
        const size_t ro = ((u.pm < 64) ? (size_t)u.pm * 256 * DM : 0) + u.pn * 256 + wc * 32 + 8 * fq + (size_t)(wr * 64 + fr) * DM;
        u16* g = (u.pm < 64 ? +gt.p : +gt.s) + ro; u16* t = (u.pm < 64 ? +ta.p : +ta.s) + ro; u16* mo = (u.pm < 64 ? +mb.p : +mb.s) + ro;
        const int sub = u.sub;
        if (sub == 0 || sub == 2) {
#pragma unroll
            for (int ai = 0; ai < 2; ++ai)
#pragma unroll
                for (int m = 0; m < 4; ++m)
#pragma unroll
                    for (int bj = 0; bj < 2; ++bj) *(u32x4*)(g + (size_t)(ai * 128 + m * 16) * DM + bj * 128) = pack8v(sig4(acc[ai][bj][m][0]), sig4(acc[ai][bj][m][1]));
        } else if (sub == 1) {
#pragma unroll
            for (int ai = 0; ai < 2; ++ai)
#pragma unroll
                for (int m = 0; m < 4; ++m)
#pragma unroll
                    for (int bj = 0; bj < 2; ++bj) { const size_t off = (size_t)(ai * 128 + m * 16) * DM + bj * 128; const F8 gv = unpack8v(*(const u32x4*)(g + off));
                        *(u32x4*)(t + off) = pack8v(gv.a * acc[ai][bj][m][0], gv.b * acc[ai][bj][m][1]); if (bj) asm volatile("" ::: "memory"); }
        } else {
#pragma unroll
            for (int ai = 0; ai < 2; ++ai)
#pragma unroll
                for (int m = 0; m < 4; ++m)
#pragma unroll
                    for (int bj = 0; bj < 2; ++bj) { const size_t off = (size_t)(ai * 128 + m * 16) * DM + bj * 128; const F8 gv = unpack8v(*(const u32x4*)(g + off)), tv = unpack8v(*(const u32x4*)(t + off));
                        *(u32x4*)(mo + off) = pack8v(tv.a + gv.a * acc[ai][bj][m][0], tv.b + gv.b * acc[ai][bj][m][1]); if (bj) asm volatile("" ::: "memory"); }
        }
    }
};

__device__ __forceinline__ void tconv_tile(const float* src, int N, int K, int kt, int nt, u16* dst, int mode, float* tile) {
    const int tid = TIDX;
    const int c4 = (tid & 15) * 4;
#pragma unroll
    for (int p = 0; p < 2; ++p) { const int r = (tid >> 4) + 32 * p; const f32x4 v = *(const f32x4*)(src + (size_t)(kt * 64 + r) * N + nt * 64 + c4);
        tile[r * 65 + c4] = v.x; tile[r * 65 + c4 + 1] = v.y; tile[r * 65 + c4 + 2] = v.z; tile[r * 65 + c4 + 3] = v.w; }
    __syncthreads();
    const int n = tid >> 3, k8 = (tid & 7) * 8; float f[8];
#pragma unroll
    for (int j = 0; j < 8; ++j) f[j] = tile[(k8 + j) * 65 + n];
    const int ng = nt * 64 + n; const int drow = mode == 0 ? ng : ((ng >> 7) * 256 + (mode == 2 ? 128 : 0) + (ng & 127));
    *(u32x4*)(dst + (size_t)drow * K + kt * 64 + k8) = pack8(f);
    __syncthreads();
}
__device__ __forceinline__ void conv_matrix(const float* src, int K, int N, u16* dst, int mode, int t, float* tile) {
    const int ntn = N / 64; tconv_tile(src, N, K, t / ntn, t % ntn, dst, mode, tile);
}
__device__ __forceinline__ void norm_rows(const float* sp, const float* ss, const float* gain, B16 dst) {
    const int lane = TIDX & 63, gw = blockIdx.x * 8 + (TIDX >> 6), nw = gridDim.x * 8;
    f32x4 g[4];
#pragma unroll
    for (int i = 0; i < 4; ++i) g[i] = *(const f32x4*)(gain + i * 256 + lane * 4);
    for (int row = gw; row < NTOK; row += nw) {
        const float* src = row < TP ? sp + (size_t)row * DM : ss + (size_t)(row - TP) * DM;
        f32x4 v[4]; float s = 0.f;
#pragma unroll
        for (int i = 0; i < 4; ++i) { v[i] = *(const f32x4*)(src + i * 256 + lane * 4); s += v[i].x * v[i].x + v[i].y * v[i].y + v[i].z * v[i].z + v[i].w * v[i].w; }
        s = wave_sum(s); const float rs = rsqrtf(s * (1.f / DM) + EPSV);
        u16* d = (row < TP ? dst.p + (size_t)row * DM : dst.s + (size_t)(row - TP) * DM);
#pragma unroll
        for (int i = 0; i < 4; ++i) { u32x2 w; w.x = pk(v[i].x * rs * g[i].x, v[i].y * rs * g[i].y); w.y = pk(v[i].z * rs * g[i].z, v[i].w * rs * g[i].w); *(u32x2*)(d + i * 256 + lane * 4) = w; }
    }
}
__device__ __forceinline__ void final_norm(const float* x, const float* gain, float* yp, float* ys) {
    const int lane = TIDX & 63, gw = blockIdx.x * 8 + (TIDX >> 6), nw = gridDim.x * 8;
    f32x4 g[4];
#pragma unroll
    for (int i = 0; i < 4; ++i) g[i] = *(const f32x4*)(gain + i * 256 + lane * 4);
    for (int row = gw; row < NTOK; row += nw) {
        const float* src = x + (size_t)row * DM;
        f32x4 v[4]; float s = 0.f;
#pragma unroll
        for (int i = 0; i < 4; ++i) { v[i] = *(const f32x4*)(src + i * 256 + lane * 4); s += v[i].x * v[i].x + v[i].y * v[i].y + v[i].z * v[i].z + v[i].w * v[i].w; }
        s = wave_sum(s); const float rs = rsqrtf(s * (1.f / DM) + EPSV);
        float* d = row < TP ? yp + (size_t)row * DM : ys + (size_t)(row - TP) * DM;
#pragma unroll
        for (int i = 0; i < 4; ++i) *(f32x4*)(d + i * 256 + lane * 4) = v[i] * rs * g[i];
    }
}

constexpr int L_BL = 0, L_TOT = 32768, L_RED = 34816, L_QE = 35328, L_KE = 52736, L_VT = 70144, L_AM = 88576, L_ST = 97792;
constexpr int QS_ = 136, VS_ = 72;

__device__ __forceinline__ void load_lf_chunk(const u16* lfp, int row0, int h, float* bL) {
    const int tid = TIDX, r = tid >> 3, seg = tid & 7;
    const u16* p = lfp + (size_t)(row0 + r) * DM + h * 128 + seg * 16;
    const u32x4 w0 = *(const u32x4*)p, w1 = *(const u32x4*)(p + 8);
    float* d = bL + r * 128 + seg * 16;
    const unsigned ws[8] = {w0.x, w0.y, w0.z, w0.w, w1.x, w1.y, w1.z, w1.w};
#pragma unroll
    for (int i = 0; i < 8; ++i) { d[2 * i] = h2f((u16)(ws[i] & 0xffffu)); d[2 * i + 1] = h2f((u16)(ws[i] >> 16)); }
}
__device__ __forceinline__ void load_vT(const u16* vp, int row0, int h, u16* vT) {
    const int tid = TIDX, s = tid >> 3, seg = tid & 7;
    const u16* p = vp + (size_t)(row0 + s) * DM + h * 128 + seg * 16;
    const u32x4 w0 = *(const u32x4*)p, w1 = *(const u32x4*)(p + 8);
    const unsigned ws[8] = {w0.x, w0.y, w0.z, w0.w, w1.x, w1.y, w1.z, w1.w};
#pragma unroll
    for (int i = 0; i < 8; ++i) { vT[(seg * 16 + 2 * i) * VS_ + s] = (u16)(ws[i] & 0xffffu); vT[(seg * 16 + 2 * i + 1) * VS_ + s] = (u16)(ws[i] >> 16); }
}

__device__ __forceinline__ void hgrn_h1(const Params& P, unsigned char* sm) {
    float* bL = (float*)(sm + L_BL); float* tot = (float*)(sm + L_TOT); u16* kdT = (u16*)(sm + L_QE); u16* vT = (u16*)(sm + L_VT);
    const u16* lfp = (const u16*)(P.ws + WS_R1); const u16* vp = (const u16*)(P.ws + WS_R2);
    u16* Sb = (u16*)(P.out + O_HS); float* BLg = (float*)(P.ws + WS_BL);
    const int tid = TIDX, lane = tid & 63, w = tid >> 6, fr = lane & 15, fq = lane >> 4;
    for (int item = blockIdx.x; item < 2048; item += gridDim.x) {
        const int h = item & 7, c = (item >> 3) & 31, b = item >> 8; const int row0 = b * SEQ + c * 64;
        const int sidx = (b * 8 + h) * 32 + c;
        load_lf_chunk(lfp, row0, h, bL); load_vT(vp, row0, h, vT);
        __syncthreads();
        const int col = tid & 127, part = tid >> 7; float lf[16]; float run = 0.f;
#pragma unroll
        for (int i = 0; i < 16; ++i) { lf[i] = bL[(part * 16 + i) * 128 + col]; run += lf[i]; }
        tot[part * 128 + col] = run;
        __syncthreads();
        float off = 0.f, bl = 0.f;
#pragma unroll
        for (int p = 0; p < 4; ++p) { const float t = tot[p * 128 + col]; bl += t; if (p < part) off += t; }
        if (part == 0) BLg[(size_t)sidx * 128 + col] = bl;
        float bc = off;
#pragma unroll
        for (int i = 0; i < 16; ++i) { bc += lf[i]; const float kd = (1.f - __expf(lf[i])) * __expf(bl - bc); kdT[col * VS_ + part * 16 + i] = f2b(kd); }
        __syncthreads();
        bf16x8 av[2];
#pragma unroll
        for (int ks = 0; ks < 2; ++ks) av[ks] = *(const bf16x8*)(vT + (16 * w + fr) * VS_ + ks * 32 + 8 * fq);
        u16* so = Sb + (size_t)sidx * 16384 + (16 * w + fr) * 128 + 4 * fq;
#pragma unroll
        for (int nt = 0; nt < 8; ++nt) {
            f32x4 acc = (f32x4){0.f, 0.f, 0.f, 0.f};
#pragma unroll
            for (int ks = 0; ks < 2; ++ks) { const bf16x8 bk = *(const bf16x8*)(kdT + (16 * nt + fr) * VS_ + ks * 32 + 8 * fq); acc = __builtin_amdgcn_mfma_f32_16x16x32_bf16(bk, av[ks], acc, 0, 0, 0); }
            u32x2 o; o.x = pk(acc.x, acc.y); o.y = pk(acc.z, acc.w); *(u32x2*)(so + 16 * nt) = o;
        }
        __syncthreads();
    }
}
__device__ __forceinline__ void hgrn_h2(const Params& P) {
    u16* Sb = (u16*)(P.out + O_HS); const float* BLg = (const float*)(P.ws + WS_BL); float* hp = P.out + O_HP;
    for (int g = blockIdx.x * 512 + TIDX; g < 64 * 2048; g += gridDim.x * 512) {
        const int bh = g >> 11, e = (g & 2047) * 8, dv = e >> 7, dk = e & 127;
        float S[8];
#pragma unroll
        for (int j = 0; j < 8; ++j) S[j] = 0.f;
        u16* sp = Sb + (size_t)bh * 32 * 16384 + e; const float* blp = BLg + (size_t)bh * 32 * 128 + dk;
#pragma unroll 4
        for (int c = 0; c < 32; ++c) {
            const u32x4 lw = *(const u32x4*)(sp + (size_t)c * 16384); const f32x4 d0 = *(const f32x4*)(blp + c * 128), d1 = *(const f32x4*)(blp + c * 128 + 4);
            float sl[8]; unpack8(lw, sl);
            *(u32x4*)(sp + (size_t)c * 16384) = pack8(S);
            const float dd[8] = {d0.x, d0.y, d0.z, d0.w, d1.x, d1.y, d1.z, d1.w};
#pragma unroll
            for (int j = 0; j < 8; ++j) S[j] = __expf(dd[j]) * S[j] + sl[j];
        }
        float* o = hp + (size_t)bh * 16384 + dv;
#pragma unroll
        for (int j = 0; j < 8; ++j) o[(size_t)(dk + j) * 128] = S[j];
    }
}
__device__ __forceinline__ void hgrn_h3(const Params& P, unsigned char* sm) {
    float* bL = (float*)(sm + L_BL); float* tot = (float*)(sm + L_TOT); float* red = (float*)(sm + L_RED);
    u16* qe = (u16*)(sm + L_QE); u16* ke = (u16*)(sm + L_KE); u16* vT = (u16*)(sm + L_VT); u16* Am = (u16*)(sm + L_AM); u16* ST = (u16*)(sm + L_ST);
    const u16* qsp = (const u16*)(P.ws + WS_R0); const u16* lfp = (const u16*)(P.ws + WS_R1); const u16* vp = (const u16*)(P.ws + WS_R2);
    u16* gsp = (u16*)(P.out + O_YP);
    const u16* Sb = (const u16*)(P.out + O_HS); const float* onorm = P.in[12];
    const int tid = TIDX, lane = tid & 63, w = tid >> 6, fr = lane & 15, fq = lane >> 4;
    for (int item = blockIdx.x; item < 2048; item += gridDim.x) {
        const int h = item & 7, c = (item >> 3) & 31, b = item >> 8; const int row0 = b * SEQ + c * 64;
        const int sidx = (b * 8 + h) * 32 + c;
        load_lf_chunk(lfp, row0, h, bL); load_vT(vp, row0, h, vT);
        { const u16* sp = Sb + (size_t)sidx * 16384;
#pragma unroll
          for (int p = 0; p < 4; ++p) { const int idx = tid + 512 * p, dv = idx >> 4, k8 = (idx & 15) * 8; *(u32x4*)(ST + dv * QS_ + k8) = *(const u32x4*)(sp + dv * 128 + k8); } }
        __syncthreads();
        const int col = tid & 127, part = tid >> 7; float lf[16]; float run = 0.f;
#pragma unroll
        for (int i = 0; i < 16; ++i) { lf[i] = bL[(part * 16 + i) * 128 + col]; run += lf[i]; }
        tot[part * 128 + col] = run;
        __syncthreads();
        float off = 0.f;
#pragma unroll
        for (int p = 0; p < 4; ++p) { const float t = tot[p * 128 + col]; if (p < part) off += t; }
        float bc = off; const u16* qp = qsp + (size_t)(row0 + part * 16) * DM + h * 128 + col;
#pragma unroll
        for (int i = 0; i < 16; ++i) { bc += lf[i]; const float q = b2f(qp[(size_t)i * DM]);
            qe[(part * 16 + i) * QS_ + col] = f2b(q * __expf(bc)); ke[(part * 16 + i) * QS_ + col] = f2b((1.f - __expf(lf[i])) * __expf(-bc)); }
        __syncthreads();
        {
            const int mt = w & 3;
            bf16x8 aq[4];
#pragma unroll
            for (int ks = 0; ks < 4; ++ks) aq[ks] = *(const bf16x8*)(qe + (16 * mt + fr) * QS_ + ks * 32 + 8 * fq);
#pragma unroll
            for (int t = 0; t < 2; ++t) { const int nt = (w >> 2) * 2 + t; f32x4 acc = (f32x4){0.f, 0.f, 0.f, 0.f};
#pragma unroll
                for (int ks = 0; ks < 4; ++ks) { const bf16x8 bk = *(const bf16x8*)(ke + (16 * nt + fr) * QS_ + ks * 32 + 8 * fq); acc = __builtin_amdgcn_mfma_f32_16x16x32_bf16(bk, aq[ks], acc, 0, 0, 0); }
                const int cr = 16 * mt + fr, s0 = 16 * nt + 4 * fq;
                u32x2 o; o.x = pk(cr >= s0 ? acc.x : 0.f, cr >= s0 + 1 ? acc.y : 0.f); o.y = pk(cr >= s0 + 2 ? acc.z : 0.f, cr >= s0 + 3 ? acc.w : 0.f);
                *(u32x2*)(Am + cr * VS_ + s0) = o; }
        }
        __syncthreads();
        {
            const int mt = w & 3, nh = w >> 2;
            bf16x8 aq[4], aa[2];
#pragma unroll
            for (int ks = 0; ks < 4; ++ks) aq[ks] = *(const bf16x8*)(qe + (16 * mt + fr) * QS_ + ks * 32 + 8 * fq);
#pragma unroll
            for (int ks = 0; ks < 2; ++ks) aa[ks] = *(const bf16x8*)(Am + (16 * mt + fr) * VS_ + ks * 32 + 8 * fq);
            f32x4 acc[4]; float ssq = 0.f;
#pragma unroll
            for (int t = 0; t < 4; ++t) { const int dt = nh * 4 + t; acc[t] = (f32x4){0.f, 0.f, 0.f, 0.f};
#pragma unroll
                for (int ks = 0; ks < 4; ++ks) { const bf16x8 bk = *(const bf16x8*)(ST + (16 * dt + fr) * QS_ + ks * 32 + 8 * fq); acc[t] = __builtin_amdgcn_mfma_f32_16x16x32_bf16(bk, aq[ks], acc[t], 0, 0, 0); }
#pragma unroll
                for (int ks = 0; ks < 2; ++ks) { const bf16x8 bk = *(const bf16x8*)(vT + (16 * dt + fr) * VS_ + ks * 32 + 8 * fq); acc[t] = __builtin_amdgcn_mfma_f32_16x16x32_bf16(bk, aa[ks], acc[t], 0, 0, 0); }
                ssq += acc[t].x * acc[t].x + acc[t].y * acc[t].y + acc[t].z * acc[t].z + acc[t].w * acc[t].w; }
            ssq += __shfl_xor(ssq, 16, 64); ssq += __shfl_xor(ssq, 32, 64);
            if (fq == 0) red[(16 * mt + fr) * 2 + nh] = ssq;
            __syncthreads();
            const int cr = 16 * mt + fr; const float rinv = rsqrtf((red[cr * 2] + red[cr * 2 + 1]) * (1.f / 128.f) + EPSV);
            u16* gp = gsp + (size_t)(row0 + cr) * DM + h * 128;
#pragma unroll
            for (int t = 0; t < 4; ++t) { const int dv = 16 * (nh * 4 + t) + 4 * fq; const u32x2 gw = *(const u32x2*)(gp + dv); const f32x4 on = *(const f32x4*)(onorm + h * 128 + dv);
                u32x2 o; o.x = pk(acc[t].x * rinv * on.x * blo(gw.x), acc[t].y * rinv * on.y * bhi(gw.x)); o.y = pk(acc[t].z * rinv * on.z * blo(gw.y), acc[t].w * rinv * on.w * bhi(gw.y));
                *(u32x2*)(gp + dv) = o; }
        }
        __syncthreads();
    }
}
__device__ __forceinline__ void hgrn_sample(const Params& P, unsigned char* sm) {
    float* red = (float*)sm;
    float* sq = red + 16 * 128;
    float* sf = sq + 128; float* sk = sf + 128; float* sv = sk + 128; float* so = sv + 128; float* sr = so + 128;
    const u16* qss = (const u16*)(P.ws + WS_SIDE + 1 * SSLOT); const u16* lfs = (const u16*)(P.ws + WS_SIDE + 2 * SSLOT); const u16* vs = (const u16*)(P.ws + WS_SIDE + 3 * SSLOT);
    u16* gss = (u16*)(P.ws + WS_SIDE + 4 * SSLOT);
    const float* S0 = P.in[2]; float* Sn = P.out + O_HS; const float* onorm = P.in[12];
    const int tid = TIDX;
    for (int item = blockIdx.x; item < 1024; item += gridDim.x) {
        const int b = item >> 3, h = item & 7;
        if (tid < 128) { const int c = h * 128 + tid; const float lfv = h2f(lfs[(size_t)b * DM + c]); const float f = __expf(lfv);
            sq[tid] = b2f(qss[(size_t)b * DM + c]); sf[tid] = f; sk[tid] = 1.f - f; sv[tid] = b2f(vs[(size_t)b * DM + c]); }
        __syncthreads();
        const int dv4 = (tid & 31) * 4, dkg = tid >> 5;
        const f32x4 vv = *(const f32x4*)(sv + dv4); f32x4 oacc = (f32x4){0.f, 0.f, 0.f, 0.f};
        const size_t base = ((size_t)(b * 8 + h)) * 16384;
#pragma unroll
        for (int i = 0; i < 8; ++i) { const int dk = dkg * 8 + i; const f32x4 s0 = *(const f32x4*)(S0 + base + dk * 128 + dv4);
            const f32x4 sn = sf[dk] * s0 + sk[dk] * vv; *(f32x4*)(Sn + base + dk * 128 + dv4) = sn; oacc += sq[dk] * sn; }
        *(f32x4*)(red + dkg * 128 + dv4) = oacc;
        __syncthreads();
        if (tid < 128) { float o = 0.f;
#pragma unroll
            for (int g = 0; g < 16; ++g) o += red[g * 128 + tid];
            so[tid] = o; const float s2 = wave_sum(o * o); if ((tid & 63) == 0) sr[tid >> 6] = s2; }
        __syncthreads();
        if (tid < 128) { const float rinv = rsqrtf((sr[0] + sr[1]) * (1.f / 128.f) + EPSV); const int c = h * 128 + tid;
            const float g = b2f(gss[(size_t)b * DM + c]); gss[(size_t)b * DM + c] = f2b(so[tid] * rinv * onorm[c] * g); }
        __syncthreads();
    }
}
__device__ __forceinline__ void conv_phase(const Params& P) {
    const u16* xrp = (const u16*)(P.ws + WS_R0); const u16* xrs = (const u16*)(P.ws + WS_SIDE + 5 * SSLOT);
    u16* xcp = (u16*)(P.ws + WS_R2); u16* xcs = (u16*)(P.ws + WS_SIDE + 7 * SSLOT);
    const float* cw = P.in[13]; const float* cb = P.in[14]; const float* sc = P.in[4];
    float* cpo = P.out + O_CP; float* cso = P.out + O_CS;
    const int tid = TIDX, ch = (tid & 127) * 8;
    float w0[8], w1[8], w2[8], w3[8], bb[8];
#pragma unroll
    for (int j = 0; j < 8; ++j) { w0[j] = cw[ch + j]; w1[j] = cw[1024 + ch + j]; w2[j] = cw[2048 + ch + j]; w3[j] = cw[3072 + ch + j]; bb[j] = cb[ch + j]; }
    for (int rg = blockIdx.x; rg < NTOK / 4; rg += gridDim.x) {
        const int row = rg * 4 + (tid >> 7);
        float x0[8], x1[8], x2[8], x3[8];
        if (row < TP) {
            const int t = row & (SEQ - 1); const u16* p = xrp + (size_t)row * DM + ch;
            unpack8(*(const u32x4*)p, x0);
            if (t >= 1) unpack8(*(const u32x4*)(p - DM), x1); else { for (int j = 0; j < 8; ++j) x1[j] = 0.f; }
            if (t >= 2) unpack8(*(const u32x4*)(p - 2 * DM), x2); else { for (int j = 0; j < 8; ++j) x2[j] = 0.f; }
            if (t >= 3) unpack8(*(const u32x4*)(p - 3 * DM), x3); else { for (int j = 0; j < 8; ++j) x3[j] = 0.f; }
            if (t >= SEQ - 3) { float* o = cpo + ((size_t)(row >> 11) * 3 + (t - (SEQ - 3))) * DM + ch; *(f32x4*)o = (f32x4){x0[0], x0[1], x0[2], x0[3]}; *(f32x4*)(o + 4) = (f32x4){x0[4], x0[5], x0[6], x0[7]}; }
        } else {
            const int b = row - TP; unpack8(*(const u32x4*)(xrs + (size_t)b * DM + ch), x0);
            const float* s = sc + (size_t)b * 3 * DM + ch;
#pragma unroll
            for (int j = 0; j < 8; ++j) { x3[j] = s[j]; x2[j] = s[DM + j]; x1[j] = s[2 * DM + j]; }
            float* o = cso + (size_t)b * 3 * DM + ch;
#pragma unroll
            for (int j = 0; j < 8; ++j) { o[j] = x2[j]; o[DM + j] = x1[j]; o[2 * DM + j] = x0[j]; }
        }
        float y[8];
#pragma unroll
        for (int j = 0; j < 8; ++j) y[j] = bb[j] + w3[j] * x0[j] + w2[j] * x1[j] + w1[j] * x2[j] + w0[j] * x3[j];
        u16* d = row < TP ? xcp + (size_t)row * DM + ch : xcs + (size_t)(row - TP) * DM + ch;
        *(u32x4*)d = pack8(y);
    }
}
__device__ __forceinline__ void lru_pass1(const Params& P) {
    const unsigned* la = (const unsigned*)(P.ws + WS_R2); const unsigned* bt = (const unsigned*)(P.ws + WS_R0); f32x4* agg = (f32x4*)(P.ws + WS_AGG);
    const int cp = TIDX;
    for (int item = blockIdx.x; item < 256; item += gridDim.x) {
        const size_t r0 = (size_t)item * 64;
        float P0 = 1.f, P1 = 1.f, H0 = 0.f, H1 = 0.f;
#pragma unroll 8
        for (int r = 0; r < 64; ++r) { const unsigned lw = la[(r0 + r) * 512 + cp], bw = bt[(r0 + r) * 512 + cp];
            const float a0 = __expf(blo(lw)), a1 = __expf(bhi(lw)); H0 = a0 * H0 + blo(bw); H1 = a1 * H1 + bhi(bw); P0 *= a0; P1 *= a1; }
        agg[(size_t)item * 512 + cp] = (f32x4){P0, H0, P1, H1};
    }
}
__device__ __forceinline__ void lru_pass2(const Params& P) {
    const unsigned* la = (const unsigned*)(P.ws + WS_R2); const unsigned* bt = (const unsigned*)(P.ws + WS_R0); unsigned* yg = (unsigned*)(P.ws + WS_R1); const f32x4* agg = (const f32x4*)(P.ws + WS_AGG);
    float* lpo = P.out + O_LP;
    const int cp = TIDX;
    for (int item = blockIdx.x; item < 256; item += gridDim.x) {
        const int b = item >> 5, c = item & 31; const size_t r0 = (size_t)item * 64;
        float h0 = 0.f, h1 = 0.f;
        for (int cc = 0; cc < c; ++cc) { const f32x4 g = agg[(size_t)(b * 32 + cc) * 512 + cp]; h0 = g.x * h0 + g.y; h1 = g.z * h1 + g.w; }
#pragma unroll 8
        for (int r = 0; r < 64; ++r) { const size_t ix = (r0 + r) * 512 + cp; const unsigned lw = la[ix], bw = bt[ix], yw = yg[ix];
            h0 = __expf(blo(lw)) * h0 + blo(bw); h1 = __expf(bhi(lw)) * h1 + bhi(bw); yg[ix] = pk(h0 * blo(yw), h1 * bhi(yw)); }
        if (c == 31) { lpo[b * DM + 2 * cp] = h0; lpo[b * DM + 2 * cp + 1] = h1; }
    }
    const unsigned* las = (const unsigned*)(P.ws + WS_SIDE + 7 * SSLOT); const unsigned* bts = (const unsigned*)(P.ws + WS_SIDE + 5 * SSLOT); unsigned* ygs = (unsigned*)(P.ws + WS_SIDE + 6 * SSLOT);
    const float* hl = P.in[3]; float* lso = P.out + O_LS;
    for (int b = blockIdx.x; b < TS; b += gridDim.x) {
        const size_t ix = (size_t)b * 512 + cp; const unsigned lw = las[ix], bw = bts[ix], yw = ygs[ix];
        const float h0 = __expf(blo(lw)) * hl[b * DM + 2 * cp] + blo(bw), h1 = __expf(bhi(lw)) * hl[b * DM + 2 * cp + 1] + bhi(bw);
        ygs[ix] = pk(h0 * blo(yw), h1 * bhi(yw)); lso[b * DM + 2 * cp] = h0; lso[b * DM + 2 * cp + 1] = h1;
    }
}


#define XB_TMO      128
#define XB_XCNT(j)  (256  + 64 * (j))
#define XB_XSUB(j)  (1280 + 64 * (j))
#define XB_XGEN(j)  (2304 + 64 * (j))
#define XB_TOP      3328
#define XB_TOPGEN   3392
#define XCD_BAR_WORDS 3456
#define XB_SPIN_CAP (1u << 18)
__device__ __forceinline__ unsigned xb_ld(unsigned* p)              { return __hip_atomic_load(p, __ATOMIC_RELAXED, __HIP_MEMORY_SCOPE_AGENT); }
__device__ __forceinline__ unsigned xb_add(unsigned* p, unsigned v) { return __hip_atomic_fetch_add(p, v, __ATOMIC_RELAXED, __HIP_MEMORY_SCOPE_AGENT); }
__device__ __forceinline__ unsigned xb_xcc_id() { return (unsigned)__builtin_amdgcn_s_getreg((3 << 11) | 20) & 0xFu; }
#define XB_SPIN(cond, bar) do { unsigned _sp = 0; while (cond) { __builtin_amdgcn_s_sleep(1); \
    if ((++_sp & 255u) == 0u) { if (xb_ld(&(bar)[XB_TMO])) break; if (_sp > XB_SPIN_CAP) { atomicAdd(&(bar)[XB_TMO], 1u); break; } } } } while (0)
struct XcdBarrier { unsigned* bar; unsigned x; volatile LAS unsigned* st; };
__device__ __forceinline__ XcdBarrier xcd_barrier_post(unsigned* bar, volatile LAS unsigned* st) {
    XcdBarrier b; b.bar = bar; b.x = xb_xcc_id(); b.st = st;
    if (threadIdx.x == 0) (void)xb_add(&bar[XB_XCNT(b.x)], 1u);
    return b;
}
__device__ __forceinline__ void xcd_barrier_complete(unsigned* bar, unsigned x, unsigned& nloc, unsigned& nx) {
    const unsigned G = gridDim.x * gridDim.y * gridDim.z;
    unsigned sum, cnt, mine, sp = 0u;
    for (;;) {
        sum = 0u; cnt = 0u; mine = 0u;
#pragma unroll
        for (unsigned j = 0; j < 16; ++j) { const unsigned c = xb_ld(&bar[XB_XCNT(j)]); sum += c; cnt += (c > 0u) ? 1u : 0u; mine = (j == x) ? c : mine; }
        if (sum == G) break;
        __builtin_amdgcn_s_sleep(1);
        if ((++sp & 255u) == 0u) { if (xb_ld(&bar[XB_TMO])) break; if (sp > XB_SPIN_CAP) { atomicAdd(&bar[XB_TMO], 1u); break; } }
    }
    nloc = mine > 0u ? mine : 1u; nx = cnt > 0u ? cnt : 1u;
}
__device__ __forceinline__ void xcd_barrier(const XcdBarrier& b) {
    asm volatile("s_waitcnt vmcnt(0)" ::: "memory");
    __syncthreads();
    if (threadIdx.x == 0) {
        unsigned* bar = b.bar;
        __builtin_amdgcn_s_waitcnt(0);
        unsigned nloc = b.st[0], nx = b.st[1];
        if (nloc == 0u) { xcd_barrier_complete(bar, b.x, nloc, nx); b.st[0] = nloc; b.st[1] = nx; }
        const unsigned old = xb_add(&bar[XB_XSUB(b.x)], 1u);
        const unsigned gen = old / nloc;
        if (old + 1u == (gen + 1u) * nloc) {
            __builtin_amdgcn_fence(__ATOMIC_RELEASE, "agent");
            asm volatile("s_waitcnt vmcnt(0)" ::: "memory");
            const unsigned og = xb_add(&bar[XB_TOP], 1u);
            const unsigned tg = og / nx;
            if (og + 1u == (tg + 1u) * nx) xb_add(&bar[XB_TOPGEN], 1u);
            else XB_SPIN(xb_ld(&bar[XB_TOPGEN]) == tg, bar);
            __builtin_amdgcn_fence(__ATOMIC_ACQUIRE, "agent");
            xb_add(&bar[XB_XGEN(b.x)], 1u);
            asm volatile("s_waitcnt vmcnt(0)" ::: "memory");
        } else {
            XB_SPIN(xb_ld(&bar[XB_XGEN(b.x)]) == gen, bar);
            __builtin_amdgcn_fence(__ATOMIC_ACQUIRE, "agent");
            asm volatile("s_waitcnt vmcnt(0)" ::: "memory");
        }
    }
    __syncthreads();
}

#define GSYNC() xcd_barrier(xbar)
#define GSYNC_CG() do { asm volatile("s_waitcnt vmcnt(0) lgkmcnt(0)" ::: "memory"); grid.sync(); } while (0)
#ifndef STOP_AT
#define STOP_AT 99
#endif
__device__ __forceinline__ void dumpcp(const unsigned char* src, unsigned char* dst, size_t bytes) {
    for (size_t i = ((size_t)blockIdx.x * 512 + threadIdx.x) * 16; i < bytes; i += (size_t)gridDim.x * 512 * 16) *(u32x4*)(dst + i) = *(const u32x4*)(src + i);
}
#define STOPCHK(n) do { if (STOP_AT == (n)) { if ((n) == 4) { dumpcp(P.ws + WS_R0, (unsigned char*)(P.out + O_HS), 2 * SLOT); dumpcp(P.ws + WS_R2, (unsigned char*)P.out + SLOT, SLOT); }  if ((n) == 2 || (n) == 14) { DEF_PTRS final_norm(X1, P.in[27], P.out + O_YP, P.out + O_YS); } return; } } while (0)
#define DEF_PTRS \
    unsigned char* ws = opq(P.ws); unsigned char* ob = opq((unsigned char*)P.out); (void)ob; \
    u16* Wgu = (u16*)(ws + WS_WGU); u16* Wd = (u16*)(ws + WS_WD); u16* Win = (u16*)(ws + WS_WIN); u16* Wbd = (u16*)(ws + WS_WBD); \
    u16* Waup = (u16*)(ws + WS_WAUP); u16* Wbup = (u16*)(ws + WS_WBUP); u16* Wout = (u16*)(ws + WS_WOUT); \
    float* X1 = (float*)(ws + WS_X1); float* LBv = (float*)(ws + WS_LB); float* LCv = (float*)(ws + WS_LC); \
    const B16 HN = {(u16*)(ws + WS_HN), (u16*)(ws + WS_SIDE + 0 * SSLOT)}; \
    const B16 QS = {(u16*)(ws + WS_R0), (u16*)(ws + WS_SIDE + 1 * SSLOT)}; \
    const B16 LF = {(u16*)(ws + WS_R1), (u16*)(ws + WS_SIDE + 2 * SSLOT)}; \
    const B16 VV = {(u16*)(ws + WS_R2), (u16*)(ws + WS_SIDE + 3 * SSLOT)}; \
    const B16 GS = {(u16*)(ob + O_YP * 4), (u16*)(ws + WS_SIDE + 4 * SSLOT)}; \
    const B16 XR = {(u16*)(ws + WS_R0), (u16*)(ws + WS_SIDE + 5 * SSLOT)}; \
    const B16 YG = {(u16*)(ws + WS_R1), (u16*)(ws + WS_SIDE + 6 * SSLOT)}; \
    const B16 XC = {(u16*)(ws + WS_R2), (u16*)(ws + WS_SIDE + 7 * SSLOT)}; \
    const B16 TA = {(u16*)(ws + WS_R0), (u16*)(ws + WS_SIDE + 8 * SSLOT)}; \
    const B16 GT = {(u16*)(ws + WS_R2), (u16*)(ws + WS_SIDE + 9 * SSLOT)}; \
    const B16 MB = {(u16*)(ob + O_YP * 4) + (size_t)TP * DM, (u16*)(ws + WS_SIDE + 10 * SSLOT)}; \
    const B16 ACT = {(u16*)(ws + WS_R0), (u16*)(ws + WS_ACTS)}; \
    (void)Wgu; (void)Wd; (void)Win; (void)Wbd; (void)Waup; (void)Wbup; (void)Wout; (void)X1; (void)LBv; (void)LCv; \
    (void)HN; (void)QS; (void)LF; (void)VV; (void)GS; (void)XR; (void)YG; (void)XC; (void)TA; (void)GT; (void)MB; (void)ACT;

__global__ void __launch_bounds__(512, 2) mega(Params P) {
    extern __shared__ __attribute__((aligned(16))) unsigned char shm[];
    cg::grid_group grid = cg::this_grid();
    LAS unsigned char* lds = (LAS unsigned char*)shm;
    const int G = gridDim.x, cblk = blockIdx.x;
    volatile LAS unsigned* xst = (volatile LAS unsigned*)(lds + (LDS_BYTES - 16));
    if (threadIdx.x == 0) { xst[0] = 0u; xst[1] = 0u; xst[2] = 0u; xst[3] = 0u; }
    __syncthreads();
    const XcdBarrier xbar = xcd_barrier_post((unsigned*)(P.ws + WS_BAR), xst);

    {
        DEF_PTRS
        float* tile = (float*)shm;
        for (int t = cblk; t < 4928; t += G) {
            if (t < 704) conv_matrix(P.in[6], 1024, 2816, Wgu, 1, t, tile);
            else if (t < 1408) conv_matrix(P.in[7], 1024, 2816, Wgu, 2, t - 704, tile);
            else if (t < 2112) conv_matrix(P.in[8], 2816, 1024, Wd, 0, t - 1408, tile);
            else if (t < 4160) conv_matrix(P.in[10], 1024, 8192, Win, 0, t - 2112, tile);
            else if (t < 4416) conv_matrix(P.in[20], 1024, 1024, Waup, 0, t - 4160, tile);
            else if (t < 4672) conv_matrix(P.in[21], 1024, 1024, Wbup, 0, t - 4416, tile);
            else conv_matrix(P.in[22], 1024, 1024, Wout, 0, t - 4672, tile);
        }
        for (int idx = cblk * 512 + TIDX; idx < 8 * 256 * 256; idx += G * 512) {
            const int n = idx >> 16, row = (idx >> 8) & 255, kk = idx & 255, bj = row >> 7, d = row & 127;
            float v = 0.f; if ((kk >> 7) == (n & 1)) v = (bj ? P.in[17] : P.in[15])[(size_t)n * 16384 + (kk & 127) * 128 + d];
            Wbd[idx] = f2b(v);
        }
        if (cblk == 0) { for (int c = TIDX; c < 1024; c += 512) { LBv[c] = 1.f / (1.f + __expf(P.in[11][1024 + c] - P.in[11][c])); LCv[c] = -8.f * log1pf(__expf(-P.in[19][c])); } }
        norm_rows(P.in[0], P.in[1], P.in[5], HN);
    }
    GSYNC_CG(); STOPCHK(0);
    { DEF_PTRS SchedSimple S{HN.p, HN.s, Wgu, DM, DM, 22, G, cblk, 0}; EpiGU E{ACT}; gemm_phase(lds, DM, DM, S, E); }
    GSYNC(); STOPCHK(1);
    { DEF_PTRS SchedSimple S{ACT.p, ACT.s, Wd, DFF, DFF, 4, G, cblk, 0}; EpiRes E{P.in[0], P.in[1], TS, X1, 0.5f}; gemm_phase(lds, DFF, DFF, S, E); }
    GSYNC(); STOPCHK(2);
    {
        DEF_PTRS
        float* tile = (float*)shm;
        for (int t = cblk; t < 2112; t += G) {
            if (t < 704) conv_matrix(P.in[24], 1024, 2816, Wgu, 1, t, tile);
            else if (t < 1408) conv_matrix(P.in[25], 1024, 2816, Wgu, 2, t - 704, tile);
            else conv_matrix(P.in[26], 2816, 1024, Wd, 0, t - 1408, tile);
        }
        norm_rows(X1, X1 + (size_t)TP * DM, P.in[9], HN);
    }
    GSYNC(); STOPCHK(3);
    { DEF_PTRS SchedSimple S{HN.p, HN.s, Win, DM, DM, 16, G, cblk, 0}; EpiInA E{QS, LF, VV, GS, LBv}; gemm_phase(lds, DM, DM, S, E); }
    GSYNC(); STOPCHK(4);
    hgrn_h1(P, shm);
    GSYNC(); STOPCHK(5);
    hgrn_h2(P);
    GSYNC(); STOPCHK(6);
    hgrn_h3(P, shm);
    GSYNC(); STOPCHK(7);
    { DEF_PTRS SchedSimple S{HN.p, HN.s, Win + (size_t)4096 * DM, DM, DM, 8, G, cblk, 0}; EpiInB E{XR, YG}; gemm_phase(lds, DM, DM, S, E); }
    GSYNC(); STOPCHK(8);
    conv_phase(P); hgrn_sample(P, shm);
    GSYNC(); STOPCHK(9);
    { DEF_PTRS SchedSimple S{XC.p, XC.s, Wbd, DM, 256, 8, G, cblk, 256}; EpiBD E{XC, XR, P.in[16], P.in[18], LCv}; gemm_phase(lds, 256, DM, S, E); }
    GSYNC(); STOPCHK(10);
    lru_pass1(P);
    GSYNC(); STOPCHK(11);
    lru_pass2(P);
    GSYNC(); STOPCHK(12);
    { DEF_PTRS SchedMerge S{HN, GS, YG, Win, Waup, Wbup, G, cblk}; EpiMerge E{GT, TA, MB}; gemm_phase(lds, DM, DM, S, E); }
    GSYNC(); STOPCHK(13);
    { DEF_PTRS SchedSimple S{MB.p, MB.s, Wout, DM, DM, 4, G, cblk, 0}; EpiRes E{X1, X1 + (size_t)TP * DM, 256, X1, 1.0f}; gemm_phase(lds, DM, DM, S, E); }
    GSYNC(); STOPCHK(14);
    { DEF_PTRS norm_rows(X1, X1 + (size_t)TP * DM, P.in[23], HN); }
    GSYNC(); STOPCHK(15);
    { DEF_PTRS SchedSimple S{HN.p, HN.s, Wgu, DM, DM, 22, G, cblk, 0}; EpiGU E{ACT}; gemm_phase(lds, DM, DM, S, E); }
    GSYNC(); STOPCHK(16);
    { DEF_PTRS SchedSimple S{ACT.p, ACT.s, Wd, DFF, DFF, 4, G, cblk, 0}; EpiRes E{X1, X1 + (size_t)TP * DM, 256, X1, 0.5f}; gemm_phase(lds, DFF, DFF, S, E); }
    GSYNC(); STOPCHK(17);
    { DEF_PTRS final_norm(X1, P.in[27], P.out + O_YP, P.out + O_YS); }
}

extern "C" void kernel_launch(void* const* d_in, const int* in_sizes, int n_in, void* d_out, int out_size, void* d_ws, size_t ws_size, hipStream_t stream) {
    static int grid = 0;
    if (grid == 0) {
        int dev = 0, cus = 0, per_cu = 0;
        if (n_in != 28 || ws_size < WS_END) { fprintf(stderr, "kernel_launch: unexpected n_in %d / ws_size %zu (need %zu)\n", n_in, ws_size, (size_t)WS_END); grid = -1; return; }
        (void)hipGetDevice(&dev); (void)hipDeviceGetAttribute(&cus, hipDeviceAttributeMultiprocessorCount, dev);
        if (hipFuncSetAttribute((const void*)mega, hipFuncAttributeMaxDynamicSharedMemorySize, LDS_BYTES) != hipSuccess) { fprintf(stderr, "kernel_launch: hipFuncSetAttribute failed\n"); grid = -1; return; }
        if (hipOccupancyMaxActiveBlocksPerMultiprocessor(&per_cu, (const void*)mega, 512, LDS_BYTES) != hipSuccess || per_cu < 1) { fprintf(stderr, "kernel_launch: occupancy query gave %d\n", per_cu); per_cu = 1; (void)hipGetLastError(); }
        grid = cus * 1;
    }
    if (grid < 0) return;
    Params p{};
    for (int i = 0; i < 28; ++i) p.in[i] = (const float*)d_in[i];
    p.out = (float*)d_out; p.ws = (unsigned char*)d_ws;
    if (hipMemsetAsync((char*)d_ws + WS_BAR, 0, 16384, stream) != hipSuccess) { fprintf(stderr, "kernel_launch: memset failed\n"); return; }
    void* args[] = {&p};
    hipError_t e = hipLaunchCooperativeKernel((void*)mega, dim3(grid), dim3(512), args, LDS_BYTES, stream);
    if (e != hipSuccess) fprintf(stderr, "cooperative launch failed: %s (grid %d)\n", hipGetErrorString(e), grid);
}
```

```cpp
#include <hip/hip_runtime.h>
#include <hip/hip_cooperative_groups.h>
#include <cstdio>
namespace cg = cooperative_groups;

#define LAS __attribute__((address_space(3)))
typedef unsigned short u16;
typedef short bf16x8 __attribute__((ext_vector_type(8)));
typedef float f32x4 __attribute__((ext_vector_type(4)));
typedef unsigned u32x4 __attribute__((ext_vector_type(4)));
typedef unsigned u32x2 __attribute__((ext_vector_type(2)));

constexpr int TP = 16384, TS = 128, NTOK = TP + TS, DM = 1024, DFF = 2816, SEQ = 2048;
constexpr float EPSV = 1e-6f;
constexpr int LDS_BYTES = 147456;

constexpr size_t SLOT = (size_t)TP * DM * 2;
constexpr size_t SSLOT = (size_t)256 * DM * 2;
constexpr size_t WS_WGU = 0;
constexpr size_t WS_WD = WS_WGU + (size_t)5632 * 1024 * 2;
constexpr size_t WS_WIN = WS_WD + (size_t)1024 * 2816 * 2;
constexpr size_t WS_WBD = WS_WIN + (size_t)8192 * 1024 * 2;
constexpr size_t WS_WAUP = WS_WBD + (size_t)8 * 256 * 256 * 2;
constexpr size_t WS_WBUP = WS_WAUP + (size_t)1024 * 1024 * 2;
constexpr size_t WS_WOUT = WS_WBUP + (size_t)1024 * 1024 * 2;
constexpr size_t WS_X1 = WS_WOUT + (size_t)1024 * 1024 * 2;
constexpr size_t WS_HN = WS_X1 + (size_t)16640 * DM * 4;
constexpr size_t WS_R0 = WS_HN + SLOT;
constexpr size_t WS_R1 = WS_R0 + SLOT;
constexpr size_t WS_R2 = WS_R1 + SLOT;
constexpr size_t WS_SIDE = WS_R2 + SLOT;
constexpr size_t WS_ACTS = WS_SIDE + 11 * SSLOT;
constexpr size_t WS_BL = WS_ACTS + (size_t)256 * DFF * 2;
constexpr size_t WS_AGG = WS_BL + (size_t)2048 * 128 * 4;
constexpr size_t WS_LB = WS_AGG + (size_t)256 * 1024 * 8;
constexpr size_t WS_LC = WS_LB + 4096;
constexpr size_t WS_BAR = WS_LC + 4096;
constexpr size_t WS_END = WS_BAR + 16384;
static_assert(WS_END <= (size_t)268435456, "workspace too large");
constexpr size_t O_YP = 0, O_YS = 16777216, O_HP = 16908288, O_LP = 17956864, O_CP = 17965056, O_HS = 17989632, O_LS = 34766848, O_CS = 34897920;

struct Params { const float* in[28]; float* out; unsigned char* ws; };
struct B16 { u16* p; u16* s; };

typedef __bf16 bf16x2_t __attribute__((ext_vector_type(2)));
typedef float f32x2_t __attribute__((ext_vector_type(2)));
__device__ __forceinline__ unsigned pk(float lo, float hi) { const f32x2_t v = {lo, hi}; const bf16x2_t b = __builtin_convertvector(v, bf16x2_t); return __builtin_bit_cast(unsigned, b); }
__device__ __forceinline__ float blo(unsigned w) { return __uint_as_float(w << 16); }
__device__ __forceinline__ float bhi(unsigned w) { return __uint_as_float(w & 0xffff0000u); }
__device__ __forceinline__ float b2f(u16 b) { return __uint_as_float(((unsigned)b) << 16); }
__device__ __forceinline__ u16 f2b(float f) { return (u16)(pk(f, 0.f) & 0xffffu); }
__device__ __forceinline__ float sigm(float x) { return __builtin_amdgcn_rcpf(1.f + __builtin_amdgcn_exp2f(-1.4426950408889634f * x)); }
__device__ __forceinline__ float silu(float x) { return x * __builtin_amdgcn_rcpf(1.f + __builtin_amdgcn_exp2f(-1.4426950408889634f * x)); }
__device__ __forceinline__ float gelu_t(float x) { const float x2 = x * x; const float t = x2 * (-0.10294324f) + (-2.3022082f); return x * __builtin_amdgcn_rcpf(1.f + __builtin_amdgcn_exp2f(x * t)); }
__device__ __forceinline__ unsigned pkh(float lo, float hi) { const _Float16 a = (_Float16)lo, b = (_Float16)hi; return (unsigned)__builtin_bit_cast(u16, a) | ((unsigned)__builtin_bit_cast(u16, b) << 16); }
__device__ __forceinline__ float h2f(u16 h) { return (float)__builtin_bit_cast(_Float16, h); }
__device__ __forceinline__ u32x4 pack8(const float* o) { u32x4 r; r.x = pk(o[0], o[1]); r.y = pk(o[2], o[3]); r.z = pk(o[4], o[5]); r.w = pk(o[6], o[7]); return r; }
__device__ __forceinline__ void unpack8(u32x4 w, float* o) { o[0] = blo(w.x); o[1] = bhi(w.x); o[2] = blo(w.y); o[3] = bhi(w.y); o[4] = blo(w.z); o[5] = bhi(w.z); o[6] = blo(w.w); o[7] = bhi(w.w); }
template <class T> __device__ __forceinline__ T* asg(T* p) { return (T*)(__attribute__((address_space(1))) T*)p; }
__device__ __forceinline__ unsigned char* opq(unsigned char* p) { return p; }
__device__ __forceinline__ int opqv(int v) { asm volatile("" : "+v"(v)); return v; }
#define TIDX opqv((int)threadIdx.x)
struct F8 { f32x4 a, b; };
__device__ __forceinline__ F8 unpack8v(u32x4 w) { F8 r; r.a = (f32x4){blo(w.x), bhi(w.x), blo(w.y), bhi(w.y)}; r.b = (f32x4){blo(w.z), bhi(w.z), blo(w.w), bhi(w.w)}; return r; }
__device__ __forceinline__ u32x4 pack8v(f32x4 a, f32x4 b) { u32x4 r; r.x = pk(a.x, a.y); r.y = pk(a.z, a.w); r.z = pk(b.x, b.y); r.w = pk(b.z, b.w); return r; }
__device__ __forceinline__ u32x4 pack8h(f32x4 a, f32x4 b) { u32x4 r; r.x = pkh(a.x, a.y); r.y = pkh(a.z, a.w); r.z = pkh(b.x, b.y); r.w = pkh(b.z, b.w); return r; }
__device__ __forceinline__ f32x4 sig4(f32x4 v) { return (f32x4){sigm(v.x), sigm(v.y), sigm(v.z), sigm(v.w)}; }
__device__ __forceinline__ f32x4 silu4(f32x4 v) { return (f32x4){silu(v.x), silu(v.y), silu(v.z), silu(v.w)}; }
__device__ __forceinline__ f32x4 gelu4(f32x4 v) { return (f32x4){gelu_t(v.x), gelu_t(v.y), gelu_t(v.z), gelu_t(v.w)}; }
__device__ __forceinline__ f32x4 log4(f32x4 v) { return (f32x4){__logf(v.x), __logf(v.y), __logf(v.z), __logf(v.w)}; }
__device__ __forceinline__ float wave_sum(float v) {
#pragma unroll
    for (int o = 32; o >= 1; o >>= 1) v += __shfl_xor(v, o, 64);
    return v;
}

constexpr int BM = 256, BK = 64, HALF = 128, HTB = HALF * BK * 2;
__device__ __forceinline__ int lds_byte(int r, int c) { const int st = (r >> 4) * 2 + (c >> 5), rr = r & 15, cc = c & 31, ob = rr * 64 + cc * 2; return st * 1024 + (ob ^ (((ob >> 9) & 1) << 5)); }
__device__ __forceinline__ void stage_rc(int b, int& R, int& C) { const int st = b / 1024, sb = b % 1024, swz = sb ^ (((sb >> 9) & 1) << 5); R = (st >> 1) * 16 + swz / 64; C = (st & 1) * 32 + (swz % 64) / 2; }
__device__ __forceinline__ int perm32(int rho) { const int n = rho >> 4, i = rho & 15; return 8 * (i >> 2) + 4 * n + (i & 3); }

struct Unit { int pm, pn, sub; const char* a; const char* b; };

__device__ __forceinline__ bool tile_of(long L, int nM, int nN, int& pm, int& pn) {
    const int nwg = nM * nN; if (L >= nwg) return false;
    int wgid = (int)L; { const int q = nwg / 8, r = nwg % 8, xcd = wgid % 8, off = wgid / 8; wgid = (xcd < r ? xcd * (q + 1) : r * (q + 1) + (xcd - r) * q) + off; }
    const int nig = 8 * nN, gid = wgid / nig, fm = gid * 8, gsz = (nM - fm) < 8 ? (nM - fm) : 8;
    pm = fm + ((wgid % nig) % gsz); pn = (wgid % nig) / gsz; return true;
}

template <class Epi, class Sched>
__device__ __forceinline__ void gemm_phase(LAS unsigned char* lds, const int K, const int lda, const Sched& S, const Epi& E) {
    const int tid = TIDX, wid = __builtin_amdgcn_readfirstlane(tid >> 6), lane = tid & 63, wr = wid >> 2, wc = wid & 3, fr = lane & 15, fq = lane >> 4;
    const int nt = K / BK;
    unsigned voffA[2], voffB[2];
#pragma unroll
    for (int i = 0; i < 2; ++i) { int R, C; stage_rc(tid * 16 + i * 8192, R, C); const int Rb = Epi::PERM ? ((R & ~31) + perm32(R & 31)) : R;
        voffA[i] = (unsigned)(R * lda + C) * 2u; voffB[i] = (unsigned)(Rb * K + C) * 2u; }
    const size_t kstep = (size_t)(BK * 2);
    const size_t hstepA = (size_t)HALF * lda * 2, hstepB = (size_t)HALF * K * 2;
    const unsigned ldsw = (unsigned)wid * 1024u;
    const int aoff = lds_byte(wr * 64 + fr, fq * 8), boff = lds_byte(wc * 32 + fr, fq * 8);
#define G_SA(b, h) (((b) * 2 + (h)) * HTB)
#define G_SB(b, h) ((4 + (b) * 2 + (h)) * HTB)
#define G_STAGE(bufoff, gbase, voff) do { _Pragma("unroll") for (int _i = 0; _i < 2; ++_i) \
        __builtin_amdgcn_global_load_lds((const unsigned*)((const char*)(gbase) + (voff)[_i]), (LAS unsigned*)(lds + (bufoff) + ldsw + _i * 8192), 16, 0, 0); } while (0)
#define G_LDA(dst, b, h) do { _Pragma("unroll") for (int m = 0; m < 4; ++m) _Pragma("unroll") for (int k = 0; k < 2; ++k) dst[m][k] = *(const LAS bf16x8*)(lds + G_SA(b, h) + aoff + m * 2048 + k * 1024); } while (0)
#define G_LDB(dst, b, h) do { _Pragma("unroll") for (int n = 0; n < 2; ++n) _Pragma("unroll") for (int k = 0; k < 2; ++k) dst[n][k] = *(const LAS bf16x8*)(lds + G_SB(b, h) + boff + n * 2048 + k * 1024); } while (0)
#define G_MMA(ai, bj, At, Bt) do { __builtin_amdgcn_s_setprio(1); _Pragma("unroll") for (int m = 0; m < 4; ++m) _Pragma("unroll") for (int n = 0; n < 2; ++n) _Pragma("unroll") for (int k = 0; k < 2; ++k) \
        acc[ai][bj][m][n] = __builtin_amdgcn_mfma_f32_16x16x32_bf16(Bt[n][k], At[m][k], acc[ai][bj][m][n], 0, 0, 0); __builtin_amdgcn_s_setprio(0); } while (0)
#define G_WAIT_V(n) asm volatile("s_waitcnt vmcnt(" #n ")" ::: "memory")
#define G_WAIT_L(n) asm volatile("s_waitcnt lgkmcnt(" #n ")" ::: "memory")
#define G_BAR __builtin_amdgcn_s_barrier()
#define G_SCHED __builtin_amdgcn_sched_barrier(0)
    Unit cur, nxt; int ui = 0;
    if (!S.next(0, cur)) return;
    f32x4 acc[2][2][4][2];
#pragma unroll
    for (int a = 0; a < 2; ++a)
#pragma unroll
        for (int b = 0; b < 2; ++b)
#pragma unroll
            for (int m = 0; m < 4; ++m)
#pragma unroll
                for (int n = 0; n < 2; ++n) acc[a][b][m][n] = (f32x4){0.f, 0.f, 0.f, 0.f};
    bf16x8 At[4][2], B0[2][2], B1[2][2];
    const char* cA = cur.a; const char* cB = cur.b;
    G_STAGE(G_SB(0, 0), cB, voffB); G_STAGE(G_SA(0, 0), cA, voffA); G_STAGE(G_SB(0, 1), cB + hstepB, voffB); G_STAGE(G_SA(0, 1), cA + hstepA, voffA);
    if (wr == 1) G_BAR;
    G_WAIT_V(4); G_BAR;
    G_STAGE(G_SB(1, 0), cB + kstep, voffB); G_STAGE(G_SA(1, 0), cA + kstep, voffA); G_STAGE(G_SB(1, 1), cB + hstepB + kstep, voffB);
    G_WAIT_V(6); G_BAR;
    for (;;) {
        const bool has_next = S.next(ui + 1, nxt);
        const char* nA = has_next ? nxt.a : cA; const char* nB = has_next ? nxt.b : cB;
        for (int t = 0; t < nt; t += 2) {
            const bool last = (t == nt - 2);
            const char* a1 = cA + (size_t)(t + 1) * kstep;
            const char* a2 = last ? nA : cA + (size_t)(t + 2) * kstep; const char* b2 = last ? nB : cB + (size_t)(t + 2) * kstep;
            const char* a3 = a2 + kstep; const char* b3 = b2 + kstep;
            G_LDB(B0, 0, 0); G_SCHED; G_LDA(At, 0, 0); G_STAGE(G_SA(1, 1), a1 + hstepA, voffA);
            G_WAIT_L(8); G_BAR; G_WAIT_L(0); G_MMA(0, 0, At, B0); G_BAR; G_SCHED;
            G_LDB(B1, 0, 1); G_STAGE(G_SB(0, 0), b2, voffB);
            G_BAR; G_WAIT_L(0); G_MMA(0, 1, At, B1); G_BAR;
            G_LDA(At, 0, 1); G_STAGE(G_SA(0, 0), a2, voffA);
            G_BAR; G_WAIT_L(0); G_MMA(1, 0, At, B0); G_BAR; G_SCHED;
            G_STAGE(G_SB(0, 1), b2 + hstepB, voffB);
            G_WAIT_V(6); G_BAR; G_MMA(1, 1, At, B1); G_BAR;
            G_LDB(B0, 1, 0); G_SCHED; G_LDA(At, 1, 0); G_STAGE(G_SA(0, 1), a2 + hstepA, voffA);
            G_WAIT_L(8); G_BAR; G_WAIT_L(0); G_MMA(0, 0, At, B0); G_BAR; G_SCHED;
            G_LDB(B1, 1, 1); G_STAGE(G_SB(1, 0), b3, voffB);
            G_BAR; G_WAIT_L(0); G_MMA(0, 1, At, B1); G_BAR;
            G_LDA(At, 1, 1); G_STAGE(G_SA(1, 0), a3, voffA);
            G_BAR; G_WAIT_L(0); G_MMA(1, 0, At, B0); G_BAR; G_SCHED;
            G_STAGE(G_SB(1, 1), b3 + hstepB, voffB);
            G_WAIT_V(6); G_BAR; G_MMA(1, 1, At, B1); G_BAR;
        }
        E(acc, cur, wr, wc, fr, fq);
        if (!has_next) break;
#pragma unroll
        for (int a = 0; a < 2; ++a)
#pragma unroll
            for (int b = 0; b < 2; ++b)
#pragma unroll
                for (int m = 0; m < 4; ++m)
#pragma unroll
                    for (int n = 0; n < 2; ++n) acc[a][b][m][n] = (f32x4){0.f, 0.f, 0.f, 0.f};
        cur = nxt; cA = nA; cB = nB; ++ui;
    }
    G_WAIT_V(0);
    if (wr == 0) G_BAR;
    G_BAR;
#undef G_SA
#undef G_SB
#undef G_STAGE
#undef G_LDA
#undef G_LDB
#undef G_MMA
#undef G_WAIT_V
#undef G_WAIT_L
#undef G_BAR
#undef G_SCHED
}

struct SchedSimple {
    const u16* Ap; const u16* As; const u16* Bt; int lda, K, nN, G, c; int acol_per_pn;
    __device__ __forceinline__ bool next(int i, Unit& u) const {
        int pm, pn; if (!tile_of((long)i * G + c, 64, nN, pm, pn)) return false;
        u.pm = pm; u.pn = pn; u.sub = 0;
        u.a = (const char*)((pm < 64 ? Ap + (size_t)pm * 256 * lda : As) + (size_t)(pn >> 1) * acol_per_pn);
        u.b = (const char*)(Bt + (size_t)pn * 256 * K); return true;
    }
};
struct SchedMerge {
    B16 hn, oa, ob; const u16* Win; const u16* Waup; const u16* Wbup; int G, c;
    __device__ __forceinline__ bool next(int i, Unit& u) const {
        int pm, pn; if (!tile_of((long)(i >> 2) * G + c, 64, 4, pm, pn)) return false;
        const int sub = i & 3; u.pm = pm; u.pn = pn; u.sub = sub;
        const unsigned long long m1 = (sub == 1) ? ~0ull : 0ull, m3 = (sub == 3) ? ~0ull : 0ull, m0 = ~(m1 | m3);
        const u16* abp = (const u16*)(((unsigned long long)oa.p & m1) | ((unsigned long long)ob.p & m3) | ((unsigned long long)hn.p & m0));
        const u16* abs_ = (const u16*)(((unsigned long long)oa.s & m1) | ((unsigned long long)ob.s & m3) | ((unsigned long long)hn.s & m0));
        const u16* bb = (const u16*)(((unsigned long long)Waup & m1) | ((unsigned long long)Wbup & m3) | ((unsigned long long)(Win + (size_t)(sub == 0 ? 6144 : 7168) * DM) & m0));
        u.a = (const char*)(pm < 64 ? abp + (size_t)pm * 256 * DM : abs_);
        u.b = (const char*)(bb + (size_t)pn * 256 * DM); return true;
    }
};

struct EpiGU {
    static constexpr bool PERM = true; B16 act;
    __device__ __forceinline__ void operator()(const f32x4 (&acc)[2][2][4][2], const Unit& u, int wr, int wc, int fr, int fq) const {
        u16* base = (u.pm < 64 ? act.p + (size_t)u.pm * 256 * DFF : act.s) + u.pn * 128 + wc * 32 + 8 * fq;
#pragma unroll
        for (int ai = 0; ai < 2; ++ai)
#pragma unroll
            for (int m = 0; m < 4; ++m) {
                const int rt = ai * 128 + wr * 64 + m * 16 + fr; float o[8];
#pragma unroll
                for (int n = 0; n < 2; ++n)
#pragma unroll
                    for (int j = 0; j < 4; ++j) o[n * 4 + j] = silu(acc[ai][0][m][n][j]) * acc[ai][1][m][n][j];
                *(u32x4*)(base + (size_t)rt * DFF) = pack8(o);
            }
    }
};
struct EpiRes {
    static constexpr bool PERM = false; const float* rp; const float* rs; int ns; float* out; float scale;
    __device__ __forceinline__ void operator()(const f32x4 (&acc)[2][2][4][2], const Unit& u, int wr, int wc, int fr, int fq) const {
        const int col0 = u.pn * 256 + wc * 32 + 4 * fq;
#pragma unroll
        for (int ai = 0; ai < 2; ++ai)
#pragma unroll
            for (int m = 0; m < 4; ++m) {
                const int rt = ai * 128 + wr * 64 + m * 16 + fr; const int row = u.pm * 256 + rt;
                const float* r = (u.pm < 64) ? rp + (size_t)row * DM : rs + (size_t)rt * DM; const bool valid = (u.pm < 64) || (rt < ns);
                float* o = out + (size_t)row * DM;
#pragma unroll
                for (int bj = 0; bj < 2; ++bj)
#pragma unroll
                    for (int n = 0; n < 2; ++n) { const int c = col0 + bj * 128 + n * 16; f32x4 rv = (f32x4){0.f, 0.f, 0.f, 0.f}; if (valid) rv = *(const f32x4*)(r + c);
                        *(f32x4*)(o + c) = rv + scale * acc[ai][bj][m][n]; }
                asm volatile("" ::: "memory");
            }
    }
};
template <int MODE> __device__ __forceinline__ void ina_store(u16* base, const f32x4 (&acc)[2][2][4][2], const float* lbp) {
#pragma unroll
    for (int bj = 0; bj < 2; ++bj) {
        f32x4 l0 = (f32x4){0.f, 0.f, 0.f, 0.f}, l1 = l0;
        if (MODE == 1) { l0 = *(const f32x4*)(lbp + bj * 128); l1 = *(const f32x4*)(lbp + bj * 128 + 4); }
#pragma unroll
        for (int ai = 0; ai < 2; ++ai)
#pragma unroll
            for (int m = 0; m < 4; ++m) {
                u16* d = base + (size_t)(ai * 128 + m * 16) * DM + bj * 128;
                if (MODE == 1) { const f32x4 f0 = l0 + (1.f - l0) * sig4(acc[ai][bj][m][0]), f1 = l1 + (1.f - l1) * sig4(acc[ai][bj][m][1]); *(u32x4*)d = pack8h(log4(f0), log4(f1)); }
                else if (MODE == 2) *(u32x4*)d = pack8v(acc[ai][bj][m][0], acc[ai][bj][m][1]);
                else *(u32x4*)d = pack8v(silu4(acc[ai][bj][m][0]), silu4(acc[ai][bj][m][1]));
            }
    }
}
struct EpiInA {
    static constexpr bool PERM = true; B16 qs, lf, v, gs; const float* lbv;
    __device__ __forceinline__ void operator()(const f32x4 (&acc)[2][2][4][2], const Unit& u, int wr, int wc, int fr, int fq) const {
        const int seg = u.pn >> 2, cs = (u.pn & 3) * 256 + wc * 32 + 8 * fq;
        const size_t ro = cs + (size_t)(wr * 64 + fr) * DM; const size_t po = (size_t)u.pm * 256 * DM; const bool pr = u.pm < 64;
        if (seg == 0) { u16* qp = qs.p; u16* qsm = qs.s; ina_store<0>((pr ? qp + po : qsm) + ro, acc, lbv); }
        else if (seg == 1) { u16* qp = lf.p; u16* qsm = lf.s; ina_store<1>((pr ? qp + po : qsm) + ro, acc, lbv + cs); }
        else if (seg == 2) { u16* qp = v.p; u16* qsm = v.s; ina_store<2>((pr ? qp + po : qsm) + ro, acc, lbv); }
        else { u16* qp = gs.p; u16* qsm = gs.s; ina_store<0>((pr ? qp + po : qsm) + ro, acc, lbv); }
    }
};
struct EpiNull { static constexpr bool PERM = true; float* sink;
    __device__ __forceinline__ void operator()(const f32x4 (&acc)[2][2][4][2], const Unit& u, int wr, int wc, int fr, int fq) const {
        float t = 0.f;
#pragma unroll
        for (int ai = 0; ai < 2; ++ai)
#pragma unroll
            for (int bj = 0; bj < 2; ++bj)
#pragma unroll
                for (int m = 0; m < 4; ++m)
#pragma unroll
                    for (int n = 0; n < 2; ++n) t += acc[ai][bj][m][n].x + acc[ai][bj][m][n].y + acc[ai][bj][m][n].z + acc[ai][bj][m][n].w;
        if (t == 12345.678f) sink[0] = t;
    }
};
struct EpiInB {
    static constexpr bool PERM = true; B16 xr, yg;
    __device__ __forceinline__ void operator()(const f32x4 (&acc)[2][2][4][2], const Unit& u, int wr, int wc, int fr, int fq) const {
        const int seg = u.pn >> 2, cs = (u.pn & 3) * 256 + wc * 32 + 8 * fq;
        u16* base = (u.pm < 64 ? (seg == 0 ? +xr.p : +yg.p) + (size_t)u.pm * 256 * DM : (seg == 0 ? +xr.s : +yg.s)) + cs + (size_t)(wr * 64 + fr) * DM;
        if (seg == 0) {
#pragma unroll
            for (int ai = 0; ai < 2; ++ai)
#pragma unroll
                for (int m = 0; m < 4; ++m)
#pragma unroll
                    for (int bj = 0; bj < 2; ++bj) *(u32x4*)(base + (size_t)(ai * 128 + m * 16) * DM + bj * 128) = pack8v(acc[ai][bj][m][0], acc[ai][bj][m][1]);
        } else {
#pragma unroll
            for (int ai = 0; ai < 2; ++ai)
#pragma unroll
                for (int m = 0; m < 4; ++m)
#pragma unroll
                    for (int bj = 0; bj < 2; ++bj) *(u32x4*)(base + (size_t)(ai * 128 + m * 16) * DM + bj * 128) = pack8v(gelu4(acc[ai][bj][m][0]), gelu4(acc[ai][bj][m][1]));
        }
    }
};
__device__ __forceinline__ f32x4 nexpm1_4(f32x4 x) { const f32x4 p = 1.f + x * (0.5f + x * (0.16666667f + x * (0.041666668f + x * (0.008333334f + x * 0.0013888889f)))); return -x * p; }
__device__ __forceinline__ f32x4 sqrt4(f32x4 v) { return (f32x4){sqrtf(fmaxf(v.x, 0.f)), sqrtf(fmaxf(v.y, 0.f)), sqrtf(fmaxf(v.z, 0.f)), sqrtf(fmaxf(v.w, 0.f))}; }
struct EpiBD {
    static constexpr bool PERM = true; B16 xc, bt; const float* ba; const float* bx; const float* lc;
    __device__ __forceinline__ void operator()(const f32x4 (&acc)[2][2][4][2], const Unit& u, int wr, int wc, int fr, int fq) const {
        const int ch = u.pn * 128 + wc * 32 + 8 * fq;
        u16* xb = (u.pm < 64 ? xc.p + (size_t)u.pm * 256 * DM : xc.s) + ch + (size_t)(wr * 64 + fr) * DM; u16* bb = (u.pm < 64 ? bt.p + (size_t)u.pm * 256 * DM : bt.s) + ch + (size_t)(wr * 64 + fr) * DM;
#pragma unroll
        for (int n = 0; n < 2; ++n) {
            const f32x4 cba = *(const f32x4*)(ba + ch + 4 * n), cbx = *(const f32x4*)(bx + ch + 4 * n), cl = *(const f32x4*)(lc + ch + 4 * n);
#pragma unroll
            for (int ai = 0; ai < 2; ++ai)
#pragma unroll
                for (int m = 0; m < 4; ++m) {
                    const size_t off = (size_t)(ai * 128 + m * 16) * DM + 4 * n;
                    const u32x2 xw = *(const u32x2*)(xb + off); const f32x4 xv = (f32x4){blo(xw.x), bhi(xw.x), blo(xw.y), bhi(xw.y)};
                    const f32x4 r = sig4(acc[ai][0][m][n] + cba), ig = sig4(acc[ai][1][m][n] + cbx);
                    const f32x4 la = r * cl; const f32x4 bo = sqrt4(nexpm1_4(2.f * la)) * ig * xv;
                    u32x2 o1, o2; o1.x = pk(la.x, la.y); o1.y = pk(la.z, la.w); o2.x = pk(bo.x, bo.y); o2.y = pk(bo.z, bo.w);
                    *(u32x2*)(xb + off) = o1; *(u32x2*)(bb + off) = o2;
                    if (m & 1) asm volatile("" ::: "memory");
                }
        }
    }
};
struct EpiMerge {
    static constexpr bool PERM = true; B16 gt, ta, mb;
    __device__ __forceinline__ void operator()(const f32x4 (&acc)[2][2][4][2], const Unit& u, int wr, int wc, int fr, int fq) const {
        const size_t ro = ((u.pm < 64) ? (size_t)u.pm * 256 * DM : 0) + u.pn * 256 + wc * 32 + 8 * fq + (size_t)(wr * 64 + fr) * DM;
        u16* g = (u.pm < 64 ? +gt.p : +gt.s) + ro; u16* t = (u.pm < 64 ? +ta.p : +ta.s) + ro; u16* mo = (u.pm < 64 ? +mb.p : +mb.s) + ro;
        const int sub = u.sub;
        if (sub == 0 || sub == 2) {
#pragma unroll
            for (int ai = 0; ai < 2; ++ai)
#pragma unroll
                for (int m = 0; m < 4; ++m)
#pragma unroll
                    for (int bj = 0; bj < 2; ++bj) *(u32x4*)(g + (size_t)(ai * 128 + m * 16) * DM + bj * 128) = pack8v(sig4(acc[ai][bj][m][0]), sig4(acc[ai][bj][m][1]));
        } else if (sub == 1) {
#pragma unroll
            for (int ai = 0; ai < 2; ++ai)
#pragma unroll
                for (int m = 0; m < 4; ++m)
#pragma unroll
                    for (int bj = 0; bj < 2; ++bj) { const size_t off = (size_t)(ai * 128 + m * 16) * DM + bj * 128; const F8 gv = unpack8v(*(const u32x4*)(g + off));
                        *(u32x4*)(t + off) = pack8v(gv.a * acc[ai][bj][m][0], gv.b * acc[ai][bj][m][1]); if (bj) asm volatile("" ::: "memory"); }
        } else {
#pragma unroll
            for (int ai = 0; ai < 2; ++ai)
#pragma unroll
                for (int m = 0; m < 4; ++m)
#pragma unroll
                    for (int bj = 0; bj < 2; ++bj) { const size_t off = (size_t)(ai * 128 + m * 16) * DM + bj * 128; const F8 gv = unpack8v(*(const u32x4*)(g + off)), tv = unpack8v(*(const u32x4*)(t + off));
                        *(u32x4*)(mo + off) = pack8v(tv.a + gv.a * acc[ai][bj][m][0], tv.b + gv.b * acc[ai][bj][m][1]); if (bj) asm volatile("" ::: "memory"); }
        }
    }
};

__device__ __forceinline__ void tconv_tile(const float* src, int N, int K, int kt, int nt, u16* dst, int mode, float* tile) {
    const int tid = TIDX;
    const int c4 = (tid & 15) * 4;
#pragma unroll
    for (int p = 0; p < 2; ++p) { const int r = (tid >> 4) + 32 * p; const f32x4 v = *(const f32x4*)(src + (size_t)(kt * 64 + r) * N + nt * 64 + c4);
        tile[r * 65 + c4] = v.x; tile[r * 65 + c4 + 1] = v.y; tile[r * 65 + c4 + 2] = v.z; tile[r * 65 + c4 + 3] = v.w; }
    __syncthreads();
    const int n = tid >> 3, k8 = (tid & 7) * 8; float f[8];
#pragma unroll
    for (int j = 0; j < 8; ++j) f[j] = tile[(k8 + j) * 65 + n];
    const int ng = nt * 64 + n; const int drow = mode == 0 ? ng : ((ng >> 7) * 256 + (mode == 2 ? 128 : 0) + (ng & 127));
    *(u32x4*)(dst + (size_t)drow * K + kt * 64 + k8) = pack8(f);
    __syncthreads();
}
__device__ __forceinline__ void conv_matrix(const float* src, int K, int N, u16* dst, int mode, int t, float* tile) {
    const int ntn = N / 64; tconv_tile(src, N, K, t / ntn, t % ntn, dst, mode, tile);
}
__device__ __forceinline__ void norm_rows(const float* sp, const float* ss, const float* gain, B16 dst) {
    const int lane = TIDX & 63, gw = blockIdx.x * 8 + (TIDX >> 6), nw = gridDim.x * 8;
    f32x4 g[4];
#pragma unroll
    for (int i = 0; i < 4; ++i) g[i] = *(const f32x4*)(gain + i * 256 + lane * 4);
    for (int row = gw; row < NTOK; row += nw) {
        const float* src = row < TP ? sp + (size_t)row * DM : ss + (size_t)(row - TP) * DM;
        f32x4 v[4]; float s = 0.f;
#pragma unroll
        for (int i = 0; i < 4; ++i) { v[i] = *(const f32x4*)(src + i * 256 + lane * 4); s += v[i].x * v[i].x + v[i].y * v[i].y + v[i].z * v[i].z + v[i].w * v[i].w; }
        s = wave_sum(s); const float rs = rsqrtf(s * (1.f / DM) + EPSV);
        u16* d = (row < TP ? dst.p + (size_t)row * DM : dst.s + (size_t)(row - TP) * DM);
#pragma unroll
        for (int i = 0; i < 4; ++i) { u32x2 w; w.x = pk(v[i].x * rs * g[i].x, v[i].y * rs * g[i].y); w.y = pk(v[i].z * rs * g[i].z, v[i].w * rs * g[i].w); *(u32x2*)(d + i * 256 + lane * 4) = w; }
    }
}
__device__ __forceinline__ void final_norm(const float* x, const float* gain, float* yp, float* ys) {
    const int lane = TIDX & 63, gw = blockIdx.x * 8 + (TIDX >> 6), nw = gridDim.x * 8;
    f32x4 g[4];
#pragma unroll
    for (int i = 0; i < 4; ++i) g[i] = *(const f32x4*)(gain + i * 256 + lane * 4);
    for (int row = gw; row < NTOK; row += nw) {
        const float* src = x + (size_t)row * DM;
        f32x4 v[4]; float s = 0.f;
#pragma unroll
        for (int i = 0; i < 4; ++i) { v[i] = *(const f32x4*)(src + i * 256 + lane * 4); s += v[i].x * v[i].x + v[i].y * v[i].y + v[i].z * v[i].z + v[i].w * v[i].w; }
        s = wave_sum(s); const float rs = rsqrtf(s * (1.f / DM) + EPSV);
        float* d = row < TP ? yp + (size_t)row * DM : ys + (size_t)(row - TP) * DM;
#pragma unroll
        for (int i = 0; i < 4; ++i) *(f32x4*)(d + i * 256 + lane * 4) = v[i] * rs * g[i];
    }
}

constexpr int L_BL = 0, L_TOT = 32768, L_RED = 34816, L_QE = 35328, L_KE = 52736, L_VT = 70144, L_AM = 88576, L_ST = 97792;
constexpr int QS_ = 136, VS_ = 72;

__device__ __forceinline__ void load_lf_chunk(const u16* lfp, int row0, int h, float* bL) {
    const int tid = TIDX, r = tid >> 3, seg = tid & 7;
    const u16* p = lfp + (size_t)(row0 + r) * DM + h * 128 + seg * 16;
    const u32x4 w0 = *(const u32x4*)p, w1 = *(const u32x4*)(p + 8);
    float* d = bL + r * 128 + seg * 16;
    const unsigned ws[8] = {w0.x, w0.y, w0.z, w0.w, w1.x, w1.y, w1.z, w1.w};
#pragma unroll
    for (int i = 0; i < 8; ++i) { d[2 * i] = h2f((u16)(ws[i] & 0xffffu)); d[2 * i + 1] = h2f((u16)(ws[i] >> 16)); }
}
__device__ __forceinline__ void load_vT(const u16* vp, int row0, int h, u16* vT) {
    const int tid = TIDX, s = tid >> 3, seg = tid & 7;
    const u16* p = vp + (size_t)(row0 + s) * DM + h * 128 + seg * 16;
    const u32x4 w0 = *(const u32x4*)p, w1 = *(const u32x4*)(p + 8);
    const unsigned ws[8] = {w0.x, w0.y, w0.z, w0.w, w1.x, w1.y, w1.z, w1.w};
#pragma unroll
    for (int i = 0; i < 8; ++i) { vT[(seg * 16 + 2 * i) * VS_ + s] = (u16)(ws[i] & 0xffffu); vT[(seg * 16 + 2 * i + 1) * VS_ + s] = (u16)(ws[i] >> 16); }
}

__device__ __forceinline__ void hgrn_h1(const Params& P, unsigned char* sm) {
    float* bL = (float*)(sm + L_BL); float* tot = (float*)(sm + L_TOT); u16* kdT = (u16*)(sm + L_QE); u16* vT = (u16*)(sm + L_VT);
    const u16* lfp = (const u16*)(P.ws + WS_R1); const u16* vp = (const u16*)(P.ws + WS_R2);
    u16* Sb = (u16*)(P.out + O_HS); float* BLg = (float*)(P.ws + WS_BL);
    const int tid = TIDX, lane = tid & 63, w = tid >> 6, fr = lane & 15, fq = lane >> 4;
    for (int item = blockIdx.x; item < 2048; item += gridDim.x) {
        const int h = item & 7, c = (item >> 3) & 31, b = item >> 8; const int row0 = b * SEQ + c * 64;
        const int sidx = (b * 8 + h) * 32 + c;
        load_lf_chunk(lfp, row0, h, bL); load_vT(vp, row0, h, vT);
        __syncthreads();
        const int col = tid & 127, part = tid >> 7; float lf[16]; float run = 0.f;
#pragma unroll
        for (int i = 0; i < 16; ++i) { lf[i] = bL[(part * 16 + i) * 128 + col]; run += lf[i]; }
        tot[part * 128 + col] = run;
        __syncthreads();
        float off = 0.f, bl = 0.f;
#pragma unroll
        for (int p = 0; p < 4; ++p) { const float t = tot[p * 128 + col]; bl += t; if (p < part) off += t; }
        if (part == 0) BLg[(size_t)sidx * 128 + col] = bl;
        float bc = off;
#pragma unroll
        for (int i = 0; i < 16; ++i) { bc += lf[i]; const float kd = (1.f - __expf(lf[i])) * __expf(bl - bc); kdT[col * VS_ + part * 16 + i] = f2b(kd); }
        __syncthreads();
        bf16x8 av[2];
#pragma unroll
        for (int ks = 0; ks < 2; ++ks) av[ks] = *(const bf16x8*)(vT + (16 * w + fr) * VS_ + ks * 32 + 8 * fq);
        u16* so = Sb + (size_t)sidx * 16384 + (16 * w + fr) * 128 + 4 * fq;
#pragma unroll
        for (int nt = 0; nt < 8; ++nt) {
            f32x4 acc = (f32x4){0.f, 0.f, 0.f, 0.f};
#pragma unroll
            for (int ks = 0; ks < 2; ++ks) { const bf16x8 bk = *(const bf16x8*)(kdT + (16 * nt + fr) * VS_ + ks * 32 + 8 * fq); acc = __builtin_amdgcn_mfma_f32_16x16x32_bf16(bk, av[ks], acc, 0, 0, 0); }
            u32x2 o; o.x = pk(acc.x, acc.y); o.y = pk(acc.z, acc.w); *(u32x2*)(so + 16 * nt) = o;
        }
        __syncthreads();
    }
}
__device__ __forceinline__ void hgrn_h2(const Params& P) {
    u16* Sb = (u16*)(P.out + O_HS); const float* BLg = (const float*)(P.ws + WS_BL); float* hp = P.out + O_HP;
    for (int g = blockIdx.x * 512 + TIDX; g < 64 * 2048; g += gridDim.x * 512) {
        const int bh = g >> 11, e = (g & 2047) * 8, dv = e >> 7, dk = e & 127;
        float S[8];
#pragma unroll
        for (int j = 0; j < 8; ++j) S[j] = 0.f;
        u16* sp = Sb + (size_t)bh * 32 * 16384 + e; const float* blp = BLg + (size_t)bh * 32 * 128 + dk;
#pragma unroll 4
        for (int c = 0; c < 32; ++c) {
            const u32x4 lw = *(const u32x4*)(sp + (size_t)c * 16384); const f32x4 d0 = *(const f32x4*)(blp + c * 128), d1 = *(const f32x4*)(blp + c * 128 + 4);
            float sl[8]; unpack8(lw, sl);
            *(u32x4*)(sp + (size_t)c * 16384) = pack8(S);
            const float dd[8] = {d0.x, d0.y, d0.z, d0.w, d1.x, d1.y, d1.z, d1.w};
#pragma unroll
            for (int j = 0; j < 8; ++j) S[j] = __expf(dd[j]) * S[j] + sl[j];
        }
        float* o = hp + (size_t)bh * 16384 + dv;
#pragma unroll
        for (int j = 0; j < 8; ++j) o[(size_t)(dk + j) * 128] = S[j];
    }
}
__device__ __forceinline__ void hgrn_h3(const Params& P, unsigned char* sm) {
    float* bL = (float*)(sm + L_BL); float* tot = (float*)(sm + L_TOT); float* red = (float*)(sm + L_RED);
    u16* qe = (u16*)(sm + L_QE); u16* ke = (u16*)(sm + L_KE); u16* vT = (u16*)(sm + L_VT); u16* Am = (u16*)(sm + L_AM); u16* ST = (u16*)(sm + L_ST);
    const u16* qsp = (const u16*)(P.ws + WS_R0); const u16* lfp = (const u16*)(P.ws + WS_R1); const u16* vp = (const u16*)(P.ws + WS_R2);
    u16* gsp = (u16*)(P.out + O_YP);
    const u16* Sb = (const u16*)(P.out + O_HS); const float* onorm = P.in[12];
    const int tid = TIDX, lane = tid & 63, w = tid >> 6, fr = lane & 15, fq = lane >> 4;
    for (int item = blockIdx.x; item < 2048; item += gridDim.x) {
        const int h = item & 7, c = (item >> 3) & 31, b = item >> 8; const int row0 = b * SEQ + c * 64;
        const int sidx = (b * 8 + h) * 32 + c;
        load_lf_chunk(lfp, row0, h, bL); load_vT(vp, row0, h, vT);
        { const u16* sp = Sb + (size_t)sidx * 16384;
#pragma unroll
          for (int p = 0; p < 4; ++p) { const int idx = tid + 512 * p, dv = idx >> 4, k8 = (idx & 15) * 8; *(u32x4*)(ST + dv * QS_ + k8) = *(const u32x4*)(sp + dv * 128 + k8); } }
        __syncthreads();
        const int col = tid & 127, part = tid >> 7; float lf[16]; float run = 0.f;
#pragma unroll
        for (int i = 0; i < 16; ++i) { lf[i] = bL[(part * 16 + i) * 128 + col]; run += lf[i]; }
        tot[part * 128 + col] = run;
        __syncthreads();
        float off = 0.f;
#pragma unroll
        for (int p = 0; p < 4; ++p) { const float t = tot[p * 128 + col]; if (p < part) off += t; }
        float bc = off; const u16* qp = qsp + (size_t)(row0 + part * 16) * DM + h * 128 + col;
#pragma unroll
        for (int i = 0; i < 16; ++i) { bc += lf[i]; const float q = b2f(qp[(size_t)i * DM]);
            qe[(part * 16 + i) * QS_ + col] = f2b(q * __expf(bc)); ke[(part * 16 + i) * QS_ + col] = f2b((1.f - __expf(lf[i])) * __expf(-bc)); }
        __syncthreads();
        {
            const int mt = w & 3;
            bf16x8 aq[4];
#pragma unroll
            for (int ks = 0; ks < 4; ++ks) aq[ks] = *(const bf16x8*)(qe + (16 * mt + fr) * QS_ + ks * 32 + 8 * fq);
#pragma unroll
            for (int t = 0; t < 2; ++t) { const int nt = (w >> 2) * 2 + t; f32x4 acc = (f32x4){0.f, 0.f, 0.f, 0.f};
#pragma unroll
                for (int ks = 0; ks < 4; ++ks) { const bf16x8 bk = *(const bf16x8*)(ke + (16 * nt + fr) * QS_ + ks * 32 + 8 * fq); acc = __builtin_amdgcn_mfma_f32_16x16x32_bf16(bk, aq[ks], acc, 0, 0, 0); }
                const int cr = 16 * mt + fr, s0 = 16 * nt + 4 * fq;
                u32x2 o; o.x = pk(cr >= s0 ? acc.x : 0.f, cr >= s0 + 1 ? acc.y : 0.f); o.y = pk(cr >= s0 + 2 ? acc.z : 0.f, cr >= s0 + 3 ? acc.w : 0.f);
                *(u32x2*)(Am + cr * VS_ + s0) = o; }
        }
        __syncthreads();
        {
            const int mt = w & 3, nh = w >> 2;
            bf16x8 aq[4], aa[2];
#pragma unroll
            for (int ks = 0; ks < 4; ++ks) aq[ks] = *(const bf16x8*)(qe + (16 * mt + fr) * QS_ + ks * 32 + 8 * fq);
#pragma unroll
            for (int ks = 0; ks < 2; ++ks) aa[ks] = *(const bf16x8*)(Am + (16 * mt + fr) * VS_ + ks * 32 + 8 * fq);
            f32x4 acc[4]; float ssq = 0.f;
#pragma unroll
            for (int t = 0; t < 4; ++t) { const int dt = nh * 4 + t; acc[t] = (f32x4){0.f, 0.f, 0.f, 0.f};
#pragma unroll
                for (int ks = 0; ks < 4; ++ks) { const bf16x8 bk = *(const bf16x8*)(ST + (16 * dt + fr) * QS_ + ks * 32 + 8 * fq); acc[t] = __builtin_amdgcn_mfma_f32_16x16x32_bf16(bk, aq[ks], acc[t], 0, 0, 0); }
#pragma unroll
                for (int ks = 0; ks < 2; ++ks) { const bf16x8 bk = *(const bf16x8*)(vT + (16 * dt + fr) * VS_ + ks * 32 + 8 * fq); acc[t] = __builtin_amdgcn_mfma_f32_16x16x32_bf16(bk, aa[ks], acc[t], 0, 0, 0); }
                ssq += acc[t].x * acc[t].x + acc[t].y * acc[t].y + acc[t].z * acc[t].z + acc[t].w * acc[t].w; }
            ssq += __shfl_xor(ssq, 16, 64); ssq += __shfl_xor(ssq, 32, 64);
            if (fq == 0) red[(16 * mt + fr) * 2 + nh] = ssq;
            __syncthreads();
            const int cr = 16 * mt + fr; const float rinv = rsqrtf((red[cr * 2] + red[cr * 2 + 1]) * (1.f / 128.f) + EPSV);
            u16* gp = gsp + (size_t)(row0 + cr) * DM + h * 128;
#pragma unroll
            for (int t = 0; t < 4; ++t) { const int dv = 16 * (nh * 4 + t) + 4 * fq; const u32x2 gw = *(const u32x2*)(gp + dv); const f32x4 on = *(const f32x4*)(onorm + h * 128 + dv);
                u32x2 o; o.x = pk(acc[t].x * rinv * on.x * blo(gw.x), acc[t].y * rinv * on.y * bhi(gw.x)); o.y = pk(acc[t].z * rinv * on.z * blo(gw.y), acc[t].w * rinv * on.w * bhi(gw.y));
                *(u32x2*)(gp + dv) = o; }
        }
        __syncthreads();
    }
}
__device__ __forceinline__ void hgrn_sample(const Params& P, unsigned char* sm) {
    float* red = (float*)sm;
    float* sq = red + 16 * 128;
    float* sf = sq + 128; float* sk = sf + 128; float* sv = sk + 128; float* so = sv + 128; float* sr = so + 128;
    const u16* qss = (const u16*)(P.ws + WS_SIDE + 1 * SSLOT); const u16* lfs = (const u16*)(P.ws + WS_SIDE + 2 * SSLOT); const u16* vs = (const u16*)(P.ws + WS_SIDE + 3 * SSLOT);
    u16* gss = (u16*)(P.ws + WS_SIDE + 4 * SSLOT);
    const float* S0 = P.in[2]; float* Sn = P.out + O_HS; const float* onorm = P.in[12];
    const int tid = TIDX;
    for (int item = blockIdx.x; item < 1024; item += gridDim.x) {
        const int b = item >> 3, h = item & 7;
        if (tid < 128) { const int c = h * 128 + tid; const float lfv = h2f(lfs[(size_t)b * DM + c]); const float f = __expf(lfv);
            sq[tid] = b2f(qss[(size_t)b * DM + c]); sf[tid] = f; sk[tid] = 1.f - f; sv[tid] = b2f(vs[(size_t)b * DM + c]); }
        __syncthreads();
        const int dv4 = (tid & 31) * 4, dkg = tid >> 5;
        const f32x4 vv = *(const f32x4*)(sv + dv4); f32x4 oacc = (f32x4){0.f, 0.f, 0.f, 0.f};
        const size_t base = ((size_t)(b * 8 + h)) * 16384;
#pragma unroll
        for (int i = 0; i < 8; ++i) { const int dk = dkg * 8 + i; const f32x4 s0 = *(const f32x4*)(S0 + base + dk * 128 + dv4);
            const f32x4 sn = sf[dk] * s0 + sk[dk] * vv; *(f32x4*)(Sn + base + dk * 128 + dv4) = sn; oacc += sq[dk] * sn; }
        *(f32x4*)(red + dkg * 128 + dv4) = oacc;
        __syncthreads();
        if (tid < 128) { float o = 0.f;
#pragma unroll
            for (int g = 0; g < 16; ++g) o += red[g * 128 + tid];
            so[tid] = o; const float s2 = wave_sum(o * o); if ((tid & 63) == 0) sr[tid >> 6] = s2; }
        __syncthreads();
        if (tid < 128) { const float rinv = rsqrtf((sr[0] + sr[1]) * (1.f / 128.f) + EPSV); const int c = h * 128 + tid;
            const float g = b2f(gss[(size_t)b * DM + c]); gss[(size_t)b * DM + c] = f2b(so[tid] * rinv * onorm[c] * g); }
        __syncthreads();
    }
}
__device__ __forceinline__ void conv_phase(const Params& P) {
    const u16* xrp = (const u16*)(P.ws + WS_R0); const u16* xrs = (const u16*)(P.ws + WS_SIDE + 5 * SSLOT);
    u16* xcp = (u16*)(P.ws + WS_R2); u16* xcs = (u16*)(P.ws + WS_SIDE + 7 * SSLOT);
    const float* cw = P.in[13]; const float* cb = P.in[14]; const float* sc = P.in[4];
    float* cpo = P.out + O_CP; float* cso = P.out + O_CS;
    const int tid = TIDX, ch = (tid & 127) * 8;
    float w0[8], w1[8], w2[8], w3[8], bb[8];
#pragma unroll
    for (int j = 0; j < 8; ++j) { w0[j] = cw[ch + j]; w1[j] = cw[1024 + ch + j]; w2[j] = cw[2048 + ch + j]; w3[j] = cw[3072 + ch + j]; bb[j] = cb[ch + j]; }
    for (int rg = blockIdx.x; rg < NTOK / 4; rg += gridDim.x) {
        const int row = rg * 4 + (tid >> 7);
        float x0[8], x1[8], x2[8], x3[8];
        if (row < TP) {
            const int t = row & (SEQ - 1); const u16* p = xrp + (size_t)row * DM + ch;
            unpack8(*(const u32x4*)p, x0);
            if (t >= 1) unpack8(*(const u32x4*)(p - DM), x1); else { for (int j = 0; j < 8; ++j) x1[j] = 0.f; }
            if (t >= 2) unpack8(*(const u32x4*)(p - 2 * DM), x2); else { for (int j = 0; j < 8; ++j) x2[j] = 0.f; }
            if (t >= 3) unpack8(*(const u32x4*)(p - 3 * DM), x3); else { for (int j = 0; j < 8; ++j) x3[j] = 0.f; }
            if (t >= SEQ - 3) { float* o = cpo + ((size_t)(row >> 11) * 3 + (t - (SEQ - 3))) * DM + ch; *(f32x4*)o = (f32x4){x0[0], x0[1], x0[2], x0[3]}; *(f32x4*)(o + 4) = (f32x4){x0[4], x0[5], x0[6], x0[7]}; }
        } else {
            const int b = row - TP; unpack8(*(const u32x4*)(xrs + (size_t)b * DM + ch), x0);
            const float* s = sc + (size_t)b * 3 * DM + ch;
#pragma unroll
            for (int j = 0; j < 8; ++j) { x3[j] = s[j]; x2[j] = s[DM + j]; x1[j] = s[2 * DM + j]; }
            float* o = cso + (size_t)b * 3 * DM + ch;
#pragma unroll
            for (int j = 0; j < 8; ++j) { o[j] = x2[j]; o[DM + j] = x1[j]; o[2 * DM + j] = x0[j]; }
        }
        float y[8];
#pragma unroll
        for (int j = 0; j < 8; ++j) y[j] = bb[j] + w3[j] * x0[j] + w2[j] * x1[j] + w1[j] * x2[j] + w0[j] * x3[j];
        u16* d = row < TP ? xcp + (size_t)row * DM + ch : xcs + (size_t)(row - TP) * DM + ch;
        *(u32x4*)d = pack8(y);
    }
}
__device__ __forceinline__ void lru_pass1(const Params& P) {
    const unsigned* la = (const unsigned*)(P.ws + WS_R2); const unsigned* bt = (const unsigned*)(P.ws + WS_R0); f32x4* agg = (f32x4*)(P.ws + WS_AGG);
    const int cp = TIDX;
    for (int item = blockIdx.x; item < 256; item += gridDim.x) {
        const size_t r0 = (size_t)item * 64;
        float P0 = 1.f, P1 = 1.f, H0 = 0.f, H1 = 0.f;
#pragma unroll 8
        for (int r = 0; r < 64; ++r) { const unsigned lw = la[(r0 + r) * 512 + cp], bw = bt[(r0 + r) * 512 + cp];
            const float a0 = __expf(blo(lw)), a1 = __expf(bhi(lw)); H0 = a0 * H0 + blo(bw); H1 = a1 * H1 + bhi(bw); P0 *= a0; P1 *= a1; }
        agg[(size_t)item * 512 + cp] = (f32x4){P0, H0, P1, H1};
    }
}
__device__ __forceinline__ void lru_pass2(const Params& P) {
    const unsigned* la = (const unsigned*)(P.ws + WS_R2); const unsigned* bt = (const unsigned*)(P.ws + WS_R0); unsigned* yg = (unsigned*)(P.ws + WS_R1); const f32x4* agg = (const f32x4*)(P.ws + WS_AGG);
    float* lpo = P.out + O_LP;
    const int cp = TIDX;
    for (int item = blockIdx.x; item < 256; item += gridDim.x) {
        const int b = item >> 5, c = item & 31; const size_t r0 = (size_t)item * 64;
        float h0 = 0.f, h1 = 0.f;
        for (int cc = 0; cc < c; ++cc) { const f32x4 g = agg[(size_t)(b * 32 + cc) * 512 + cp]; h0 = g.x * h0 + g.y; h1 = g.z * h1 + g.w; }
#pragma unroll 8
        for (int r = 0; r < 64; ++r) { const size_t ix = (r0 + r) * 512 + cp; const unsigned lw = la[ix], bw = bt[ix], yw = yg[ix];
            h0 = __expf(blo(lw)) * h0 + blo(bw); h1 = __expf(bhi(lw)) * h1 + bhi(bw); yg[ix] = pk(h0 * blo(yw), h1 * bhi(yw)); }
        if (c == 31) { lpo[b * DM + 2 * cp] = h0; lpo[b * DM + 2 * cp + 1] = h1; }
    }
    const unsigned* las = (const unsigned*)(P.ws + WS_SIDE + 8 * SSLOT); const unsigned* bts = (const unsigned*)(P.ws + WS_SIDE + 5 * SSLOT); unsigned* ygs = (unsigned*)(P.ws + WS_SIDE + 6 * SSLOT);
    const float* hl = P.in[3]; float* lso = P.out + O_LS;
    for (int b = blockIdx.x; b < TS; b += gridDim.x) {
        const size_t ix = (size_t)b * 512 + cp; const unsigned lw = las[ix], bw = bts[ix], yw = ygs[ix];
        const float h0 = __expf(blo(lw)) * hl[b * DM + 2 * cp] + blo(bw), h1 = __expf(bhi(lw)) * hl[b * DM + 2 * cp + 1] + bhi(bw);
        ygs[ix] = pk(h0 * blo(yw), h1 * bhi(yw)); lso[b * DM + 2 * cp] = h0; lso[b * DM + 2 * cp + 1] = h1;
    }
}


__device__ __forceinline__ f32x4 sk_acc(const u16* Ap, const u16* Bp, int K) {
    f32x4 acc = (f32x4){0.f, 0.f, 0.f, 0.f};
#pragma unroll
    for (int k0 = 0; k0 < 128; k0 += 32) { const bf16x8 a = *(const bf16x8*)(Ap + k0), b = *(const bf16x8*)(Bp + k0); acc = __builtin_amdgcn_mfma_f32_16x16x32_bf16(b, a, acc, 0, 0, 0); }
    return acc;
}
template <int KS>
__device__ __forceinline__ f32x4 sk_ks(const u16* A, int lda, const u16* Brow, float* red, int w, int fr, int fq, int lane) {
    constexpr int CH = (KS == 4) ? 2 : 3;
    __builtin_amdgcn_sched_barrier(0);
    const int kb = w * KS * 32 + 8 * fq;
    f32x4 acc[8];
#pragma unroll
    for (int mt = 0; mt < 8; ++mt) acc[mt] = (f32x4){0.f, 0.f, 0.f, 0.f};
    const u16* ap = A + (size_t)fr * lda + kb; const u16* bp = Brow + kb;
#pragma unroll
    for (int c0 = 0; c0 < KS; c0 += CH) {
        bf16x8 bfr[CH], afr[CH][8];
#pragma unroll
        for (int s = 0; s < CH; ++s) if (c0 + s < KS) {
            bfr[s] = *(const bf16x8*)(bp + (c0 + s) * 32);
#pragma unroll
            for (int mt = 0; mt < 8; ++mt) afr[s][mt] = *(const bf16x8*)(ap + (size_t)(16 * mt) * lda + (c0 + s) * 32);
        }
#pragma unroll
        for (int s = 0; s < CH; ++s) if (c0 + s < KS) {
#pragma unroll
            for (int mt = 0; mt < 8; ++mt) acc[mt] = __builtin_amdgcn_mfma_f32_16x16x32_bf16(bfr[s], afr[s][mt], acc[mt], 0, 0, 0);
        }
        asm volatile("" ::: "memory");
    }
#pragma unroll
    for (int mt = 0; mt < 8; ++mt) *(f32x4*)(red + (size_t)((w * 8 + mt) * 64 + lane) * 4) = acc[mt];
    __syncthreads();
    f32x4 r = (f32x4){0.f, 0.f, 0.f, 0.f};
#pragma unroll
    for (int ww = 0; ww < 8; ++ww) r += *(const f32x4*)(red + (size_t)((ww * 8 + w) * 64 + lane) * 4);
    __syncthreads();
    __builtin_amdgcn_sched_barrier(0);
    return r;
}
#define SK_SETUP const int tid = TIDX, lane = tid & 63, w = tid >> 6, fr = lane & 15, fq = lane >> 4, r = 16 * w + fr; (void)r;
#define SK_LOOP(ns) for (int sl = (int)gridDim.x - 1 - (int)blockIdx.x; sl < (ns); sl += (int)gridDim.x)
__device__ __forceinline__ u32x2 pk4(f32x4 v) { u32x2 o; o.x = pk(v.x, v.y); o.y = pk(v.z, v.w); return o; }
__device__ __forceinline__ f32x4 up4(u32x2 w) { return (f32x4){blo(w.x), bhi(w.x), blo(w.y), bhi(w.y)}; }
__device__ __forceinline__ void sk_gu(const u16* hn_s, const u16* Wgu, u16* act_s, float* red) {
    SK_SETUP
    SK_LOOP(176) { const int f0 = sl * 16, br = (f0 >> 7) * 256 + (f0 & 127);
        const f32x4 g = sk_ks<4>(hn_s, DM, Wgu + (size_t)(br + fr) * DM, red, w, fr, fq, lane);
        const f32x4 u = sk_ks<4>(hn_s, DM, Wgu + (size_t)(br + 128 + fr) * DM, red, w, fr, fq, lane);
        *(u32x2*)(act_s + (size_t)r * DFF + f0 + 4 * fq) = pk4(silu4(g) * u); }
}
template <int KS>
__device__ __forceinline__ void sk_res(const u16* a_s, const u16* Bt, const float* resid, float* out, float scale, float* red) {
    SK_SETUP
    SK_LOOP(64) { const int n0 = sl * 16;
        const f32x4 a = sk_ks<KS>(a_s, 256 * KS, Bt + (size_t)(n0 + fr) * (256 * KS), red, w, fr, fq, lane);
        const f32x4 rv = *(const f32x4*)(resid + (size_t)r * DM + n0 + 4 * fq);
        *(f32x4*)(out + (size_t)r * DM + n0 + 4 * fq) = rv + scale * a; }
}
__device__ __forceinline__ void sk_ina(const u16* hn_s, const u16* Win, u16* qs, u16* lf, u16* vv, u16* gs, const float* lbv, float* red) {
    SK_SETUP
    SK_LOOP(256) { const int n0 = sl * 16, seg = n0 >> 10, c = (n0 & 1023) + 4 * fq;
        const f32x4 a = sk_ks<4>(hn_s, DM, Win + (size_t)(n0 + fr) * DM, red, w, fr, fq, lane);
        if (seg == 0) *(u32x2*)(qs + (size_t)r * DM + c) = pk4(silu4(a));
        else if (seg == 1) { const f32x4 l = *(const f32x4*)(lbv + c); const f32x4 lg = log4(l + (1.f - l) * sig4(a)); u32x2 o; o.x = pkh(lg.x, lg.y); o.y = pkh(lg.z, lg.w); *(u32x2*)(lf + (size_t)r * DM + c) = o; }
        else if (seg == 2) *(u32x2*)(vv + (size_t)r * DM + c) = pk4(a);
        else *(u32x2*)(gs + (size_t)r * DM + c) = pk4(silu4(a)); }
}
__device__ __forceinline__ void sk_inb(const u16* hn_s, const u16* Win, u16* xr, u16* yg, float* red) {
    SK_SETUP
    SK_LOOP(128) { const int n0 = sl * 16, seg = n0 >> 10, c = (n0 & 1023) + 4 * fq;
        const f32x4 a = sk_ks<4>(hn_s, DM, Win + (size_t)(4096 + n0 + fr) * DM, red, w, fr, fq, lane);
        if (seg == 0) *(u32x2*)(xr + (size_t)r * DM + c) = pk4(a); else *(u32x2*)(yg + (size_t)r * DM + c) = pk4(gelu4(a)); }
}
__device__ __forceinline__ void sk_bd(const u16* xc_s, const u16* Wbd, const float* ba, const float* bx, const float* lc, u16* la_s, u16* bt_s) {
    SK_SETUP
    SK_LOOP(64) { const int ch0 = sl * 16, n = ch0 >> 7, d0 = ch0 & 127, c = ch0 + 4 * fq;
        const u16* ap = xc_s + (size_t)r * DM + n * 128 + 8 * fq;
        const f32x4 pa = sk_acc(ap, Wbd + ((size_t)(n * 256 + d0 + fr) * 256 + (n & 1) * 128) + 8 * fq, 128);
        const f32x4 px = sk_acc(ap, Wbd + ((size_t)(n * 256 + 128 + d0 + fr) * 256 + (n & 1) * 128) + 8 * fq, 128);
        const f32x4 rr = sig4(pa + *(const f32x4*)(ba + c)), ig = sig4(px + *(const f32x4*)(bx + c)); const f32x4 la = rr * *(const f32x4*)(lc + c);
        const f32x4 xv = up4(*(const u32x2*)(xc_s + (size_t)r * DM + c));
        *(u32x2*)(la_s + (size_t)r * DM + c) = pk4(la); *(u32x2*)(bt_s + (size_t)r * DM + c) = pk4(sqrt4(nexpm1_4(2.f * la)) * ig * xv); }
}
__device__ __forceinline__ void sk_merge(const u16* hn_s, const u16* oa_s, const u16* ob_s, const u16* Win, const u16* Waup, const u16* Wbup, u16* mb_s, float* red) {
    SK_SETUP
    SK_LOOP(64) { const int n0 = sl * 16; const size_t bo = (size_t)(n0 + fr) * DM;
        const f32x4 g1 = sk_ks<4>(hn_s, DM, Win + (size_t)6144 * DM + bo, red, w, fr, fq, lane), a = sk_ks<4>(oa_s, DM, Waup + bo, red, w, fr, fq, lane);
        const f32x4 g2 = sk_ks<4>(hn_s, DM, Win + (size_t)7168 * DM + bo, red, w, fr, fq, lane), b = sk_ks<4>(ob_s, DM, Wbup + bo, red, w, fr, fq, lane);
        *(u32x2*)(mb_s + (size_t)r * DM + n0 + 4 * fq) = pk4(sig4(g1) * a + sig4(g2) * b); }
}

#define XB_TMO      128
#define XB_XCNT(j)  (256  + 64 * (j))
#define XB_XSUB(j)  (1280 + 64 * (j))
#define XB_XGEN(j)  (2304 + 64 * (j))
#define XB_TOP      3328
#define XB_TOPGEN   3392
#define XCD_BAR_WORDS 3456
#define XB_SPIN_CAP (1u << 18)
__device__ __forceinline__ unsigned xb_ld(unsigned* p)              { return __hip_atomic_load(p, __ATOMIC_RELAXED, __HIP_MEMORY_SCOPE_AGENT); }
__device__ __forceinline__ unsigned xb_add(unsigned* p, unsigned v) { return __hip_atomic_fetch_add(p, v, __ATOMIC_RELAXED, __HIP_MEMORY_SCOPE_AGENT); }
__device__ __forceinline__ unsigned xb_xcc_id() { return (unsigned)__builtin_amdgcn_s_getreg((3 << 11) | 20) & 0xFu; }
#define XB_SPIN(cond, bar) do { unsigned _sp = 0; while (cond) { __builtin_amdgcn_s_sleep(1); \
    if ((++_sp & 255u) == 0u) { if (xb_ld(&(bar)[XB_TMO])) break; if (_sp > XB_SPIN_CAP) { atomicAdd(&(bar)[XB_TMO], 1u); break; } } } } while (0)
struct XcdBarrier { unsigned* bar; unsigned x; volatile LAS unsigned* st; };
__device__ __forceinline__ XcdBarrier xcd_barrier_post(unsigned* bar, volatile LAS unsigned* st) {
    XcdBarrier b; b.bar = bar; b.x = xb_xcc_id(); b.st = st;
    if (threadIdx.x == 0) (void)xb_add(&bar[XB_XCNT(b.x)], 1u);
    return b;
}
__device__ __forceinline__ void xcd_barrier_complete(unsigned* bar, unsigned x, unsigned& nloc, unsigned& nx) {
    const unsigned G = gridDim.x * gridDim.y * gridDim.z;
    unsigned sum, cnt, mine, sp = 0u;
    for (;;) {
        sum = 0u; cnt = 0u; mine = 0u;
#pragma unroll
        for (unsigned j = 0; j < 16; ++j) { const unsigned c = xb_ld(&bar[XB_XCNT(j)]); sum += c; cnt += (c > 0u) ? 1u : 0u; mine = (j == x) ? c : mine; }
        if (sum == G) break;
        __builtin_amdgcn_s_sleep(1);
        if ((++sp & 255u) == 0u) { if (xb_ld(&bar[XB_TMO])) break; if (sp > XB_SPIN_CAP) { atomicAdd(&bar[XB_TMO], 1u); break; } }
    }
    nloc = mine > 0u ? mine : 1u; nx = cnt > 0u ? cnt : 1u;
}
__device__ __forceinline__ void xcd_barrier(const XcdBarrier& b) {
    asm volatile("s_waitcnt vmcnt(0)" ::: "memory");
    __syncthreads();
    if (threadIdx.x == 0) {
        unsigned* bar = b.bar;
        __builtin_amdgcn_s_waitcnt(0);
        unsigned nloc = b.st[0], nx = b.st[1];
        if (nloc == 0u) { xcd_barrier_complete(bar, b.x, nloc, nx); b.st[0] = nloc; b.st[1] = nx; }
        const unsigned old = xb_add(&bar[XB_XSUB(b.x)], 1u);
        const unsigned gen = old / nloc;
        if (old + 1u == (gen + 1u) * nloc) {
            __builtin_amdgcn_fence(__ATOMIC_RELEASE, "agent");
            asm volatile("s_waitcnt vmcnt(0)" ::: "memory");
            const unsigned og = xb_add(&bar[XB_TOP], 1u);
            const unsigned tg = og / nx;
            if (og + 1u == (tg + 1u) * nx) xb_add(&bar[XB_TOPGEN], 1u);
            else XB_SPIN(xb_ld(&bar[XB_TOPGEN]) == tg, bar);
            __builtin_amdgcn_fence(__ATOMIC_ACQUIRE, "agent");
            xb_add(&bar[XB_XGEN(b.x)], 1u);
            asm volatile("s_waitcnt vmcnt(0)" ::: "memory");
        } else {
            XB_SPIN(xb_ld(&bar[XB_XGEN(b.x)]) == gen, bar);
            __builtin_amdgcn_fence(__ATOMIC_ACQUIRE, "agent");
            asm volatile("s_waitcnt vmcnt(0)" ::: "memory");
        }
    }
    __syncthreads();
}

#define GSYNC() xcd_barrier(xbar)
#define GSYNC_CG() do { asm volatile("s_waitcnt vmcnt(0) lgkmcnt(0)" ::: "memory"); grid.sync(); } while (0)
#ifndef PROBE
#define PROBE 0
#endif
#ifndef STOP_AT
#define STOP_AT 99
#endif
__device__ __forceinline__ void dumpcp(const unsigned char* src, unsigned char* dst, size_t bytes) {
    for (size_t i = ((size_t)blockIdx.x * 512 + threadIdx.x) * 16; i < bytes; i += (size_t)gridDim.x * 512 * 16) *(u32x4*)(dst + i) = *(const u32x4*)(src + i);
}
#define STOPCHK(n) do { if (STOP_AT == (n)) { if ((n) == 4) { dumpcp(P.ws + WS_R0, (unsigned char*)(P.out + O_HS), 2 * SLOT); dumpcp(P.ws + WS_R2, (unsigned char*)P.out + SLOT, SLOT); }  if ((n) == 2 || (n) == 14) { DEF_PTRS final_norm(X1, P.in[27], P.out + O_YP, P.out + O_YS); } return; } } while (0)
#define DEF_PTRS \
    unsigned char* ws = opq(P.ws); unsigned char* ob = opq((unsigned char*)P.out); (void)ob; \
    u16* Wgu = (u16*)(ws + WS_WGU); u16* Wd = (u16*)(ws + WS_WD); u16* Win = (u16*)(ws + WS_WIN); u16* Wbd = (u16*)(ws + WS_WBD); \
    u16* Waup = (u16*)(ws + WS_WAUP); u16* Wbup = (u16*)(ws + WS_WBUP); u16* Wout = (u16*)(ws + WS_WOUT); \
    float* X1 = (float*)(ws + WS_X1); float* LBv = (float*)(ws + WS_LB); float* LCv = (float*)(ws + WS_LC); \
    const B16 HN = {(u16*)(ws + WS_HN), (u16*)(ws + WS_SIDE + 0 * SSLOT)}; \
    const B16 QS = {(u16*)(ws + WS_R0), (u16*)(ws + WS_SIDE + 1 * SSLOT)}; \
    const B16 LF = {(u16*)(ws + WS_R1), (u16*)(ws + WS_SIDE + 2 * SSLOT)}; \
    const B16 VV = {(u16*)(ws + WS_R2), (u16*)(ws + WS_SIDE + 3 * SSLOT)}; \
    const B16 GS = {(u16*)(ob + O_YP * 4), (u16*)(ws + WS_SIDE + 4 * SSLOT)}; \
    const B16 XR = {(u16*)(ws + WS_R0), (u16*)(ws + WS_SIDE + 5 * SSLOT)}; \
    const B16 YG = {(u16*)(ws + WS_R1), (u16*)(ws + WS_SIDE + 6 * SSLOT)}; \
    const B16 XC = {(u16*)(ws + WS_R2), (u16*)(ws + WS_SIDE + 7 * SSLOT)}; \
    const B16 TA = {(u16*)(ws + WS_R0), (u16*)(ws + WS_SIDE + 8 * SSLOT)}; \
    const B16 GT = {(u16*)(ws + WS_R2), (u16*)(ws + WS_SIDE + 9 * SSLOT)}; \
    const B16 MB = {(u16*)(ob + O_YP * 4) + (size_t)TP * DM, (u16*)(ws + WS_SIDE + 10 * SSLOT)}; \
    const B16 ACT = {(u16*)(ws + WS_R0), (u16*)(ws + WS_ACTS)}; \
    (void)Wgu; (void)Wd; (void)Win; (void)Wbd; (void)Waup; (void)Wbup; (void)Wout; (void)X1; (void)LBv; (void)LCv; \
    (void)HN; (void)QS; (void)LF; (void)VV; (void)GS; (void)XR; (void)YG; (void)XC; (void)TA; (void)GT; (void)MB; (void)ACT;

__global__ void __launch_bounds__(512, 2) mega(const float* i0, const float* i1, const float* i2, const float* i3, const float* i4, const float* i5, const float* i6, const float* i7, const float* i8, const float* i9, const float* i10, const float* i11, const float* i12, const float* i13, const float* i14, const float* i15, const float* i16, const float* i17, const float* i18, const float* i19, const float* i20, const float* i21, const float* i22, const float* i23, const float* i24, const float* i25, const float* i26, const float* i27, float* outp, unsigned char* wsp) {
    Params P;
    P.in[0] = i0; P.in[1] = i1; P.in[2] = i2; P.in[3] = i3; P.in[4] = i4; P.in[5] = i5; P.in[6] = i6; P.in[7] = i7; P.in[8] = i8; P.in[9] = i9; P.in[10] = i10; P.in[11] = i11; P.in[12] = i12; P.in[13] = i13; P.in[14] = i14; P.in[15] = i15; P.in[16] = i16; P.in[17] = i17; P.in[18] = i18; P.in[19] = i19; P.in[20] = i20; P.in[21] = i21; P.in[22] = i22; P.in[23] = i23; P.in[24] = i24; P.in[25] = i25; P.in[26] = i26; P.in[27] = i27;
    P.out = outp; P.ws = wsp;
    extern __shared__ __attribute__((aligned(16))) unsigned char shm[];
    cg::grid_group grid = cg::this_grid();
    LAS unsigned char* lds = (LAS unsigned char*)shm;
    const int G = gridDim.x, cblk = blockIdx.x;
    volatile LAS unsigned* xst = (volatile LAS unsigned*)(lds + (LDS_BYTES - 16));
    if (threadIdx.x == 0) { xst[0] = 0u; xst[1] = 0u; xst[2] = 0u; xst[3] = 0u; }
    __syncthreads();
    const XcdBarrier xbar = xcd_barrier_post((unsigned*)(P.ws + WS_BAR), xst);

    {
        DEF_PTRS
        float* tile = (float*)shm;
        for (int rep = 0; rep < (PROBE == 7 ? 2 : 1); ++rep)
        for (int t = cblk; t < 4928; t += G) {
            if (t < 704) conv_matrix(P.in[6], 1024, 2816, Wgu, 1, t, tile);
            else if (t < 1408) conv_matrix(P.in[7], 1024, 2816, Wgu, 2, t - 704, tile);
            else if (t < 2112) conv_matrix(P.in[8], 2816, 1024, Wd, 0, t - 1408, tile);
            else if (t < 4160) conv_matrix(P.in[10], 1024, 8192, Win, 0, t - 2112, tile);
            else if (t < 4416) conv_matrix(P.in[20], 1024, 1024, Waup, 0, t - 4160, tile);
            else if (t < 4672) conv_matrix(P.in[21], 1024, 1024, Wbup, 0, t - 4416, tile);
            else conv_matrix(P.in[22], 1024, 1024, Wout, 0, t - 4672, tile);
        }
        for (int idx = cblk * 512 + TIDX; idx < 8 * 256 * 256; idx += G * 512) {
            const int n = idx >> 16, row = (idx >> 8) & 255, kk = idx & 255, bj = row >> 7, d = row & 127;
            float v = 0.f; if ((kk >> 7) == (n & 1)) v = (bj ? P.in[17] : P.in[15])[(size_t)n * 16384 + (kk & 127) * 128 + d];
            Wbd[idx] = f2b(v);
        }
        if (PROBE == 12 || PROBE == 13) { unsigned char* dst = (PROBE == 12) ? (ws + WS_R2) : ((unsigned char*)P.out + SLOT);
            for (int rep = 0; rep < 4; ++rep) for (size_t i = ((size_t)cblk * 512 + TIDX) * 16; i < SLOT; i += (size_t)G * 512 * 16) *(u32x4*)(dst + i) = (u32x4){(unsigned)rep, 0u, 0u, 0u}; }
        if (cblk == 0) { for (int c = TIDX; c < 1024; c += 512) { LBv[c] = 1.f / (1.f + __expf(P.in[11][1024 + c] - P.in[11][c])); LCv[c] = -8.f * log1pf(__expf(-P.in[19][c])); } }
        norm_rows(P.in[0], P.in[1], P.in[5], HN); if (PROBE == 6) norm_rows(P.in[0], P.in[1], P.in[5], HN);
    }
    GSYNC_CG(); STOPCHK(0);
    { DEF_PTRS SchedSimple S{HN.p, HN.s, Wgu, DM, DM, 22, G, cblk, 0}; EpiGU E{ACT}; gemm_phase(lds, DM, DM, S, E); sk_gu(HN.s, Wgu, ACT.s, (float*)shm); if (PROBE == 9) sk_gu(HN.s, Wgu, ACT.s, (float*)shm); }
    GSYNC(); STOPCHK(1);
    { DEF_PTRS SchedSimple S{ACT.p, ACT.s, Wd, DFF, DFF, 4, G, cblk, 0}; EpiRes E{P.in[0], P.in[1], TS, X1, 0.5f}; gemm_phase(lds, DFF, DFF, S, E); sk_res<11>(ACT.s, Wd, P.in[1], X1 + (size_t)TP * DM, 0.5f, (float*)shm); }
    GSYNC(); STOPCHK(2);
    {
        DEF_PTRS
        float* tile = (float*)shm;
        for (int t = cblk; t < 2112; t += G) {
            if (t < 704) conv_matrix(P.in[24], 1024, 2816, Wgu, 1, t, tile);
            else if (t < 1408) conv_matrix(P.in[25], 1024, 2816, Wgu, 2, t - 704, tile);
            else conv_matrix(P.in[26], 2816, 1024, Wd, 0, t - 1408, tile);
        }
        norm_rows(X1, X1 + (size_t)TP * DM, P.in[9], HN);
    }
    GSYNC(); STOPCHK(3);
    { DEF_PTRS SchedSimple S{HN.p, HN.s, Win, DM, DM, 16, G, cblk, 0}; EpiInA E{QS, LF, VV, GS, LBv}; gemm_phase(lds, DM, DM, S, E); if (PROBE == 11) gemm_phase(lds, DM, DM, S, E); sk_ina(HN.s, Win, QS.s, LF.s, VV.s, GS.s, LBv, (float*)shm); if (PROBE == 9) sk_ina(HN.s, Win, QS.s, LF.s, VV.s, GS.s, LBv, (float*)shm); }
    GSYNC(); STOPCHK(4);
    hgrn_h1(P, shm); if (PROBE == 3) hgrn_h1(P, shm);
    GSYNC(); STOPCHK(5);
    hgrn_h2(P);
    if (PROBE == 8) { GSYNC(); hgrn_h1(P, shm); GSYNC(); hgrn_h2(P); }
    GSYNC(); STOPCHK(6);
    hgrn_h3(P, shm);
    GSYNC(); STOPCHK(7);
    { DEF_PTRS SchedSimple S{HN.p, HN.s, Win + (size_t)4096 * DM, DM, DM, 8, G, cblk, 0}; EpiInB E{XR, YG}; gemm_phase(lds, DM, DM, S, E); if (PROBE == 14) gemm_phase(lds, DM, DM, S, E); if (PROBE == 15) { EpiNull EN{(float*)(ws + WS_AGG)}; gemm_phase(lds, DM, DM, S, EN); } sk_inb(HN.s, Win, XR.s, YG.s, (float*)shm); if (PROBE == 9) sk_inb(HN.s, Win, XR.s, YG.s, (float*)shm); }
    GSYNC(); STOPCHK(8);
    conv_phase(P); if (PROBE == 4) conv_phase(P); hgrn_sample(P, shm);
    GSYNC(); STOPCHK(9);
    { DEF_PTRS SchedSimple S{XC.p, XC.s, Wbd, DM, 256, 8, G, cblk, 256}; EpiBD E{XC, XR, P.in[16], P.in[18], LCv}; gemm_phase(lds, 256, DM, S, E); sk_bd(XC.s, Wbd, P.in[16], P.in[18], LCv, TA.s, XR.s); }
    GSYNC(); STOPCHK(10);
    lru_pass1(P); if (PROBE == 5) lru_pass1(P);
    GSYNC(); STOPCHK(11);
    lru_pass2(P);
    GSYNC(); STOPCHK(12);
    { DEF_PTRS SchedMerge S{HN, GS, YG, Win, Waup, Wbup, G, cblk}; EpiMerge E{GT, TA, MB}; gemm_phase(lds, DM, DM, S, E); if (PROBE == 10) gemm_phase(lds, DM, DM, S, E); sk_merge(HN.s, GS.s, YG.s, Win, Waup, Wbup, MB.s, (float*)shm); if (PROBE == 9) sk_merge(HN.s, GS.s, YG.s, Win, Waup, Wbup, MB.s, (float*)shm); }
    GSYNC(); STOPCHK(13);
    { DEF_PTRS SchedSimple S{MB.p, MB.s, Wout, DM, DM, 4, G, cblk, 0}; EpiRes E{X1, X1 + (size_t)TP * DM, 256, X1, 1.0f}; gemm_phase(lds, DM, DM, S, E); sk_res<4>(MB.s, Wout, X1 + (size_t)TP * DM, X1 + (size_t)TP * DM, 1.0f, (float*)shm); }
    GSYNC(); STOPCHK(14);
    { DEF_PTRS norm_rows(X1, X1 + (size_t)TP * DM, P.in[23], HN); }
    GSYNC(); STOPCHK(15);
    { DEF_PTRS SchedSimple S{HN.p, HN.s, Wgu, DM, DM, 22, G, cblk, 0}; EpiGU E{ACT}; gemm_phase(lds, DM, DM, S, E); sk_gu(HN.s, Wgu, ACT.s, (float*)shm); if (PROBE == 9) sk_gu(HN.s, Wgu, ACT.s, (float*)shm); }
    GSYNC(); STOPCHK(16);
    { DEF_PTRS SchedSimple S{ACT.p, ACT.s, Wd, DFF, DFF, 4, G, cblk, 0}; EpiRes E{X1, X1 + (size_t)TP * DM, 256, X1, 0.5f}; gemm_phase(lds, DFF, DFF, S, E); sk_res<11>(ACT.s, Wd, X1 + (size_t)TP * DM, X1 + (size_t)TP * DM, 0.5f, (float*)shm); }
    GSYNC(); STOPCHK(17);
    { DEF_PTRS final_norm(X1, P.in[27], P.out + O_YP, P.out + O_YS); }
}

extern "C" void kernel_launch(void* const* d_in, const int* in_sizes, int n_in, void* d_out, int out_size, void* d_ws, size_t ws_size, hipStream_t stream) {
    static int grid = 0;
    if (grid == 0) {
        int dev = 0, cus = 0, per_cu = 0;
        if (n_in != 28 || ws_size < WS_END) { fprintf(stderr, "kernel_launch: unexpected n_in %d / ws_size %zu (need %zu)\n", n_in, ws_size, (size_t)WS_END); grid = -1; return; }
        (void)hipGetDevice(&dev); (void)hipDeviceGetAttribute(&cus, hipDeviceAttributeMultiprocessorCount, dev);
        if (hipFuncSetAttribute((const void*)mega, hipFuncAttributeMaxDynamicSharedMemorySize, LDS_BYTES) != hipSuccess) { fprintf(stderr, "kernel_launch: hipFuncSetAttribute failed\n"); grid = -1; return; }
        if (hipOccupancyMaxActiveBlocksPerMultiprocessor(&per_cu, (const void*)mega, 512, LDS_BYTES) != hipSuccess || per_cu < 1) { fprintf(stderr, "kernel_launch: occupancy query gave %d\n", per_cu); per_cu = 1; (void)hipGetLastError(); }
        grid = cus * 1;
    }
    if (grid < 0) return;
    const float* ins[28]; for (int i = 0; i < 28; ++i) ins[i] = (const float*)d_in[i];
    float* outp = (float*)d_out; unsigned char* wsp = (unsigned char*)d_ws;
    if (hipMemsetAsync((char*)d_ws + WS_BAR, 0, 16384, stream) != hipSuccess) { fprintf(stderr, "kernel_launch: memset failed\n"); return; }
    void* args[30]; for (int i = 0; i < 28; ++i) args[i] = (void*)&ins[i];
    args[28] = (void*)&outp; args[29] = (void*)&wsp;
    hipError_t e = hipLaunchCooperativeKernel((void*)mega, dim3(grid), dim3(512), args, LDS_BYTES, stream);
    if (e != hipSuccess) fprintf(stderr, "cooperative launch failed: %s (grid %d)\n", hipGetErrorString(e), grid);
}
```

```cpp
#include <hip/hip_runtime.h>
#include <hip/hip_cooperative_groups.h>
#include <cstdio>
namespace cg = cooperative_groups;

#define LAS __attribute__((address_space(3)))
typedef unsigned short u16;
typedef short bf16x8 __attribute__((ext_vector_type(8)));
typedef float f32x4 __attribute__((ext_vector_type(4)));
typedef unsigned u32x4 __attribute__((ext_vector_type(4)));
typedef unsigned u32x2 __attribute__((ext_vector_type(2)));

constexpr int TP = 16384, TS = 128, NTOK = TP + TS, DM = 1024, DFF = 2816, SEQ = 2048;
constexpr float EPSV = 1e-6f;
constexpr int LDS_BYTES = 147456;

constexpr size_t SLOT = (size_t)TP * DM * 2;
constexpr size_t SSLOT = (size_t)256 * DM * 2;
constexpr size_t WS_WGU = 0;
constexpr size_t WS_WD = WS_WGU + (size_t)5632 * 1024 * 2;
constexpr size_t WS_WIN = WS_WD + (size_t)1024 * 2816 * 2;
constexpr size_t WS_WBD = WS_WIN + (size_t)8192 * 1024 * 2;
constexpr size_t WS_WAUP = WS_WBD + (size_t)8 * 256 * 256 * 2;
constexpr size_t WS_WBUP = WS_WAUP + (size_t)1024 * 1024 * 2;
constexpr size_t WS_WOUT = WS_WBUP + (size_t)1024 * 1024 * 2;
constexpr size_t WS_X1 = WS_WOUT + (size_t)1024 * 1024 * 2;
constexpr size_t WS_HN = WS_X1 + (size_t)16640 * DM * 4;
constexpr size_t WS_R0 = WS_HN + SLOT;
constexpr size_t WS_R1 = WS_R0 + SLOT;
constexpr size_t WS_R2 = WS_R1 + SLOT;
constexpr size_t WS_SIDE = WS_R2 + SLOT;
constexpr size_t WS_ACTS = WS_SIDE + 11 * SSLOT;
constexpr size_t WS_BL = WS_ACTS + (size_t)256 * DFF * 2;
constexpr size_t WS_AGG = WS_BL + (size_t)2048 * 128 * 4;
constexpr size_t WS_LB = WS_AGG + (size_t)256 * 1024 * 8;
constexpr size_t WS_LC = WS_LB + 4096;
constexpr size_t WS_BAR = WS_LC + 4096;
constexpr size_t WS_END = WS_BAR + 16384;
static_assert(WS_END <= (size_t)268435456, "workspace too large");
constexpr size_t O_YP = 0, O_YS = 16777216, O_HP = 16908288, O_LP = 17956864, O_CP = 17965056, O_HS = 17989632, O_LS = 34766848, O_CS = 34897920;

struct Params { const float* in[28]; float* out; unsigned char* ws; };
struct B16 { u16* p; u16* s; };

typedef __bf16 bf16x2_t __attribute__((ext_vector_type(2)));
typedef float f32x2_t __attribute__((ext_vector_type(2)));
__device__ __forceinline__ unsigned pk(float lo, float hi) { const f32x2_t v = {lo, hi}; const bf16x2_t b = __builtin_convertvector(v, bf16x2_t); return __builtin_bit_cast(unsigned, b); }
__device__ __forceinline__ float blo(unsigned w) { return __uint_as_float(w << 16); }
__device__ __forceinline__ float bhi(unsigned w) { return __uint_as_float(w & 0xffff0000u); }
__device__ __forceinline__ float b2f(u16 b) { return __uint_as_float(((unsigned)b) << 16); }
__device__ __forceinline__ u16 f2b(float f) { return (u16)(pk(f, 0.f) & 0xffffu); }
__device__ __forceinline__ float sigm(float x) { return __builtin_amdgcn_rcpf(1.f + __builtin_amdgcn_exp2f(-1.4426950408889634f * x)); }
__device__ __forceinline__ float silu(float x) { return x * __builtin_amdgcn_rcpf(1.f + __builtin_amdgcn_exp2f(-1.4426950408889634f * x)); }
__device__ __forceinline__ float gelu_t(float x) { const float x2 = x * x; const float t = x2 * (-0.10294324f) + (-2.3022082f); return x * __builtin_amdgcn_rcpf(1.f + __builtin_amdgcn_exp2f(x * t)); }
__device__ __forceinline__ unsigned pkh(float lo, float hi) { const _Float16 a = (_Float16)lo, b = (_Float16)hi; return (unsigned)__builtin_bit_cast(u16, a) | ((unsigned)__builtin_bit_cast(u16, b) << 16); }
__device__ __forceinline__ float h2f(u16 h) { return (float)__builtin_bit_cast(_Float16, h); }
__device__ __forceinline__ u32x4 pack8(const float* o) { u32x4 r; r.x = pk(o[0], o[1]); r.y = pk(o[2], o[3]); r.z = pk(o[4], o[5]); r.w = pk(o[6], o[7]); return r; }
__device__ __forceinline__ void unpack8(u32x4 w, float* o) { o[0] = blo(w.x); o[1] = bhi(w.x); o[2] = blo(w.y); o[3] = bhi(w.y); o[4] = blo(w.z); o[5] = bhi(w.z); o[6] = blo(w.w); o[7] = bhi(w.w); }
template <class T> __device__ __forceinline__ T* asg(T* p) { return (T*)(__attribute__((address_space(1))) T*)p; }
__device__ __forceinline__ unsigned char* opq(unsigned char* p) { return p; }
__device__ __forceinline__ int opqv(int v) { asm volatile("" : "+v"(v)); return v; }
#define TIDX opqv((int)threadIdx.x)
struct F8 { f32x4 a, b; };
__device__ __forceinline__ F8 unpack8v(u32x4 w) { F8 r; r.a = (f32x4){blo(w.x), bhi(w.x), blo(w.y), bhi(w.y)}; r.b = (f32x4){blo(w.z), bhi(w.z), blo(w.w), bhi(w.w)}; return r; }
__device__ __forceinline__ u32x4 pack8v(f32x4 a, f32x4 b) { u32x4 r; r.x = pk(a.x, a.y); r.y = pk(a.z, a.w); r.z = pk(b.x, b.y); r.w = pk(b.z, b.w); return r; }
__device__ __forceinline__ u32x4 pack8h(f32x4 a, f32x4 b) { u32x4 r; r.x = pkh(a.x, a.y); r.y = pkh(a.z, a.w); r.z = pkh(b.x, b.y); r.w = pkh(b.z, b.w); return r; }
__device__ __forceinline__ f32x4 sig4(f32x4 v) { return (f32x4){sigm(v.x), sigm(v.y), sigm(v.z), sigm(v.w)}; }
__device__ __forceinline__ f32x4 silu4(f32x4 v) { return (f32x4){silu(v.x), silu(v.y), silu(v.z), silu(v.w)}; }
__device__ __forceinline__ f32x4 gelu4(f32x4 v) { return (f32x4){gelu_t(v.x), gelu_t(v.y), gelu_t(v.z), gelu_t(v.w)}; }
__device__ __forceinline__ f32x4 log4(f32x4 v) { return (f32x4){__logf(v.x), __logf(v.y), __logf(v.z), __logf(v.w)}; }
__device__ __forceinline__ float wave_sum(float v) {
#pragma unroll
    for (int o = 32; o >= 1; o >>= 1) v += __shfl_xor(v, o, 64);
    return v;
}

constexpr int BM = 256, BK = 64, HALF = 128, HTB = HALF * BK * 2;
__device__ __forceinline__ int lds_byte(int r, int c) { const int st = (r >> 4) * 2 + (c >> 5), rr = r & 15, cc = c & 31, ob = rr * 64 + cc * 2; return st * 1024 + (ob ^ (((ob >> 9) & 1) << 5)); }
__device__ __forceinline__ void stage_rc(int b, int& R, int& C) { const int st = b / 1024, sb = b % 1024, swz = sb ^ (((sb >> 9) & 1) << 5); R = (st >> 1) * 16 + swz / 64; C = (st & 1) * 32 + (swz % 64) / 2; }
__device__ __forceinline__ int perm32(int rho) { const int n = rho >> 4, i = rho & 15; return 8 * (i >> 2) + 4 * n + (i & 3); }

struct Unit { int pm, pn, sub; const char* a; const char* b; };

__device__ __forceinline__ bool tile_of(long L, int nM, int nN, int& pm, int& pn) {
    const int nwg = nM * nN; if (L >= nwg) return false;
    int wgid = (int)L; { const int q = nwg / 8, r = nwg % 8, xcd = wgid % 8, off = wgid / 8; wgid = (xcd < r ? xcd * (q + 1) : r * (q + 1) + (xcd - r) * q) + off; }
    const int nig = 8 * nN, gid = wgid / nig, fm = gid * 8, gsz = (nM - fm) < 8 ? (nM - fm) : 8;
    pm = fm + ((wgid % nig) % gsz); pn = (wgid % nig) / gsz; return true;
}

template <class Epi, class Sched>
__device__ __forceinline__ void gemm_phase(LAS unsigned char* lds, const int K, const int lda, const Sched& S, const Epi& E) {
    const int tid = TIDX, wid = __builtin_amdgcn_readfirstlane(tid >> 6), lane = tid & 63, wr = wid >> 2, wc = wid & 3, fr = lane & 15, fq = lane >> 4;
    const int nt = K / BK;
    unsigned voffA[2], voffB[2];
#pragma unroll
    for (int i = 0; i < 2; ++i) { int R, C; stage_rc(tid * 16 + i * 8192, R, C); const int Rb = Epi::PERM ? ((R & ~31) + perm32(R & 31)) : R;
        voffA[i] = (unsigned)(R * lda + C) * 2u; voffB[i] = (unsigned)(Rb * K + C) * 2u; }
    const size_t kstep = (size_t)(BK * 2);
    const size_t hstepA = (size_t)HALF * lda * 2, hstepB = (size_t)HALF * K * 2;
    const unsigned ldsw = (unsigned)wid * 1024u;
    const int aoff = lds_byte(wr * 64 + fr, fq * 8), boff = lds_byte(wc * 32 + fr, fq * 8);
#define G_SA(b, h) (((b) * 2 + (h)) * HTB)
#define G_SB(b, h) ((4 + (b) * 2 + (h)) * HTB)
#define G_STAGE(bufoff, gbase, voff) do { _Pragma("unroll") for (int _i = 0; _i < 2; ++_i) \
        __builtin_amdgcn_global_load_lds((const unsigned*)((const char*)(gbase) + (voff)[_i]), (LAS unsigned*)(lds + (bufoff) + ldsw + _i * 8192), 16, 0, 0); } while (0)
#define G_LDA(dst, b, h) do { _Pragma("unroll") for (int m = 0; m < 4; ++m) _Pragma("unroll") for (int k = 0; k < 2; ++k) dst[m][k] = *(const LAS bf16x8*)(lds + G_SA(b, h) + aoff + m * 2048 + k * 1024); } while (0)
#define G_LDB(dst, b, h) do { _Pragma("unroll") for (int n = 0; n < 2; ++n) _Pragma("unroll") for (int k = 0; k < 2; ++k) dst[n][k] = *(const LAS bf16x8*)(lds + G_SB(b, h) + boff + n * 2048 + k * 1024); } while (0)
#define G_MMA(ai, bj, At, Bt) do { __builtin_amdgcn_s_setprio(1); _Pragma("unroll") for (int m = 0; m < 4; ++m) _Pragma("unroll") for (int n = 0; n < 2; ++n) _Pragma("unroll") for (int k = 0; k < 2; ++k) \
        acc[ai][bj][m][n] = __builtin_amdgcn_mfma_f32_16x16x32_bf16(Bt[n][k], At[m][k], acc[ai][bj][m][n], 0, 0, 0); __builtin_amdgcn_s_setprio(0); } while (0)
#define G_WAIT_V(n) asm volatile("s_waitcnt vmcnt(" #n ")" ::: "memory")
#define G_WAIT_L(n) asm volatile("s_waitcnt lgkmcnt(" #n ")" ::: "memory")
#define G_BAR __builtin_amdgcn_s_barrier()
#define G_SCHED __builtin_amdgcn_sched_barrier(0)
    Unit cur, nxt; int ui = 0;
    if (!S.next(0, cur)) return;
    f32x4 acc[2][2][4][2];
#pragma unroll
    for (int a = 0; a < 2; ++a)
#pragma unroll
        for (int b = 0; b < 2; ++b)
#pragma unroll
            for (int m = 0; m < 4; ++m)
#pragma unroll
                for (int n = 0; n < 2; ++n) acc[a][b][m][n] = (f32x4){0.f, 0.f, 0.f, 0.f};
    bf16x8 At[4][2], B0[2][2], B1[2][2];
    const char* cA = cur.a; const char* cB = cur.b;
    G_STAGE(G_SB(0, 0), cB, voffB); G_STAGE(G_SA(0, 0), cA, voffA); G_STAGE(G_SB(0, 1), cB + hstepB, voffB); G_STAGE(G_SA(0, 1), cA + hstepA, voffA);
    if (wr == 1) G_BAR;
    G_WAIT_V(4); G_BAR;
    G_STAGE(G_SB(1, 0), cB + kstep, voffB); G_STAGE(G_SA(1, 0), cA + kstep, voffA); G_STAGE(G_SB(1, 1), cB + hstepB + kstep, voffB);
    G_WAIT_V(6); G_BAR;
    for (;;) {
        const bool has_next = S.next(ui + 1, nxt);
        const char* nA = has_next ? nxt.a : cA; const char* nB = has_next ? nxt.b : cB;
        for (int t = 0; t < nt; t += 2) {
            const bool last = (t == nt - 2);
            const char* a1 = cA + (size_t)(t + 1) * kstep;
            const char* a2 = last ? nA : cA + (size_t)(t + 2) * kstep; const char* b2 = last ? nB : cB + (size_t)(t + 2) * kstep;
            const char* a3 = a2 + kstep; const char* b3 = b2 + kstep;
            G_LDB(B0, 0, 0); G_SCHED; G_LDA(At, 0, 0); G_STAGE(G_SA(1, 1), a1 + hstepA, voffA);
            G_WAIT_L(8); G_BAR; G_WAIT_L(0); G_MMA(0, 0, At, B0); G_BAR; G_SCHED;
            G_LDB(B1, 0, 1); G_STAGE(G_SB(0, 0), b2, voffB);
            G_BAR; G_WAIT_L(0); G_MMA(0, 1, At, B1); G_BAR;
            G_LDA(At, 0, 1); G_STAGE(G_SA(0, 0), a2, voffA);
            G_BAR; G_WAIT_L(0); G_MMA(1, 0, At, B0); G_BAR; G_SCHED;
            G_STAGE(G_SB(0, 1), b2 + hstepB, voffB);
            G_WAIT_V(6); G_BAR; G_MMA(1, 1, At, B1); G_BAR;
            G_LDB(B0, 1, 0); G_SCHED; G_LDA(At, 1, 0); G_STAGE(G_SA(0, 1), a2 + hstepA, voffA);
            G_WAIT_L(8); G_BAR; G_WAIT_L(0); G_MMA(0, 0, At, B0); G_BAR; G_SCHED;
            G_LDB(B1, 1, 1); G_STAGE(G_SB(1, 0), b3, voffB);
            G_BAR; G_WAIT_L(0); G_MMA(0, 1, At, B1); G_BAR;
            G_LDA(At, 1, 1); G_STAGE(G_SA(1, 0), a3, voffA);
            G_BAR; G_WAIT_L(0); G_MMA(1, 0, At, B0); G_BAR; G_SCHED;
            G_STAGE(G_SB(1, 1), b3 + hstepB, voffB);
            G_WAIT_V(6); G_BAR; G_MMA(1, 1, At, B1); G_BAR;
        }
        E(acc, cur, wr, wc, fr, fq);
        if (!has_next) break;
#pragma unroll
        for (int a = 0; a < 2; ++a)
#pragma unroll
            for (int b = 0; b < 2; ++b)
#pragma unroll
                for (int m = 0; m < 4; ++m)
#pragma unroll
                    for (int n = 0; n < 2; ++n) acc[a][b][m][n] = (f32x4){0.f, 0.f, 0.f, 0.f};
        cur = nxt; cA = nA; cB = nB; ++ui;
    }
    G_WAIT_V(0);
    if (wr == 0) G_BAR;
    G_BAR;
#undef G_SA
#undef G_SB
#undef G_STAGE
#undef G_LDA
#undef G_LDB
#undef G_MMA
#undef G_WAIT_V
#undef G_WAIT_L
#undef G_BAR
#undef G_SCHED
}

struct SchedLim {
    const u16* Ap; const u16* As; const u16* Bt; int lda, K, nN, G, c; int lim;
    __device__ __forceinline__ bool next(int i, Unit& u) const {
        int pm, pn; if (i >= lim || !tile_of((long)(i & 1) * G + c, 64, nN, pm, pn)) return false;
        u.pm = pm; u.pn = pn; u.sub = 0;
        u.a = (const char*)(Ap + (size_t)pm * 256 * lda);
        u.b = (const char*)(Bt + (size_t)pn * 256 * K); return true;
    }
};
struct SchedSimple {
    const u16* Ap; const u16* As; const u16* Bt; int lda, K, nN, G, c; int acol_per_pn;
    __device__ __forceinline__ bool next(int i, Unit& u) const {
        int pm, pn; if (!tile_of((long)i * G + c, 64, nN, pm, pn)) return false;
        u.pm = pm; u.pn = pn; u.sub = 0;
        u.a = (const char*)((pm < 64 ? Ap + (size_t)pm * 256 * lda : As) + (size_t)(pn >> 1) * acol_per_pn);
        u.b = (const char*)(Bt + (size_t)pn * 256 * K); return true;
    }
};
struct SchedMerge {
    B16 hn, oa, ob; const u16* Win; const u16* Waup; const u16* Wbup; int G, c;
    __device__ __forceinline__ bool next(int i, Unit& u) const {
        int pm, pn; if (!tile_of((long)(i >> 2) * G + c, 64, 4, pm, pn)) return false;
        const int sub = i & 3; u.pm = pm; u.pn = pn; u.sub = sub;
        const unsigned long long m1 = (sub == 1) ? ~0ull : 0ull, m3 = (sub == 3) ? ~0ull : 0ull, m0 = ~(m1 | m3);
        const u16* abp = (const u16*)(((unsigned long long)oa.p & m1) | ((unsigned long long)ob.p & m3) | ((unsigned long long)hn.p & m0));
        const u16* abs_ = (const u16*)(((unsigned long long)oa.s & m1) | ((unsigned long long)ob.s & m3) | ((unsigned long long)hn.s & m0));
        const u16* bb = (const u16*)(((unsigned long long)Waup & m1) | ((unsigned long long)Wbup & m3) | ((unsigned long long)(Win + (size_t)(sub == 0 ? 6144 : 7168) * DM) & m0));
        u.a = (const char*)(pm < 64 ? abp + (size_t)pm * 256 * DM : abs_);
        u.b = (const char*)(bb + (size_t)pn * 256 * DM); return true;
    }
};

struct EpiGU {
    static constexpr bool PERM = true; B16 act;
    __device__ __forceinline__ void operator()(const f32x4 (&acc)[2][2][4][2], const Unit& u, int wr, int wc, int fr, int fq) const {
        u16* base = (u.pm < 64 ? act.p + (size_t)u.pm * 256 * DFF : act.s) + u.pn * 128 + wc * 32 + 8 * fq;
#pragma unroll
        for (int ai = 0; ai < 2; ++ai)
#pragma unroll
            for (int m = 0; m < 4; ++m) {
                const int rt = ai * 128 + wr * 64 + m * 16 + fr; float o[8];
#pragma unroll
                for (int n = 0; n < 2; ++n)
#pragma unroll
                    for (int j = 0; j < 4; ++j) o[n * 4 + j] = silu(acc[ai][0][m][n][j]) * acc[ai][1][m][n][j];
                *(u32x4*)(base + (size_t)rt * DFF) = pack8(o);
            }
    }
};
struct EpiRes {
    static constexpr bool PERM = false; const float* rp; const float* rs; int ns; float* out; float scale;
    __device__ __forceinline__ void operator()(const f32x4 (&acc)[2][2][4][2], const Unit& u, int wr, int wc, int fr, int fq) const {
        const int col0 = u.pn * 256 + wc * 32 + 4 * fq;
#pragma unroll
        for (int ai = 0; ai < 2; ++ai)
#pragma unroll
            for (int m = 0; m < 4; ++m) {
                const int rt = ai * 128 + wr * 64 + m * 16 + fr; const int row = u.pm * 256 + rt;
                const float* r = (u.pm < 64) ? rp + (size_t)row * DM : rs + (size_t)rt * DM; const bool valid = (u.pm < 64) || (rt < ns);
                float* o = out + (size_t)row * DM;
#pragma unroll
                for (int bj = 0; bj < 2; ++bj)
#pragma unroll
                    for (int n = 0; n < 2; ++n) { const int c = col0 + bj * 128 + n * 16; f32x4 rv = (f32x4){0.f, 0.f, 0.f, 0.f}; if (valid) rv = *(const f32x4*)(r + c);
                        *(f32x4*)(o + c) = rv + scale * acc[ai][bj][m][n]; }
                asm volatile("" ::: "memory");
            }
    }
};
template <int MODE> __device__ __forceinline__ void ina_store(u16* base, const f32x4 (&acc)[2][2][4][2], const float* lbp) {
#pragma unroll
    for (int bj = 0; bj < 2; ++bj) {
        f32x4 l0 = (f32x4){0.f, 0.f, 0.f, 0.f}, l1 = l0;
        (void)lbp; (void)l0; (void)l1;
#pragma unroll
        for (int ai = 0; ai < 2; ++ai)
#pragma unroll
            for (int m = 0; m < 4; ++m) {
                u16* d = base + (size_t)(ai * 128 + m * 16) * DM + bj * 128;
                if (MODE == 1) *(u32x4*)d = pack8h(acc[ai][bj][m][0], acc[ai][bj][m][1]);
                else *(u32x4*)d = pack8v(acc[ai][bj][m][0], acc[ai][bj][m][1]);
            }
    }
}
struct EpiInA {
    static constexpr bool PERM = true; B16 qs, lf, v, gs; const float* lbv;
    __device__ __forceinline__ void operator()(const f32x4 (&acc)[2][2][4][2], const Unit& u, int wr, int wc, int fr, int fq) const {
        const int seg = u.pn >> 2, cs = (u.pn & 3) * 256 + wc * 32 + 8 * fq;
        const size_t ro = cs + (size_t)(wr * 64 + fr) * DM; const size_t po = (size_t)u.pm * 256 * DM; const bool pr = u.pm < 64;
        if (seg == 0) { u16* qp = qs.p; u16* qsm = qs.s; ina_store<0>((pr ? qp + po : qsm) + ro, acc, lbv); }
        else if (seg == 1) { u16* qp = lf.p; u16* qsm = lf.s; ina_store<1>((pr ? qp + po : qsm) + ro, acc, lbv + cs); }
        else if (seg == 2) { u16* qp = v.p; u16* qsm = v.s; ina_store<2>((pr ? qp + po : qsm) + ro, acc, lbv); }
        else { u16* qp = gs.p; u16* qsm = gs.s; ina_store<0>((pr ? qp + po : qsm) + ro, acc, lbv); }
    }
};
struct EpiNull { static constexpr bool PERM = true; float* sink;
    __device__ __forceinline__ void operator()(const f32x4 (&acc)[2][2][4][2], const Unit& u, int wr, int wc, int fr, int fq) const {
        float t = 0.f;
#pragma unroll
        for (int ai = 0; ai < 2; ++ai)
#pragma unroll
            for (int bj = 0; bj < 2; ++bj)
#pragma unroll
                for (int m = 0; m < 4; ++m)
#pragma unroll
                    for (int n = 0; n < 2; ++n) t += acc[ai][bj][m][n].x + acc[ai][bj][m][n].y + acc[ai][bj][m][n].z + acc[ai][bj][m][n].w;
        if (t == 12345.678f) sink[0] = t;
    }
};
struct EpiInBP {
    static constexpr bool PERM = true; u16* dst; int ldp;
    __device__ __forceinline__ void operator()(const f32x4 (&acc)[2][2][4][2], const Unit& u, int wr, int wc, int fr, int fq) const {
        const int seg = u.pn >> 2, cs = (u.pn & 3) * 256 + wc * 32 + 8 * fq;
        u16* base = dst + (size_t)u.pm * 256 * ldp + cs + (size_t)(wr * 64 + fr) * ldp;
        if (seg == 0) {
#pragma unroll
            for (int ai = 0; ai < 2; ++ai)
#pragma unroll
                for (int m = 0; m < 4; ++m)
#pragma unroll
                    for (int bj = 0; bj < 2; ++bj) *(u32x4*)(base + (size_t)(ai * 128 + m * 16) * ldp + bj * 128) = pack8v(acc[ai][bj][m][0], acc[ai][bj][m][1]);
        } else {
#pragma unroll
            for (int ai = 0; ai < 2; ++ai)
#pragma unroll
                for (int m = 0; m < 4; ++m)
#pragma unroll
                    for (int bj = 0; bj < 2; ++bj) *(u32x4*)(base + (size_t)(ai * 128 + m * 16) * ldp + bj * 128) = pack8v(gelu4(acc[ai][bj][m][0]), gelu4(acc[ai][bj][m][1]));
        }
    }
};
struct EpiInB {
    static constexpr bool PERM = true; B16 xr, yg;
    __device__ __forceinline__ void operator()(const f32x4 (&acc)[2][2][4][2], const Unit& u, int wr, int wc, int fr, int fq) const {
        const int seg = u.pn >> 2, cs = (u.pn & 3) * 256 + wc * 32 + 8 * fq;
        u16* base = (u.pm < 64 ? (seg == 0 ? +xr.p : +yg.p) + (size_t)u.pm * 256 * DM : (seg == 0 ? +xr.s : +yg.s)) + cs + (size_t)(wr * 64 + fr) * DM;
        if (seg == 0) {
#pragma unroll
            for (int ai = 0; ai < 2; ++ai)
#pragma unroll
                for (int m = 0; m < 4; ++m)
#pragma unroll
                    for (int bj = 0; bj < 2; ++bj) *(u32x4*)(base + (size_t)(ai * 128 + m * 16) * DM + bj * 128) = pack8v(acc[ai][bj][m][0], acc[ai][bj][m][1]);
        } else {
#pragma unroll
            for (int ai = 0; ai < 2; ++ai)
#pragma unroll
                for (int m = 0; m < 4; ++m)
#pragma unroll
                    for (int bj = 0; bj < 2; ++bj) *(u32x4*)(base + (size_t)(ai * 128 + m * 16) * DM + bj * 128) = pack8v(acc[ai][bj][m][0], acc[ai][bj][m][1]);
        }
    }
};
__device__ __forceinline__ f32x4 nexpm1_4(f32x4 x) { const f32x4 p = 1.f + x * (0.5f + x * (0.16666667f + x * (0.041666668f + x * (0.008333334f + x * 0.0013888889f)))); return -x * p; }
__device__ __forceinline__ f32x4 sqrt4(f32x4 v) { return (f32x4){sqrtf(fmaxf(v.x, 0.f)), sqrtf(fmaxf(v.y, 0.f)), sqrtf(fmaxf(v.z, 0.f)), sqrtf(fmaxf(v.w, 0.f))}; }
struct EpiBD {
    static constexpr bool PERM = true; B16 xc, bt; const float* ba; const float* bx; const float* lc;
    __device__ __forceinline__ void operator()(const f32x4 (&acc)[2][2][4][2], const Unit& u, int wr, int wc, int fr, int fq) const {
        const int ch = u.pn * 128 + wc * 32 + 8 * fq;
        u16* xb = (u.pm < 64 ? xc.p + (size_t)u.pm * 256 * DM : xc.s) + ch + (size_t)(wr * 64 + fr) * DM; u16* bb = (u.pm < 64 ? bt.p + (size_t)u.pm * 256 * DM : bt.s) + ch + (size_t)(wr * 64 + fr) * DM;
#pragma unroll
        for (int n = 0; n < 2; ++n) {
            const f32x4 cba = *(const f32x4*)(ba + ch + 4 * n), cbx = *(const f32x4*)(bx + ch + 4 * n), cl = *(const f32x4*)(lc + ch + 4 * n);
#pragma unroll
            for (int ai = 0; ai < 2; ++ai)
#pragma unroll
                for (int m = 0; m < 4; ++m) {
                    const size_t off = (size_t)(ai * 128 + m * 16) * DM + 4 * n;
                    const u32x2 xw = *(const u32x2*)(xb + off); const f32x4 xv = (f32x4){blo(xw.x), bhi(xw.x), blo(xw.y), bhi(xw.y)};
                    const f32x4 r = sig4(acc[ai][0][m][n] + cba), ig = sig4(acc[ai][1][m][n] + cbx);
                    const f32x4 la = r * cl; const f32x4 bo = sqrt4(nexpm1_4(2.f * la)) * ig * xv;
                    u32x2 o1, o2; o1.x = pk(la.x, la.y); o1.y = pk(la.z, la.w); o2.x = pk(bo.x, bo.y); o2.y = pk(bo.z, bo.w);
                    *(u32x2*)(xb + off) = o1; *(u32x2*)(bb + off) = o2;
                    if (m & 1) asm volatile("" ::: "memory");
                }
        }
    }
};
struct EpiMerge {
    static constexpr bool PERM = true; B16 gt, ta, mb;
    __device__ __forceinline__ void operator()(const f32x4 (&acc)[2][2][4][2], const Unit& u, int wr, int wc, int fr, int fq) const {
        const size_t ro = ((u.pm < 64) ? (size_t)u.pm * 256 * DM : 0) + u.pn * 256 + wc * 32 + 8 * fq + (size_t)(wr * 64 + fr) * DM;
        u16* g = (u.pm < 64 ? +gt.p : +gt.s) + ro; u16* t = (u.pm < 64 ? +ta.p : +ta.s) + ro; u16* mo = (u.pm < 64 ? +mb.p : +mb.s) + ro;
        const int sub = u.sub;
        if (sub == 0 || sub == 2) {
#pragma unroll
            for (int ai = 0; ai < 2; ++ai)
#pragma unroll
                for (int m = 0; m < 4; ++m)
#pragma unroll
                    for (int bj = 0; bj < 2; ++bj) *(u32x4*)(g + (size_t)(ai * 128 + m * 16) * DM + bj * 128) = pack8v(sig4(acc[ai][bj][m][0]), sig4(acc[ai][bj][m][1]));
        } else if (sub == 1) {
#pragma unroll
            for (int ai = 0; ai < 2; ++ai)
#pragma unroll
                for (int m = 0; m < 4; ++m)
#pragma unroll
                    for (int bj = 0; bj < 2; ++bj) { const size_t off = (size_t)(ai * 128 + m * 16) * DM + bj * 128; const F8 gv = unpack8v(*(const u32x4*)(g + off));
                        *(u32x4*)(t + off) = pack8v(gv.a * acc[ai][bj][m][0], gv.b * acc[ai][bj][m][1]); if (bj) asm volatile("" ::: "memory"); }
        } else {
#pragma unroll
            for (int ai = 0; ai < 2; ++ai)
#pragma unroll
                for (int m = 0; m < 4; ++m)
#pragma unroll
                    for (int bj = 0; bj < 2; ++bj) { const size_t off = (size_t)(ai * 128 + m * 16) * DM + bj * 128; const F8 gv = unpack8v(*(const u32x4*)(g + off)), tv = unpack8v(*(const u32x4*)(t + off));
                        *(u32x4*)(mo + off) = pack8v(tv.a + gv.a * acc[ai][bj][m][0], tv.b + gv.b * acc[ai][bj][m][1]); if (bj) asm volatile("" ::: "memory"); }
        }
    }
};

__device__ __forceinline__ void tconv_tile(const float* src, int N, int K, int kt, int nt, u16* dst, int mode, float* tile) {
    const int tid = TIDX;
    const int c4 = (tid & 15) * 4;
#pragma unroll
    for (int p = 0; p < 2; ++p) { const int r = (tid >> 4) + 32 * p; const f32x4 v = *(const f32x4*)(src + (size_t)(kt * 64 + r) * N + nt * 64 + c4);
        tile[r * 65 + c4] = v.x; tile[r * 65 + c4 + 1] = v.y; tile[r * 65 + c4 + 2] = v.z; tile[r * 65 + c4 + 3] = v.w; }
    __syncthreads();
    const int n = tid >> 3, k8 = (tid & 7) * 8; float f[8];
#pragma unroll
    for (int j = 0; j < 8; ++j) f[j] = tile[(k8 + j) * 65 + n];
    const int ng = nt * 64 + n; const int drow = mode == 0 ? ng : ((ng >> 7) * 256 + (mode == 2 ? 128 : 0) + (ng & 127));
    *(u32x4*)(dst + (size_t)drow * K + kt * 64 + k8) = pack8(f);
    __syncthreads();
}
__device__ __forceinline__ void conv_matrix(const float* src, int K, int N, u16* dst, int mode, int t, float* tile) {
    const int ntn = N / 64; tconv_tile(src, N, K, t / ntn, t % ntn, dst, mode, tile);
}
__device__ __forceinline__ void norm_rows(const float* sp, const float* ss, const float* gain, B16 dst) {
    const int lane = TIDX & 63, gw = blockIdx.x * 8 + (TIDX >> 6), nw = gridDim.x * 8;
    f32x4 g[4];
#pragma unroll
    for (int i = 0; i < 4; ++i) g[i] = *(const f32x4*)(gain + i * 256 + lane * 4);
    for (int row = gw; row < NTOK; row += nw) {
        const float* src = row < TP ? sp + (size_t)row * DM : ss + (size_t)(row - TP) * DM;
        f32x4 v[4]; float s = 0.f;
#pragma unroll
        for (int i = 0; i < 4; ++i) { v[i] = *(const f32x4*)(src + i * 256 + lane * 4); s += v[i].x * v[i].x + v[i].y * v[i].y + v[i].z * v[i].z + v[i].w * v[i].w; }
        s = wave_sum(s); const float rs = rsqrtf(s * (1.f / DM) + EPSV);
        u16* d = (row < TP ? dst.p + (size_t)row * DM : dst.s + (size_t)(row - TP) * DM);
#pragma unroll
        for (int i = 0; i < 4; ++i) { u32x2 w; w.x = pk(v[i].x * rs * g[i].x, v[i].y * rs * g[i].y); w.y = pk(v[i].z * rs * g[i].z, v[i].w * rs * g[i].w); *(u32x2*)(d + i * 256 + lane * 4) = w; }
    }
}
__device__ __forceinline__ void final_norm(const float* x, const float* gain, float* yp, float* ys) {
    const int lane = TIDX & 63, gw = blockIdx.x * 8 + (TIDX >> 6), nw = gridDim.x * 8;
    f32x4 g[4];
#pragma unroll
    for (int i = 0; i < 4; ++i) g[i] = *(const f32x4*)(gain + i * 256 + lane * 4);
    for (int row = gw; row < NTOK; row += nw) {
        const float* src = x + (size_t)row * DM;
        f32x4 v[4]; float s = 0.f;
#pragma unroll
        for (int i = 0; i < 4; ++i) { v[i] = *(const f32x4*)(src + i * 256 + lane * 4); s += v[i].x * v[i].x + v[i].y * v[i].y + v[i].z * v[i].z + v[i].w * v[i].w; }
        s = wave_sum(s); const float rs = rsqrtf(s * (1.f / DM) + EPSV);
        float* d = row < TP ? yp + (size_t)row * DM : ys + (size_t)(row - TP) * DM;
#pragma unroll
        for (int i = 0; i < 4; ++i) *(f32x4*)(d + i * 256 + lane * 4) = v[i] * rs * g[i];
    }
}

constexpr int L_BL = 0, L_TOT = 32768, L_RED = 34816, L_QE = 35328, L_KE = 52736, L_VT = 70144, L_AM = 88576, L_ST = 97792;
constexpr int QS_ = 136, VS_ = 72;

__device__ __forceinline__ void load_lf_chunk(const u16* lfp, int row0, int h, float* bL, const float* lbv) {
    const int tid = TIDX, r = tid >> 3, seg = tid & 7;
    float lb[16];
#pragma unroll
    for (int i = 0; i < 4; ++i) { const f32x4 t = *(const f32x4*)(lbv + h * 128 + seg * 16 + 4 * i); lb[4 * i] = t.x; lb[4 * i + 1] = t.y; lb[4 * i + 2] = t.z; lb[4 * i + 3] = t.w; }
    const u16* p = lfp + (size_t)(row0 + r) * DM + h * 128 + seg * 16;
    const u32x4 w0 = *(const u32x4*)p, w1 = *(const u32x4*)(p + 8);
    float* d = bL + r * 128 + seg * 16;
    const unsigned ws[8] = {w0.x, w0.y, w0.z, w0.w, w1.x, w1.y, w1.z, w1.w};
#pragma unroll
    for (int i = 0; i < 8; ++i) { const float p0 = h2f((u16)(ws[i] & 0xffffu)), p1 = h2f((u16)(ws[i] >> 16));
        d[2 * i] = __logf(lb[2 * i] + (1.f - lb[2 * i]) * sigm(p0)); d[2 * i + 1] = __logf(lb[2 * i + 1] + (1.f - lb[2 * i + 1]) * sigm(p1)); }
}
__device__ __forceinline__ void load_vT(const u16* vp, int row0, int h, u16* vT) {
    const int tid = TIDX, s = tid >> 3, seg = tid & 7;
    const u16* p = vp + (size_t)(row0 + s) * DM + h * 128 + seg * 16;
    const u32x4 w0 = *(const u32x4*)p, w1 = *(const u32x4*)(p + 8);
    const unsigned ws[8] = {w0.x, w0.y, w0.z, w0.w, w1.x, w1.y, w1.z, w1.w};
#pragma unroll
    for (int i = 0; i < 8; ++i) { vT[(seg * 16 + 2 * i) * VS_ + s] = (u16)(ws[i] & 0xffffu); vT[(seg * 16 + 2 * i + 1) * VS_ + s] = (u16)(ws[i] >> 16); }
}

__device__ __forceinline__ void hgrn_h1(const Params& P, unsigned char* sm) {
    float* bL = (float*)(sm + L_BL); float* tot = (float*)(sm + L_TOT); u16* kdT = (u16*)(sm + L_QE); u16* vT = (u16*)(sm + L_VT);
    const u16* lfp = (const u16*)(P.ws + WS_R1); const u16* vp = (const u16*)(P.ws + WS_R2);
    u16* Sb = (u16*)(P.out + O_HS); float* BLg = (float*)(P.ws + WS_BL);
    const int tid = TIDX, lane = tid & 63, w = tid >> 6, fr = lane & 15, fq = lane >> 4;
    for (int item = blockIdx.x; item < 2048; item += gridDim.x) {
        const int h = item & 7, c = (item >> 3) & 31, b = item >> 8; const int row0 = b * SEQ + c * 64;
        const int sidx = (b * 8 + h) * 32 + c;
        load_lf_chunk(lfp, row0, h, bL, (const float*)(P.ws + WS_LB)); load_vT(vp, row0, h, vT);
        __syncthreads();
        const int col = tid & 127, part = tid >> 7; float lf[16]; float run = 0.f;
#pragma unroll
        for (int i = 0; i < 16; ++i) { lf[i] = bL[(part * 16 + i) * 128 + col]; run += lf[i]; }
        tot[part * 128 + col] = run;
        __syncthreads();
        float off = 0.f, bl = 0.f;
#pragma unroll
        for (int p = 0; p < 4; ++p) { const float t = tot[p * 128 + col]; bl += t; if (p < part) off += t; }
        if (part == 0) BLg[(size_t)sidx * 128 + col] = bl;
        float bc = off;
#pragma unroll
        for (int i = 0; i < 16; ++i) { bc += lf[i]; const float kd = (1.f - __expf(lf[i])) * __expf(bl - bc); kdT[col * VS_ + part * 16 + i] = f2b(kd); }
        __syncthreads();
        bf16x8 av[2];
#pragma unroll
        for (int ks = 0; ks < 2; ++ks) av[ks] = *(const bf16x8*)(vT + (16 * w + fr) * VS_ + ks * 32 + 8 * fq);
        u16* so = Sb + (size_t)sidx * 16384 + (16 * w + fr) * 128 + 4 * fq;
#pragma unroll
        for (int nt = 0; nt < 8; ++nt) {
            f32x4 acc = (f32x4){0.f, 0.f, 0.f, 0.f};
#pragma unroll
            for (int ks = 0; ks < 2; ++ks) { const bf16x8 bk = *(const bf16x8*)(kdT + (16 * nt + fr) * VS_ + ks * 32 + 8 * fq); acc = __builtin_amdgcn_mfma_f32_16x16x32_bf16(bk, av[ks], acc, 0, 0, 0); }
            u32x2 o; o.x = pk(acc.x, acc.y); o.y = pk(acc.z, acc.w); *(u32x2*)(so + 16 * nt) = o;
        }
        __syncthreads();
    }
}
__device__ __forceinline__ void hgrn_h2(const Params& P) {
    u16* Sb = (u16*)(P.out + O_HS); const float* BLg = (const float*)(P.ws + WS_BL); float* hp = P.out + O_HP;
    for (int g = blockIdx.x * 512 + TIDX; g < 64 * 2048; g += gridDim.x * 512) {
        const int bh = g >> 11, e = (g & 2047) * 8, dv = e >> 7, dk = e & 127;
        float S[8];
#pragma unroll
        for (int j = 0; j < 8; ++j) S[j] = 0.f;
        u16* sp = Sb + (size_t)bh * 32 * 16384 + e; const float* blp = BLg + (size_t)bh * 32 * 128 + dk;
#pragma unroll 4
        for (int c = 0; c < 32; ++c) {
            const u32x4 lw = *(const u32x4*)(sp + (size_t)c * 16384); const f32x4 d0 = *(const f32x4*)(blp + c * 128), d1 = *(const f32x4*)(blp + c * 128 + 4);
            float sl[8]; unpack8(lw, sl);
            *(u32x4*)(sp + (size_t)c * 16384) = pack8(S);
            const float dd[8] = {d0.x, d0.y, d0.z, d0.w, d1.x, d1.y, d1.z, d1.w};
#pragma unroll
            for (int j = 0; j < 8; ++j) S[j] = __expf(dd[j]) * S[j] + sl[j];
        }
        float* o = hp + (size_t)bh * 16384 + dv;
#pragma unroll
        for (int j = 0; j < 8; ++j) o[(size_t)(dk + j) * 128] = S[j];
    }
}
__device__ __forceinline__ void hgrn_h3(const Params& P, unsigned char* sm, u16* dstp) {
    float* bL = (float*)(sm + L_BL); float* tot = (float*)(sm + L_TOT); float* red = (float*)(sm + L_RED);
    u16* qe = (u16*)(sm + L_QE); u16* ke = (u16*)(sm + L_KE); u16* vT = (u16*)(sm + L_VT); u16* Am = (u16*)(sm + L_AM); u16* ST = (u16*)(sm + L_ST);
    const u16* qsp = (const u16*)(P.ws + WS_R0); const u16* lfp = (const u16*)(P.ws + WS_R1); const u16* vp = (const u16*)(P.ws + WS_R2);
    u16* gsp = (u16*)(P.out + O_YP);
    const u16* Sb = (const u16*)(P.out + O_HS); const float* onorm = P.in[12];
    const int tid = TIDX, lane = tid & 63, w = tid >> 6, fr = lane & 15, fq = lane >> 4;
    for (int item = blockIdx.x; item < 2048; item += gridDim.x) {
        const int h = item & 7, c = (item >> 3) & 31, b = item >> 8; const int row0 = b * SEQ + c * 64;
        const int sidx = (b * 8 + h) * 32 + c;
        load_lf_chunk(lfp, row0, h, bL, (const float*)(P.ws + WS_LB)); load_vT(vp, row0, h, vT);
        { const u16* sp = Sb + (size_t)sidx * 16384;
#pragma unroll
          for (int p = 0; p < 4; ++p) { const int idx = tid + 512 * p, dv = idx >> 4, k8 = (idx & 15) * 8; *(u32x4*)(ST + dv * QS_ + k8) = *(const u32x4*)(sp + dv * 128 + k8); } }
        __syncthreads();
        const int col = tid & 127, part = tid >> 7; float lf[16]; float run = 0.f;
#pragma unroll
        for (int i = 0; i < 16; ++i) { lf[i] = bL[(part * 16 + i) * 128 + col]; run += lf[i]; }
        tot[part * 128 + col] = run;
        __syncthreads();
        float off = 0.f;
#pragma unroll
        for (int p = 0; p < 4; ++p) { const float t = tot[p * 128 + col]; if (p < part) off += t; }
        float bc = off; const u16* qp = qsp + (size_t)(row0 + part * 16) * DM + h * 128 + col;
#pragma unroll
        for (int i = 0; i < 16; ++i) { bc += lf[i]; const float q = silu(b2f(qp[(size_t)i * DM]));
            qe[(part * 16 + i) * QS_ + col] = f2b(q * __expf(bc)); ke[(part * 16 + i) * QS_ + col] = f2b((1.f - __expf(lf[i])) * __expf(-bc)); }
        __syncthreads();
        {
            const int mt = w & 3;
            bf16x8 aq[4];
#pragma unroll
            for (int ks = 0; ks < 4; ++ks) aq[ks] = *(const bf16x8*)(qe + (16 * mt + fr) * QS_ + ks * 32 + 8 * fq);
#pragma unroll
            for (int t = 0; t < 2; ++t) { const int nt = (w >> 2) * 2 + t; f32x4 acc = (f32x4){0.f, 0.f, 0.f, 0.f};
#pragma unroll
                for (int ks = 0; ks < 4; ++ks) { const bf16x8 bk = *(const bf16x8*)(ke + (16 * nt + fr) * QS_ + ks * 32 + 8 * fq); acc = __builtin_amdgcn_mfma_f32_16x16x32_bf16(bk, aq[ks], acc, 0, 0, 0); }
                const int cr = 16 * mt + fr, s0 = 16 * nt + 4 * fq;
                u32x2 o; o.x = pk(cr >= s0 ? acc.x : 0.f, cr >= s0 + 1 ? acc.y : 0.f); o.y = pk(cr >= s0 + 2 ? acc.z : 0.f, cr >= s0 + 3 ? acc.w : 0.f);
                *(u32x2*)(Am + cr * VS_ + s0) = o; }
        }
        __syncthreads();
        {
            const int mt = w & 3, nh = w >> 2;
            bf16x8 aq[4], aa[2];
#pragma unroll
            for (int ks = 0; ks < 4; ++ks) aq[ks] = *(const bf16x8*)(qe + (16 * mt + fr) * QS_ + ks * 32 + 8 * fq);
#pragma unroll
            for (int ks = 0; ks < 2; ++ks) aa[ks] = *(const bf16x8*)(Am + (16 * mt + fr) * VS_ + ks * 32 + 8 * fq);
            f32x4 acc[4]; float ssq = 0.f;
#pragma unroll
            for (int t = 0; t < 4; ++t) { const int dt = nh * 4 + t; acc[t] = (f32x4){0.f, 0.f, 0.f, 0.f};
#pragma unroll
                for (int ks = 0; ks < 4; ++ks) { const bf16x8 bk = *(const bf16x8*)(ST + (16 * dt + fr) * QS_ + ks * 32 + 8 * fq); acc[t] = __builtin_amdgcn_mfma_f32_16x16x32_bf16(bk, aq[ks], acc[t], 0, 0, 0); }
#pragma unroll
                for (int ks = 0; ks < 2; ++ks) { const bf16x8 bk = *(const bf16x8*)(vT + (16 * dt + fr) * VS_ + ks * 32 + 8 * fq); acc[t] = __builtin_amdgcn_mfma_f32_16x16x32_bf16(bk, aa[ks], acc[t], 0, 0, 0); }
                ssq += acc[t].x * acc[t].x + acc[t].y * acc[t].y + acc[t].z * acc[t].z + acc[t].w * acc[t].w; }
            ssq += __shfl_xor(ssq, 16, 64); ssq += __shfl_xor(ssq, 32, 64);
            if (fq == 0) red[(16 * mt + fr) * 2 + nh] = ssq;
            __syncthreads();
            const int cr = 16 * mt + fr; const float rinv = rsqrtf((red[cr * 2] + red[cr * 2 + 1]) * (1.f / 128.f) + EPSV);
            u16* gp = gsp + (size_t)(row0 + cr) * DM + h * 128;
#pragma unroll
            for (int t = 0; t < 4; ++t) { const int dv = 16 * (nh * 4 + t) + 4 * fq; const u32x2 gw = *(const u32x2*)(gp + dv); const f32x4 on = *(const f32x4*)(onorm + h * 128 + dv);
                u32x2 o; o.x = pk(acc[t].x * rinv * on.x * silu(blo(gw.x)), acc[t].y * rinv * on.y * silu(bhi(gw.x))); o.y = pk(acc[t].z * rinv * on.z * silu(blo(gw.y)), acc[t].w * rinv * on.w * silu(bhi(gw.y)));
                *(u32x2*)(dstp + (size_t)(row0 + cr) * DM + h * 128 + dv) = o; }
        }
        __syncthreads();
    }
}
__device__ __forceinline__ void hgrn_sample(const Params& P, unsigned char* sm, u16* gdst) {
    float* red = (float*)sm;
    float* sq = red + 16 * 128;
    float* sf = sq + 128; float* sk = sf + 128; float* sv = sk + 128; float* so = sv + 128; float* sr = so + 128;
    const u16* qss = (const u16*)(P.ws + WS_SIDE + 1 * SSLOT); const u16* lfs = (const u16*)(P.ws + WS_SIDE + 2 * SSLOT); const u16* vs = (const u16*)(P.ws + WS_SIDE + 3 * SSLOT);
    u16* gss = (u16*)(P.ws + WS_SIDE + 4 * SSLOT);
    const float* S0 = P.in[2]; float* Sn = P.out + O_HS; const float* onorm = P.in[12];
    const int tid = TIDX;
    for (int item = blockIdx.x; item < 1024; item += gridDim.x) {
        const int b = item >> 3, h = item & 7;
        if (tid < 128) { const int c = h * 128 + tid; const float lbc = ((const float*)(P.ws + WS_LB))[c]; const float f = lbc + (1.f - lbc) * sigm(h2f(lfs[(size_t)b * DM + c]));
            sq[tid] = silu(b2f(qss[(size_t)b * DM + c])); sf[tid] = f; sk[tid] = 1.f - f; sv[tid] = b2f(vs[(size_t)b * DM + c]); }
        __syncthreads();
        const int dv4 = (tid & 31) * 4, dkg = tid >> 5;
        const f32x4 vv = *(const f32x4*)(sv + dv4); f32x4 oacc = (f32x4){0.f, 0.f, 0.f, 0.f};
        const size_t base = ((size_t)(b * 8 + h)) * 16384;
#pragma unroll
        for (int i = 0; i < 8; ++i) { const int dk = dkg * 8 + i; const f32x4 s0 = *(const f32x4*)(S0 + base + dk * 128 + dv4);
            const f32x4 sn = sf[dk] * s0 + sk[dk] * vv; *(f32x4*)(Sn + base + dk * 128 + dv4) = sn; oacc += sq[dk] * sn; }
        *(f32x4*)(red + dkg * 128 + dv4) = oacc;
        __syncthreads();
        if (tid < 128) { float o = 0.f;
#pragma unroll
            for (int g = 0; g < 16; ++g) o += red[g * 128 + tid];
            so[tid] = o; const float s2 = wave_sum(o * o); if ((tid & 63) == 0) sr[tid >> 6] = s2; }
        __syncthreads();
        if (tid < 128) { const float rinv = rsqrtf((sr[0] + sr[1]) * (1.f / 128.f) + EPSV); const int c = h * 128 + tid;
            const float g = silu(b2f(gss[(size_t)b * DM + c])); gdst[(size_t)b * DM + c] = f2b(so[tid] * rinv * onorm[c] * g); }
        __syncthreads();
    }
}
__device__ __forceinline__ void conv_phase(const Params& P) {
    const u16* xrp = (const u16*)(P.ws + WS_R0); const u16* xrs = (const u16*)(P.ws + WS_SIDE + 5 * SSLOT);
    u16* xcp = (u16*)(P.ws + WS_R2); u16* xcs = (u16*)(P.ws + WS_SIDE + 7 * SSLOT);
    const float* cw = P.in[13]; const float* cb = P.in[14]; const float* sc = P.in[4];
    float* cpo = P.out + O_CP; float* cso = P.out + O_CS;
    const int tid = TIDX, ch = (tid & 127) * 8;
    float w0[8], w1[8], w2[8], w3[8], bb[8];
#pragma unroll
    for (int j = 0; j < 8; ++j) { w0[j] = cw[ch + j]; w1[j] = cw[1024 + ch + j]; w2[j] = cw[2048 + ch + j]; w3[j] = cw[3072 + ch + j]; bb[j] = cb[ch + j]; }
    for (int rg = blockIdx.x; rg < NTOK / 4; rg += gridDim.x) {
        const int row = rg * 4 + (tid >> 7);
        float x0[8], x1[8], x2[8], x3[8];
        if (row < TP) {
            const int t = row & (SEQ - 1); const u16* p = xrp + (size_t)row * DM + ch;
            unpack8(*(const u32x4*)p, x0);
            if (t >= 1) unpack8(*(const u32x4*)(p - DM), x1); else { for (int j = 0; j < 8; ++j) x1[j] = 0.f; }
            if (t >= 2) unpack8(*(const u32x4*)(p - 2 * DM), x2); else { for (int j = 0; j < 8; ++j) x2[j] = 0.f; }
            if (t >= 3) unpack8(*(const u32x4*)(p - 3 * DM), x3); else { for (int j = 0; j < 8; ++j) x3[j] = 0.f; }
            if (t >= SEQ - 3) { float* o = cpo + ((size_t)(row >> 11) * 3 + (t - (SEQ - 3))) * DM + ch; *(f32x4*)o = (f32x4){x0[0], x0[1], x0[2], x0[3]}; *(f32x4*)(o + 4) = (f32x4){x0[4], x0[5], x0[6], x0[7]}; }
        } else {
            const int b = row - TP; unpack8(*(const u32x4*)(xrs + (size_t)b * DM + ch), x0);
            const float* s = sc + (size_t)b * 3 * DM + ch;
#pragma unroll
            for (int j = 0; j < 8; ++j) { x3[j] = s[j]; x2[j] = s[DM + j]; x1[j] = s[2 * DM + j]; }
            float* o = cso + (size_t)b * 3 * DM + ch;
#pragma unroll
            for (int j = 0; j < 8; ++j) { o[j] = x2[j]; o[DM + j] = x1[j]; o[2 * DM + j] = x0[j]; }
        }
        float y[8];
#pragma unroll
        for (int j = 0; j < 8; ++j) y[j] = bb[j] + w3[j] * x0[j] + w2[j] * x1[j] + w1[j] * x2[j] + w0[j] * x3[j];
        u16* d = row < TP ? xcp + (size_t)row * DM + ch : xcs + (size_t)(row - TP) * DM + ch;
        *(u32x4*)d = pack8(y);
    }
}
__device__ __forceinline__ void lru_pass1(const Params& P) {
    const unsigned* la = (const unsigned*)(P.ws + WS_R2); const unsigned* bt = (const unsigned*)(P.ws + WS_R0); f32x4* agg = (f32x4*)(P.ws + WS_AGG);
    const int cp = TIDX;
    for (int item = blockIdx.x; item < 256; item += gridDim.x) {
        const size_t r0 = (size_t)item * 64;
        float P0 = 1.f, P1 = 1.f, H0 = 0.f, H1 = 0.f;
#pragma unroll 8
        for (int r = 0; r < 64; ++r) { const unsigned lw = la[(r0 + r) * 512 + cp], bw = bt[(r0 + r) * 512 + cp];
            const float a0 = __expf(blo(lw)), a1 = __expf(bhi(lw)); H0 = a0 * H0 + blo(bw); H1 = a1 * H1 + bhi(bw); P0 *= a0; P1 *= a1; }
        agg[(size_t)item * 512 + cp] = (f32x4){P0, H0, P1, H1};
    }
}
__device__ __forceinline__ void lru_pass2(const Params& P, unsigned* ydst, bool dummy) {
    const unsigned* la = (const unsigned*)(P.ws + WS_R2); const unsigned* bt = (const unsigned*)(P.ws + WS_R0); unsigned* yg = (unsigned*)(P.ws + WS_R1); const f32x4* agg = (const f32x4*)(P.ws + WS_AGG);
    float* lpo = P.out + O_LP;
    const int cp = TIDX;
    for (int item = blockIdx.x; item < 256; item += gridDim.x) {
        const int b = item >> 5, c = item & 31; const size_t r0 = (size_t)item * 64;
        float h0 = 0.f, h1 = 0.f;
        for (int cc = 0; cc < c; ++cc) { const f32x4 g = agg[(size_t)(b * 32 + cc) * 512 + cp]; h0 = g.x * h0 + g.y; h1 = g.z * h1 + g.w; }
#pragma unroll 8
        for (int r = 0; r < 64; ++r) { const size_t ix = (r0 + r) * 512 + cp; const unsigned lw = la[ix], bw = bt[ix], yw = yg[ix];
            h0 = __expf(blo(lw)) * h0 + blo(bw); h1 = __expf(bhi(lw)) * h1 + bhi(bw); ydst[ix] = pk(h0 * gelu_t(blo(yw)), h1 * gelu_t(bhi(yw))); }
        if (c == 31) { lpo[b * DM + 2 * cp] = h0; lpo[b * DM + 2 * cp + 1] = h1; }
    }
    if (dummy) return;
    const unsigned* las = (const unsigned*)(P.ws + WS_SIDE + 8 * SSLOT); const unsigned* bts = (const unsigned*)(P.ws + WS_SIDE + 5 * SSLOT); unsigned* ygs = (unsigned*)(P.ws + WS_SIDE + 6 * SSLOT);
    const float* hl = P.in[3]; float* lso = P.out + O_LS;
    for (int b = blockIdx.x; b < TS; b += gridDim.x) {
        const size_t ix = (size_t)b * 512 + cp; const unsigned lw = las[ix], bw = bts[ix], yw = ygs[ix];
        const float h0 = __expf(blo(lw)) * hl[b * DM + 2 * cp] + blo(bw), h1 = __expf(bhi(lw)) * hl[b * DM + 2 * cp + 1] + bhi(bw);
        ygs[ix] = pk(h0 * gelu_t(blo(yw)), h1 * gelu_t(bhi(yw))); lso[b * DM + 2 * cp] = h0; lso[b * DM + 2 * cp + 1] = h1;
    }
}


__device__ __forceinline__ f32x4 sk_acc(const u16* Ap, const u16* Bp, int K) {
    f32x4 acc = (f32x4){0.f, 0.f, 0.f, 0.f};
#pragma unroll
    for (int k0 = 0; k0 < 128; k0 += 32) { const bf16x8 a = *(const bf16x8*)(Ap + k0), b = *(const bf16x8*)(Bp + k0); acc = __builtin_amdgcn_mfma_f32_16x16x32_bf16(b, a, acc, 0, 0, 0); }
    return acc;
}
template <int KS, int RT, int CH>
__device__ __forceinline__ f32x4 sk_ks(const u16* A  , int lda, const u16* Brow, float* red, int w, int fr, int fq, int lane) {
    __builtin_amdgcn_sched_barrier(0);
    const int kb = w * KS * 32 + 8 * fq;
    f32x4 acc[RT];
#pragma unroll
    for (int mt = 0; mt < RT; ++mt) acc[mt] = (f32x4){0.f, 0.f, 0.f, 0.f};
    const u16* ap = A + (size_t)fr * lda + kb; const u16* bp = Brow + kb;
#pragma unroll
    for (int c0 = 0; c0 < KS; c0 += CH) {
        bf16x8 bfr[CH], afr[CH][RT];
#pragma unroll
        for (int s = 0; s < CH; ++s) if (c0 + s < KS) {
            bfr[s] = *(const bf16x8*)(bp + (c0 + s) * 32);
#pragma unroll
            for (int mt = 0; mt < RT; ++mt) afr[s][mt] = *(const bf16x8*)(ap + (size_t)(16 * mt) * lda + (c0 + s) * 32);
        }
#pragma unroll
        for (int s = 0; s < CH; ++s) if (c0 + s < KS) {
#pragma unroll
            for (int mt = 0; mt < RT; ++mt) acc[mt] = __builtin_amdgcn_mfma_f32_16x16x32_bf16(bfr[s], afr[s][mt], acc[mt], 0, 0, 0);
        }
        asm volatile("" ::: "memory");
    }
#pragma unroll
    for (int mt = 0; mt < RT; ++mt) *(f32x4*)(red + (size_t)((w * RT + mt) * 64 + lane) * 4) = acc[mt];
    __syncthreads();
    f32x4 r = (f32x4){0.f, 0.f, 0.f, 0.f};
    if (w < RT) {
#pragma unroll
        for (int ww = 0; ww < 8; ++ww) r += *(const f32x4*)(red + (size_t)((ww * RT + w) * 64 + lane) * 4);
    }
    __syncthreads();
    __builtin_amdgcn_sched_barrier(0);
    return r;
}
#define SK_SETUP const int tid = TIDX, lane = tid & 63, w = tid >> 6, fr = lane & 15, fq = lane >> 4;
#define SK_LOOP(ni) for (int it = (int)gridDim.x - 1 - (int)blockIdx.x; it < (ni); it += (int)gridDim.x)
__device__ __forceinline__ u32x2 pk4(f32x4 v) { u32x2 o; o.x = pk(v.x, v.y); o.y = pk(v.z, v.w); return o; }
__device__ __forceinline__ f32x4 up4(u32x2 w) { return (f32x4){blo(w.x), bhi(w.x), blo(w.y), bhi(w.y)}; }
__device__ __forceinline__ void sk_gu(const u16* hn_s, const u16* Wgu, u16* act_s, float* red) {
    SK_SETUP
    SK_LOOP(176) { const int f0 = it * 16, br = (f0 >> 7) * 256 + (f0 & 127), r = 16 * w + fr;
        const f32x4 g = sk_ks<4, 8, 4>(hn_s, DM, Wgu + (size_t)(br + fr) * DM, red, w, fr, fq, lane);
        const f32x4 u = sk_ks<4, 8, 4>(hn_s, DM, Wgu + (size_t)(br + 128 + fr) * DM, red, w, fr, fq, lane);
        *(u32x2*)(act_s + (size_t)r * DFF + f0 + 4 * fq) = pk4(silu4(g) * u); }
}
template <int KS>
__device__ __forceinline__ void sk_res(const u16* a_s, const u16* Bt, const float* resid, float* out, float scale, float* red) {
    SK_SETUP
    SK_LOOP(256) { const int n0 = (it >> 2) * 16, rg = it & 3, r = rg * 32 + 16 * w + fr;
        const f32x4 a = sk_ks<KS, 2, KS>(a_s + (size_t)(rg * 32) * (256 * KS), 256 * KS, Bt + (size_t)(n0 + fr) * (256 * KS), red, w, fr, fq, lane);
        if (w < 2) { const f32x4 rv = *(const f32x4*)(resid + (size_t)r * DM + n0 + 4 * fq);
            *(f32x4*)(out + (size_t)r * DM + n0 + 4 * fq) = rv + scale * a; } }
}
__device__ __forceinline__ void sk_ina(const u16* hn_s, const u16* Win, u16* qs, u16* lf, u16* vv, u16* gs, const float* lbv, float* red) {
    SK_SETUP
    SK_LOOP(256) { const int n0 = it * 16, seg = n0 >> 10, c = (n0 & 1023) + 4 * fq, r = 16 * w + fr;
        const f32x4 a = sk_ks<4, 8, 4>(hn_s, DM, Win + (size_t)(n0 + fr) * DM, red, w, fr, fq, lane);
        if (seg == 0) *(u32x2*)(qs + (size_t)r * DM + c) = pk4(a);
        else if (seg == 1) { u32x2 o; o.x = pkh(a.x, a.y); o.y = pkh(a.z, a.w); *(u32x2*)(lf + (size_t)r * DM + c) = o; }
        else if (seg == 2) *(u32x2*)(vv + (size_t)r * DM + c) = pk4(a);
        else *(u32x2*)(gs + (size_t)r * DM + c) = pk4(a); }
}
__device__ __forceinline__ void sk_inb(const u16* hn_s, const u16* Win, u16* xr, u16* yg, float* red) {
    SK_SETUP
    SK_LOOP(256) { const int n0 = (it >> 1) * 16, rg = it & 1, seg = n0 >> 10, c = (n0 & 1023) + 4 * fq, r = rg * 64 + 16 * w + fr;
        const f32x4 a = sk_ks<4, 4, 4>(hn_s + (size_t)(rg * 64) * DM, DM, Win + (size_t)(4096 + n0 + fr) * DM, red, w, fr, fq, lane);
        if (w < 4) { if (seg == 0) *(u32x2*)(xr + (size_t)r * DM + c) = pk4(a); else *(u32x2*)(yg + (size_t)r * DM + c) = pk4(a); } }
}
__device__ __forceinline__ void sk_bd(const u16* xc_s, const u16* Wbd, const float* ba, const float* bx, const float* lc, u16* la_s, u16* bt_s) {
    SK_SETUP
    SK_LOOP(64) { const int ch0 = it * 16, n = ch0 >> 7, d0 = ch0 & 127, c = ch0 + 4 * fq, r = 16 * w + fr;
        const u16* ap = xc_s + (size_t)r * DM + n * 128 + 8 * fq;
        const f32x4 pa = sk_acc(ap, Wbd + ((size_t)(n * 256 + d0 + fr) * 256 + (n & 1) * 128) + 8 * fq, 128);
        const f32x4 px = sk_acc(ap, Wbd + ((size_t)(n * 256 + 128 + d0 + fr) * 256 + (n & 1) * 128) + 8 * fq, 128);
        const f32x4 rr = sig4(pa + *(const f32x4*)(ba + c)), ig = sig4(px + *(const f32x4*)(bx + c)); const f32x4 la = rr * *(const f32x4*)(lc + c);
        const f32x4 xv = up4(*(const u32x2*)(xc_s + (size_t)r * DM + c));
        *(u32x2*)(la_s + (size_t)r * DM + c) = pk4(la); *(u32x2*)(bt_s + (size_t)r * DM + c) = pk4(sqrt4(nexpm1_4(2.f * la)) * ig * xv); }
}
__device__ __forceinline__ void sk_merge(const u16* hn_s, const u16* oa_s, const u16* ob_s, const u16* Win, const u16* Waup, const u16* Wbup, u16* mb_s, float* red) {
    SK_SETUP
    SK_LOOP(256) { const int n0 = (it >> 2) * 16, rg = it & 3, r = rg * 32 + 16 * w + fr; const size_t bo = (size_t)(n0 + fr) * DM, ao = (size_t)(rg * 32) * DM;
        const f32x4 g1 = sk_ks<4, 2, 4>(hn_s + ao, DM, Win + (size_t)6144 * DM + bo, red, w, fr, fq, lane), a = sk_ks<4, 2, 4>(oa_s + ao, DM, Waup + bo, red, w, fr, fq, lane);
        const f32x4 g2 = sk_ks<4, 2, 4>(hn_s + ao, DM, Win + (size_t)7168 * DM + bo, red, w, fr, fq, lane), b = sk_ks<4, 2, 4>(ob_s + ao, DM, Wbup + bo, red, w, fr, fq, lane);
        if (w < 2) *(u32x2*)(mb_s + (size_t)r * DM + n0 + 4 * fq) = pk4(sig4(g1) * a + sig4(g2) * b); }
}

#define XB_TMO      128
#define XB_XCNT(j)  (256  + 64 * (j))
#define XB_XSUB(j)  (1280 + 64 * (j))
#define XB_XGEN(j)  (2304 + 64 * (j))
#define XB_TOP      3328
#define XB_TOPGEN   3392
#define XCD_BAR_WORDS 3456
#define XB_SPIN_CAP (1u << 18)
__device__ __forceinline__ unsigned xb_ld(unsigned* p)              { return __hip_atomic_load(p, __ATOMIC_RELAXED, __HIP_MEMORY_SCOPE_AGENT); }
__device__ __forceinline__ unsigned xb_add(unsigned* p, unsigned v) { return __hip_atomic_fetch_add(p, v, __ATOMIC_RELAXED, __HIP_MEMORY_SCOPE_AGENT); }
__device__ __forceinline__ unsigned xb_xcc_id() { return (unsigned)__builtin_amdgcn_s_getreg((3 << 11) | 20) & 0xFu; }
#define XB_SPIN(cond, bar) do { unsigned _sp = 0; while (cond) { __builtin_amdgcn_s_sleep(1); \
    if ((++_sp & 255u) == 0u) { if (xb_ld(&(bar)[XB_TMO])) break; if (_sp > XB_SPIN_CAP) { atomicAdd(&(bar)[XB_TMO], 1u); break; } } } } while (0)
struct XcdBarrier { unsigned* bar; unsigned x; volatile LAS unsigned* st; };
__device__ __forceinline__ XcdBarrier xcd_barrier_post(unsigned* bar, volatile LAS unsigned* st) {
    XcdBarrier b; b.bar = bar; b.x = xb_xcc_id(); b.st = st;
    if (threadIdx.x == 0) (void)xb_add(&bar[XB_XCNT(b.x)], 1u);
    return b;
}
__device__ __forceinline__ void xcd_barrier_complete(unsigned* bar, unsigned x, unsigned& nloc, unsigned& nx) {
    const unsigned G = gridDim.x * gridDim.y * gridDim.z;
    unsigned sum, cnt, mine, sp = 0u;
    for (;;) {
        sum = 0u; cnt = 0u; mine = 0u;
#pragma unroll
        for (unsigned j = 0; j < 16; ++j) { const unsigned c = xb_ld(&bar[XB_XCNT(j)]); sum += c; cnt += (c > 0u) ? 1u : 0u; mine = (j == x) ? c : mine; }
        if (sum == G) break;
        __builtin_amdgcn_s_sleep(1);
        if ((++sp & 255u) == 0u) { if (xb_ld(&bar[XB_TMO])) break; if (sp > XB_SPIN_CAP) { atomicAdd(&bar[XB_TMO], 1u); break; } }
    }
    nloc = mine > 0u ? mine : 1u; nx = cnt > 0u ? cnt : 1u;
}
__device__ __forceinline__ void xcd_barrier(const XcdBarrier& b) {
    asm volatile("s_waitcnt vmcnt(0)" ::: "memory");
    __syncthreads();
    if (threadIdx.x == 0) {
        unsigned* bar = b.bar;
        __builtin_amdgcn_s_waitcnt(0);
        unsigned nloc = b.st[0], nx = b.st[1];
        if (nloc == 0u) { xcd_barrier_complete(bar, b.x, nloc, nx); b.st[0] = nloc; b.st[1] = nx; }
        const unsigned old = xb_add(&bar[XB_XSUB(b.x)], 1u);
        const unsigned gen = old / nloc;
        if (old + 1u == (gen + 1u) * nloc) {
            __builtin_amdgcn_fence(__ATOMIC_RELEASE, "agent");
            asm volatile("s_waitcnt vmcnt(0)" ::: "memory");
            const unsigned og = xb_add(&bar[XB_TOP], 1u);
            const unsigned tg = og / nx;
            if (og + 1u == (tg + 1u) * nx) xb_add(&bar[XB_TOPGEN], 1u);
            else XB_SPIN(xb_ld(&bar[XB_TOPGEN]) == tg, bar);
            __builtin_amdgcn_fence(__ATOMIC_ACQUIRE, "agent");
            xb_add(&bar[XB_XGEN(b.x)], 1u);
            asm volatile("s_waitcnt vmcnt(0)" ::: "memory");
        } else {
            XB_SPIN(xb_ld(&bar[XB_XGEN(b.x)]) == gen, bar);
            __builtin_amdgcn_fence(__ATOMIC_ACQUIRE, "agent");
            asm volatile("s_waitcnt vmcnt(0)" ::: "memory");
        }
    }
    __syncthreads();
}

#define GSYNC() xcd_barrier(xbar)
#define GSYNC_CG() do { asm volatile("s_waitcnt vmcnt(0) lgkmcnt(0)" ::: "memory"); grid.sync(); } while (0)
#ifndef PROBE
#define PROBE 0
#endif
#ifndef STOP_AT
#define STOP_AT 99
#endif
__device__ __forceinline__ void dumpcp(const unsigned char* src, unsigned char* dst, size_t bytes) {
    for (size_t i = ((size_t)blockIdx.x * 512 + threadIdx.x) * 16; i < bytes; i += (size_t)gridDim.x * 512 * 16) *(u32x4*)(dst + i) = *(const u32x4*)(src + i);
}
#define STOPCHK(n) do { if (STOP_AT == (n)) { if ((n) == 4) { dumpcp(P.ws + WS_R0, (unsigned char*)(P.out + O_HS), 2 * SLOT); dumpcp(P.ws + WS_R2, (unsigned char*)P.out + SLOT, SLOT); }  if ((n) == 2 || (n) == 14) { DEF_PTRS final_norm(X1, P.in[27], P.out + O_YP, P.out + O_YS); } return; } } while (0)
#define DEF_PTRS \
    unsigned char* ws = opq(P.ws); unsigned char* ob = opq((unsigned char*)P.out); (void)ob; \
    u16* Wgu = (u16*)(ws + WS_WGU); u16* Wd = (u16*)(ws + WS_WD); u16* Win = (u16*)(ws + WS_WIN); u16* Wbd = (u16*)(ws + WS_WBD); \
    u16* Waup = (u16*)(ws + WS_WAUP); u16* Wbup = (u16*)(ws + WS_WBUP); u16* Wout = (u16*)(ws + WS_WOUT); \
    float* X1 = (float*)(ws + WS_X1); float* LBv = (float*)(ws + WS_LB); float* LCv = (float*)(ws + WS_LC); \
    const B16 HN = {(u16*)(ws + WS_HN), (u16*)(ws + WS_SIDE + 0 * SSLOT)}; \
    const B16 QS = {(u16*)(ws + WS_R0), (u16*)(ws + WS_SIDE + 1 * SSLOT)}; \
    const B16 LF = {(u16*)(ws + WS_R1), (u16*)(ws + WS_SIDE + 2 * SSLOT)}; \
    const B16 VV = {(u16*)(ws + WS_R2), (u16*)(ws + WS_SIDE + 3 * SSLOT)}; \
    const B16 GS = {(u16*)(ob + O_YP * 4), (u16*)(ws + WS_SIDE + 4 * SSLOT)}; \
    const B16 XR = {(u16*)(ws + WS_R0), (u16*)(ws + WS_SIDE + 5 * SSLOT)}; \
    const B16 YG = {(u16*)(ws + WS_R1), (u16*)(ws + WS_SIDE + 6 * SSLOT)}; \
    const B16 XC = {(u16*)(ws + WS_R2), (u16*)(ws + WS_SIDE + 7 * SSLOT)}; \
    const B16 TA = {(u16*)(ws + WS_R0), (u16*)(ws + WS_SIDE + 8 * SSLOT)}; \
    const B16 GT = {(u16*)(ws + WS_R2), (u16*)(ws + WS_SIDE + 9 * SSLOT)}; \
    const B16 MB = {(u16*)(ob + O_YP * 4) + (size_t)TP * DM, (u16*)(ws + WS_SIDE + 10 * SSLOT)}; \
    const B16 ACT = {(u16*)(ws + WS_R0), (u16*)(ws + WS_ACTS)}; \
    (void)Wgu; (void)Wd; (void)Win; (void)Wbd; (void)Waup; (void)Wbup; (void)Wout; (void)X1; (void)LBv; (void)LCv; \
    (void)HN; (void)QS; (void)LF; (void)VV; (void)GS; (void)XR; (void)YG; (void)XC; (void)TA; (void)GT; (void)MB; (void)ACT;

__global__ void __launch_bounds__(512, 2) mega(const float* i0, const float* i1, const float* i2, const float* i3, const float* i4, const float* i5, const float* i6, const float* i7, const float* i8, const float* i9, const float* i10, const float* i11, const float* i12, const float* i13, const float* i14, const float* i15, const float* i16, const float* i17, const float* i18, const float* i19, const float* i20, const float* i21, const float* i22, const float* i23, const float* i24, const float* i25, const float* i26, const float* i27, float* outp, unsigned char* wsp) {
    Params P;
    P.in[0] = i0; P.in[1] = i1; P.in[2] = i2; P.in[3] = i3; P.in[4] = i4; P.in[5] = i5; P.in[6] = i6; P.in[7] = i7; P.in[8] = i8; P.in[9] = i9; P.in[10] = i10; P.in[11] = i11; P.in[12] = i12; P.in[13] = i13; P.in[14] = i14; P.in[15] = i15; P.in[16] = i16; P.in[17] = i17; P.in[18] = i18; P.in[19] = i19; P.in[20] = i20; P.in[21] = i21; P.in[22] = i22; P.in[23] = i23; P.in[24] = i24; P.in[25] = i25; P.in[26] = i26; P.in[27] = i27;
    P.out = outp; P.ws = wsp;
    extern __shared__ __attribute__((aligned(16))) unsigned char shm[];
    cg::grid_group grid = cg::this_grid();
    LAS unsigned char* lds = (LAS unsigned char*)shm;
    const int G = gridDim.x, cblk = blockIdx.x;
    volatile LAS unsigned* xst = (volatile LAS unsigned*)(lds + (LDS_BYTES - 16));
    if (threadIdx.x == 0) { xst[0] = 0u; xst[1] = 0u; xst[2] = 0u; xst[3] = 0u; }
    __syncthreads();
    const XcdBarrier xbar = xcd_barrier_post((unsigned*)(P.ws + WS_BAR), xst);

    {
        DEF_PTRS
        float* tile = (float*)shm;
        for (int rep = 0; rep < (PROBE == 7 ? 2 : 1); ++rep)
        for (int t = cblk; t < 4928; t += G) {
            if (t < 704) conv_matrix(P.in[6], 1024, 2816, Wgu, 1, t, tile);
            else if (t < 1408) conv_matrix(P.in[7], 1024, 2816, Wgu, 2, t - 704, tile);
            else if (t < 2112) conv_matrix(P.in[8], 2816, 1024, Wd, 0, t - 1408, tile);
            else if (t < 4160) conv_matrix(P.in[10], 1024, 8192, Win, 0, t - 2112, tile);
            else if (t < 4416) conv_matrix(P.in[20], 1024, 1024, Waup, 0, t - 4160, tile);
            else if (t < 4672) conv_matrix(P.in[21], 1024, 1024, Wbup, 0, t - 4416, tile);
            else conv_matrix(P.in[22], 1024, 1024, Wout, 0, t - 4672, tile);
        }
        for (int idx = cblk * 512 + TIDX; idx < 8 * 256 * 256; idx += G * 512) {
            const int n = idx >> 16, row = (idx >> 8) & 255, kk = idx & 255, bj = row >> 7, d = row & 127;
            float v = 0.f; if ((kk >> 7) == (n & 1)) v = (bj ? P.in[17] : P.in[15])[(size_t)n * 16384 + (kk & 127) * 128 + d];
            Wbd[idx] = f2b(v);
        }
        if (PROBE == 12 || PROBE == 13) { unsigned char* dst = (PROBE == 12) ? (ws + WS_R2) : ((unsigned char*)P.out + SLOT);
            for (int rep = 0; rep < 4; ++rep) for (size_t i = ((size_t)cblk * 512 + TIDX) * 16; i < SLOT; i += (size_t)G * 512 * 16) *(u32x4*)(dst + i) = (u32x4){(unsigned)rep, 0u, 0u, 0u}; }
        if (cblk == 0) { for (int c = TIDX; c < 1024; c += 512) { LBv[c] = 1.f / (1.f + __expf(P.in[11][1024 + c] - P.in[11][c])); LCv[c] = -8.f * log1pf(__expf(-P.in[19][c])); } }
        norm_rows(P.in[0], P.in[1], P.in[5], HN); if (PROBE == 6) norm_rows(P.in[0], P.in[1], P.in[5], HN);
    }
    GSYNC_CG(); STOPCHK(0);
    { DEF_PTRS SchedSimple S{HN.p, HN.s, Wgu, DM, DM, 22, G, cblk, 0}; EpiGU E{ACT}; gemm_phase(lds, DM, DM, S, E); if (PROBE == 1) gemm_phase(lds, DM, DM, S, E); sk_gu(HN.s, Wgu, ACT.s, (float*)shm); if (PROBE == 9) sk_gu(HN.s, Wgu, ACT.s, (float*)shm); }
    GSYNC(); STOPCHK(1);
    { DEF_PTRS SchedSimple S{ACT.p, ACT.s, Wd, DFF, DFF, 4, G, cblk, 0}; EpiRes E{P.in[0], P.in[1], TS, X1, 0.5f}; gemm_phase(lds, DFF, DFF, S, E); if (PROBE == 22) gemm_phase(lds, DFF, DFF, S, E); sk_res<11>(ACT.s, Wd, P.in[1], X1 + (size_t)TP * DM, 0.5f, (float*)shm); }
    GSYNC(); STOPCHK(2);
    {
        DEF_PTRS
        float* tile = (float*)shm;
        for (int t = cblk; t < 2112; t += G) {
            if (t < 704) conv_matrix(P.in[24], 1024, 2816, Wgu, 1, t, tile);
            else if (t < 1408) conv_matrix(P.in[25], 1024, 2816, Wgu, 2, t - 704, tile);
            else conv_matrix(P.in[26], 2816, 1024, Wd, 0, t - 1408, tile);
        }
        norm_rows(X1, X1 + (size_t)TP * DM, P.in[9], HN);
    }
    GSYNC(); STOPCHK(3);
    { DEF_PTRS SchedSimple S{HN.p, HN.s, Win, DM, DM, 16, G, cblk, 0}; EpiInA E{QS, LF, VV, GS, LBv}; gemm_phase(lds, DM, DM, S, E); if (PROBE == 11) gemm_phase(lds, DM, DM, S, E); sk_ina(HN.s, Win, QS.s, LF.s, VV.s, GS.s, LBv, (float*)shm); if (PROBE == 9) sk_ina(HN.s, Win, QS.s, LF.s, VV.s, GS.s, LBv, (float*)shm); }
    GSYNC(); STOPCHK(4);
    hgrn_h1(P, shm); if (PROBE == 3) hgrn_h1(P, shm);
    GSYNC(); STOPCHK(5);
    hgrn_h2(P);
    if (PROBE == 21) { GSYNC(); GSYNC(); GSYNC(); GSYNC(); }
    if (PROBE == 8) { GSYNC(); hgrn_h1(P, shm); GSYNC(); hgrn_h2(P); }
    GSYNC(); STOPCHK(6);
    if (PROBE == 18) hgrn_h3(P, shm, (u16*)(P.out + O_YP) + (size_t)TP * DM);
    hgrn_h3(P, shm, (u16*)(P.out + O_YP));
    GSYNC(); STOPCHK(7);
    { DEF_PTRS SchedSimple S{HN.p, HN.s, Win + (size_t)4096 * DM, DM, DM, 8, G, cblk, 0}; EpiInB E{XR, YG}; gemm_phase(lds, DM, DM, S, E); if (PROBE == 14) gemm_phase(lds, DM, DM, S, E); if (PROBE == 27 || PROBE == 28 || PROBE == 29) { SchedLim SL{HN.p, HN.s, Win + (size_t)4096 * DM, DM, DM, 8, G, cblk, PROBE == 27 ? 1 : (PROBE == 28 ? 2 : 4)}; EpiNull EN{(float*)(ws + WS_AGG)}; gemm_phase(lds, DM, DM, SL, EN); }
        if (PROBE == 25 || PROBE == 26) { SchedLim SL{HN.p, HN.s, Win + (size_t)4096 * DM, DM, DM, 8, G, cblk, PROBE == 25 ? 1 : 2}; EpiInBP EP{(u16*)(P.out + O_HS), 1024}; gemm_phase(lds, DM, DM, SL, EP); } if (PROBE == 23) { EpiInBP EP{(u16*)(P.out + O_HS), 1088}; gemm_phase(lds, DM, DM, S, EP); } if (PROBE == 24) { EpiInBP EP{(u16*)(P.out + O_HS), 1024}; gemm_phase(lds, DM, DM, S, EP); } if (PROBE == 15) { EpiNull EN{(float*)(ws + WS_AGG)}; gemm_phase(lds, DM, DM, S, EN); } sk_inb(HN.s, Win, XR.s, YG.s, (float*)shm); if (PROBE == 9) sk_inb(HN.s, Win, XR.s, YG.s, (float*)shm); }
    GSYNC(); STOPCHK(8);
    conv_phase(P); if (PROBE == 4) conv_phase(P); if (PROBE == 20) hgrn_sample(P, shm, (u16*)(P.ws + WS_SIDE + 10 * SSLOT)); hgrn_sample(P, shm, (u16*)(P.ws + WS_SIDE + 4 * SSLOT));
    GSYNC(); STOPCHK(9);
    { DEF_PTRS SchedSimple S{XC.p, XC.s, Wbd, DM, 256, 8, G, cblk, 256}; EpiBD E{XC, XR, P.in[16], P.in[18], LCv}; gemm_phase(lds, 256, DM, S, E); sk_bd(XC.s, Wbd, P.in[16], P.in[18], LCv, TA.s, XR.s); }
    GSYNC(); STOPCHK(10);
    lru_pass1(P); if (PROBE == 5) lru_pass1(P);
    GSYNC(); STOPCHK(11);
    if (PROBE == 19) lru_pass2(P, (unsigned*)((u16*)(P.out + O_YP) + (size_t)TP * DM), true);
    lru_pass2(P, (unsigned*)(P.ws + WS_R1), false);
    GSYNC(); STOPCHK(12);
    { DEF_PTRS SchedMerge S{HN, GS, YG, Win, Waup, Wbup, G, cblk}; EpiMerge E{GT, TA, MB}; gemm_phase(lds, DM, DM, S, E); if (PROBE == 10) gemm_phase(lds, DM, DM, S, E); sk_merge(HN.s, GS.s, YG.s, Win, Waup, Wbup, MB.s, (float*)shm); if (PROBE == 9) sk_merge(HN.s, GS.s, YG.s, Win, Waup, Wbup, MB.s, (float*)shm); }
    GSYNC(); STOPCHK(13);
    { DEF_PTRS SchedSimple S{MB.p, MB.s, Wout, DM, DM, 4, G, cblk, 0}; EpiRes E{X1, X1 + (size_t)TP * DM, 256, X1, 1.0f}; gemm_phase(lds, DM, DM, S, E); sk_res<4>(MB.s, Wout, X1 + (size_t)TP * DM, X1 + (size_t)TP * DM, 1.0f, (float*)shm); }
    GSYNC(); STOPCHK(14);
    { DEF_PTRS norm_rows(X1, X1 + (size_t)TP * DM, P.in[23], HN); }
    GSYNC(); STOPCHK(15);
    { DEF_PTRS SchedSimple S{HN.p, HN.s, Wgu, DM, DM, 22, G, cblk, 0}; EpiGU E{ACT}; gemm_phase(lds, DM, DM, S, E); sk_gu(HN.s, Wgu, ACT.s, (float*)shm); if (PROBE == 9) sk_gu(HN.s, Wgu, ACT.s, (float*)shm); }
    GSYNC(); STOPCHK(16);
    { DEF_PTRS SchedSimple S{ACT.p, ACT.s, Wd, DFF, DFF, 4, G, cblk, 0}; EpiRes E{X1, X1 + (size_t)TP * DM, 256, X1, 0.5f}; gemm_phase(lds, DFF, DFF, S, E); sk_res<11>(ACT.s, Wd, X1 + (size_t)TP * DM, X1 + (size_t)TP * DM, 0.5f, (float*)shm); }
    GSYNC(); STOPCHK(17);
    { DEF_PTRS final_norm(X1, P.in[27], P.out + O_YP, P.out + O_YS); }
}

extern "C" void kernel_launch(void* const* d_in, const int* in_sizes, int n_in, void* d_out, int out_size, void* d_ws, size_t ws_size, hipStream_t stream) {
    static int grid = 0;
    if (grid == 0) {
        int dev = 0, cus = 0, per_cu = 0;
        if (n_in != 28 || ws_size < WS_END) { fprintf(stderr, "kernel_launch: unexpected n_in %d / ws_size %zu (need %zu)\n", n_in, ws_size, (size_t)WS_END); grid = -1; return; }
        (void)hipGetDevice(&dev); (void)hipDeviceGetAttribute(&cus, hipDeviceAttributeMultiprocessorCount, dev);
        if (hipFuncSetAttribute((const void*)mega, hipFuncAttributeMaxDynamicSharedMemorySize, LDS_BYTES) != hipSuccess) { fprintf(stderr, "kernel_launch: hipFuncSetAttribute failed\n"); grid = -1; return; }
        if (hipOccupancyMaxActiveBlocksPerMultiprocessor(&per_cu, (const void*)mega, 512, LDS_BYTES) != hipSuccess || per_cu < 1) { fprintf(stderr, "kernel_launch: occupancy query gave %d\n", per_cu); per_cu = 1; (void)hipGetLastError(); }
        grid = cus * 1;
    }
    if (grid < 0) return;
    const float* ins[28]; for (int i = 0; i < 28; ++i) ins[i] = (const float*)d_in[i];
    float* outp = (float*)d_out; unsigned char* wsp = (unsigned char*)d_ws;
    if (hipMemsetAsync((char*)d_ws + WS_BAR, 0, 16384, stream) != hipSuccess) { fprintf(stderr, "kernel_launch: memset failed\n"); return; }
    void* args[30]; for (int i = 0; i < 28; ++i) args[i] = (void*)&ins[i];
    args[28] = (void*)&outp; args[29] = (void*)&wsp;
    hipError_t e = hipLaunchCooperativeKernel((void*)mega, dim3(grid), dim3(512), args, LDS_BYTES, stream);
    if (e != hipSuccess) fprintf(stderr, "cooperative launch failed: %s (grid %d)\n", hipGetErrorString(e), grid);
}
```

```cpp
#include <hip/hip_runtime.h>
#include <hip/hip_cooperative_groups.h>
#include <cstdio>
namespace cg = cooperative_groups;

#define LAS __attribute__((address_space(3)))
typedef unsigned short u16;
typedef short bf16x8 __attribute__((ext_vector_type(8)));
typedef float f32x4 __attribute__((ext_vector_type(4)));
typedef unsigned u32x4 __attribute__((ext_vector_type(4)));
typedef unsigned u32x2 __attribute__((ext_vector_type(2)));

constexpr int TP = 16384, TS = 128, NTOK = TP + TS, DM = 1024, DFF = 2816, SEQ = 2048;
constexpr float EPSV = 1e-6f;
constexpr int LDS_BYTES = 147456;

constexpr size_t SLOT = (size_t)TP * DM * 2;
constexpr size_t SSLOT = (size_t)256 * DM * 2;
constexpr size_t WS_WGU = 0;
constexpr size_t WS_WD = WS_WGU + (size_t)5632 * 1024 * 2;
constexpr size_t WS_WIN = WS_WD + (size_t)1024 * 2816 * 2;
constexpr size_t WS_WBD = WS_WIN + (size_t)8192 * 1024 * 2;
constexpr size_t WS_WAUP = WS_WBD + (size_t)8 * 256 * 256 * 2;
constexpr size_t WS_WBUP = WS_WAUP + (size_t)1024 * 1024 * 2;
constexpr size_t WS_WOUT = WS_WBUP + (size_t)1024 * 1024 * 2;
constexpr size_t WS_X1 = WS_WOUT + (size_t)1024 * 1024 * 2;
constexpr size_t WS_HN = WS_X1 + (size_t)16640 * DM * 4;
constexpr size_t WS_R0 = WS_HN + SLOT;
constexpr size_t WS_R1 = WS_R0 + SLOT;
constexpr size_t WS_R2 = WS_R1 + SLOT;
constexpr size_t WS_SIDE = WS_R2 + SLOT;
constexpr size_t WS_ACTS = WS_SIDE + 11 * SSLOT;
constexpr size_t WS_BL = WS_ACTS + (size_t)256 * DFF * 2;
constexpr size_t WS_AGG = WS_BL + (size_t)2048 * 128 * 4;
constexpr size_t WS_LB = WS_AGG + (size_t)256 * 1024 * 8;
constexpr size_t WS_LC = WS_LB + 4096;
constexpr size_t WS_BAR = WS_LC + 4096;
constexpr size_t WS_END = WS_BAR + 16384;
static_assert(WS_END <= (size_t)268435456, "workspace too large");
constexpr size_t O_YP = 0, O_YS = 16777216, O_HP = 16908288, O_LP = 17956864, O_CP = 17965056, O_HS = 17989632, O_LS = 34766848, O_CS = 34897920;

struct Params { const float* in[28]; float* out; unsigned char* ws; };
struct B16 { u16* p; u16* s; };

typedef __bf16 bf16x2_t __attribute__((ext_vector_type(2)));
typedef float f32x2_t __attribute__((ext_vector_type(2)));
__device__ __forceinline__ unsigned pk(float lo, float hi) { const f32x2_t v = {lo, hi}; const bf16x2_t b = __builtin_convertvector(v, bf16x2_t); return __builtin_bit_cast(unsigned, b); }
__device__ __forceinline__ float blo(unsigned w) { return __uint_as_float(w << 16); }
__device__ __forceinline__ float bhi(unsigned w) { return __uint_as_float(w & 0xffff0000u); }
__device__ __forceinline__ float b2f(u16 b) { return __uint_as_float(((unsigned)b) << 16); }
__device__ __forceinline__ u16 f2b(float f) { return (u16)(pk(f, 0.f) & 0xffffu); }
__device__ __forceinline__ float sigm(float x) { return __builtin_amdgcn_rcpf(1.f + __builtin_amdgcn_exp2f(-1.4426950408889634f * x)); }
__device__ __forceinline__ float silu(float x) { return x * __builtin_amdgcn_rcpf(1.f + __builtin_amdgcn_exp2f(-1.4426950408889634f * x)); }
__device__ __forceinline__ float gelu_t(float x) { const float x2 = x * x; const float t = x2 * (-0.10294324f) + (-2.3022082f); return x * __builtin_amdgcn_rcpf(1.f + __builtin_amdgcn_exp2f(x * t)); }
__device__ __forceinline__ unsigned pkh(float lo, float hi) { const _Float16 a = (_Float16)lo, b = (_Float16)hi; return (unsigned)__builtin_bit_cast(u16, a) | ((unsigned)__builtin_bit_cast(u16, b) << 16); }
__device__ __forceinline__ float h2f(u16 h) { return (float)__builtin_bit_cast(_Float16, h); }
__device__ __forceinline__ u32x4 pack8(const float* o) { u32x4 r; r.x = pk(o[0], o[1]); r.y = pk(o[2], o[3]); r.z = pk(o[4], o[5]); r.w = pk(o[6], o[7]); return r; }
__device__ __forceinline__ void unpack8(u32x4 w, float* o) { o[0] = blo(w.x); o[1] = bhi(w.x); o[2] = blo(w.y); o[3] = bhi(w.y); o[4] = blo(w.z); o[5] = bhi(w.z); o[6] = blo(w.w); o[7] = bhi(w.w); }
template <class T> __device__ __forceinline__ T* asg(T* p) { return (T*)(__attribute__((address_space(1))) T*)p; }
__device__ __forceinline__ unsigned char* opq(unsigned char* p) { return p; }
__device__ __forceinline__ int opqv(int v) { asm volatile("" : "+v"(v)); return v; }
#define TIDX opqv((int)threadIdx.x)
struct F8 { f32x4 a, b; };
__device__ __forceinline__ F8 unpack8v(u32x4 w) { F8 r; r.a = (f32x4){blo(w.x), bhi(w.x), blo(w.y), bhi(w.y)}; r.b = (f32x4){blo(w.z), bhi(w.z), blo(w.w), bhi(w.w)}; return r; }
__device__ __forceinline__ u32x4 pack8v(f32x4 a, f32x4 b) { u32x4 r; r.x = pk(a.x, a.y); r.y = pk(a.z, a.w); r.z = pk(b.x, b.y); r.w = pk(b.z, b.w); return r; }
__device__ __forceinline__ u32x4 pack8h(f32x4 a, f32x4 b) { u32x4 r; r.x = pkh(a.x, a.y); r.y = pkh(a.z, a.w); r.z = pkh(b.x, b.y); r.w = pkh(b.z, b.w); return r; }
__device__ __forceinline__ f32x4 sig4(f32x4 v) { return (f32x4){sigm(v.x), sigm(v.y), sigm(v.z), sigm(v.w)}; }
__device__ __forceinline__ f32x4 silu4(f32x4 v) { return (f32x4){silu(v.x), silu(v.y), silu(v.z), silu(v.w)}; }
__device__ __forceinline__ f32x4 gelu4(f32x4 v) { return (f32x4){gelu_t(v.x), gelu_t(v.y), gelu_t(v.z), gelu_t(v.w)}; }
__device__ __forceinline__ f32x4 log4(f32x4 v) { return (f32x4){__logf(v.x), __logf(v.y), __logf(v.z), __logf(v.w)}; }
__device__ __forceinline__ u32x2 pk4(f32x4 v) { u32x2 o; o.x = pk(v.x, v.y); o.y = pk(v.z, v.w); return o; }
__device__ __forceinline__ f32x4 up4(u32x2 w) { return (f32x4){blo(w.x), bhi(w.x), blo(w.y), bhi(w.y)}; }
__device__ __forceinline__ float wave_sum(float v) {
#pragma unroll
    for (int o = 32; o >= 1; o >>= 1) v += __shfl_xor(v, o, 64);
    return v;
}

constexpr int BM = 256, BK = 64, HALF = 128, HTB = HALF * BK * 2;
__device__ __forceinline__ int lds_byte(int r, int c) { const int st = (r >> 4) * 2 + (c >> 5), rr = r & 15, cc = c & 31, ob = rr * 64 + cc * 2; return st * 1024 + (ob ^ (((ob >> 9) & 1) << 5)); }
__device__ __forceinline__ void stage_rc(int b, int& R, int& C) { const int st = b / 1024, sb = b % 1024, swz = sb ^ (((sb >> 9) & 1) << 5); R = (st >> 1) * 16 + swz / 64; C = (st & 1) * 32 + (swz % 64) / 2; }
__device__ __forceinline__ int perm32(int rho) { const int n = rho >> 4, i = rho & 15; return 8 * (i >> 2) + 4 * n + (i & 3); }

struct Unit { int pm, pn, sub; const char* a; const char* b; };

__device__ __forceinline__ bool tile_of(long L, int nM, int nN, int& pm, int& pn) {
    const int nwg = nM * nN; if (L >= nwg) return false;
    int wgid = (int)L; { const int q = nwg / 8, r = nwg % 8, xcd = wgid % 8, off = wgid / 8; wgid = (xcd < r ? xcd * (q + 1) : r * (q + 1) + (xcd - r) * q) + off; }
    const int nig = 8 * nN, gid = wgid / nig, fm = gid * 8, gsz = (nM - fm) < 8 ? (nM - fm) : 8;
    pm = fm + ((wgid % nig) % gsz); pn = (wgid % nig) / gsz; return true;
}

template <class Epi, class Sched>
__device__ __forceinline__ void gemm_phase(LAS unsigned char* lds, const int K, const int lda, const Sched& S, const Epi& E) {
    const int tid = TIDX, wid = __builtin_amdgcn_readfirstlane(tid >> 6), lane = tid & 63, wr = wid >> 2, wc = wid & 3, fr = lane & 15, fq = lane >> 4;
    const int nt = K / BK;
    unsigned voffA[2], voffB[2];
#pragma unroll
    for (int i = 0; i < 2; ++i) { int R, C; stage_rc(tid * 16 + i * 8192, R, C); const int Rb = Epi::PERM ? ((R & ~31) + perm32(R & 31)) : R;
        voffA[i] = (unsigned)(R * lda + C) * 2u; voffB[i] = (unsigned)(Rb * K + C) * 2u; }
    const size_t kstep = (size_t)(BK * 2);
    const size_t hstepA = (size_t)HALF * lda * 2, hstepB = (size_t)HALF * K * 2;
    const unsigned ldsw = (unsigned)wid * 1024u;
    const int aoff = lds_byte(wr * 64 + fr, fq * 8), boff = lds_byte(wc * 32 + fr, fq * 8);
#define G_SA(b, h) (((b) * 2 + (h)) * HTB)
#define G_SB(b, h) ((4 + (b) * 2 + (h)) * HTB)
#define G_STAGE(bufoff, gbase, voff) do { _Pragma("unroll") for (int _i = 0; _i < 2; ++_i) \
        __builtin_amdgcn_global_load_lds((const unsigned*)((const char*)(gbase) + (voff)[_i]), (LAS unsigned*)(lds + (bufoff) + ldsw + _i * 8192), 16, 0, 0); } while (0)
#define G_LDA(dst, b, h) do { _Pragma("unroll") for (int m = 0; m < 4; ++m) _Pragma("unroll") for (int k = 0; k < 2; ++k) dst[m][k] = *(const LAS bf16x8*)(lds + G_SA(b, h) + aoff + m * 2048 + k * 1024); } while (0)
#define G_LDB(dst, b, h) do { _Pragma("unroll") for (int n = 0; n < 2; ++n) _Pragma("unroll") for (int k = 0; k < 2; ++k) dst[n][k] = *(const LAS bf16x8*)(lds + G_SB(b, h) + boff + n * 2048 + k * 1024); } while (0)
#define G_MMA(ai, bj, At, Bt) do { __builtin_amdgcn_s_setprio(1); _Pragma("unroll") for (int m = 0; m < 4; ++m) _Pragma("unroll") for (int n = 0; n < 2; ++n) _Pragma("unroll") for (int k = 0; k < 2; ++k) \
        acc[ai][bj][m][n] = __builtin_amdgcn_mfma_f32_16x16x32_bf16(Bt[n][k], At[m][k], acc[ai][bj][m][n], 0, 0, 0); __builtin_amdgcn_s_setprio(0); } while (0)
#define G_WAIT_V(n) asm volatile("s_waitcnt vmcnt(" #n ")" ::: "memory")
#define G_WAIT_L(n) asm volatile("s_waitcnt lgkmcnt(" #n ")" ::: "memory")
#define G_BAR __builtin_amdgcn_s_barrier()
#define G_SCHED __builtin_amdgcn_sched_barrier(0)
    Unit cur, nxt; int ui = 0;
    if (!S.next(0, cur)) return;
    f32x4 acc[2][2][4][2];
#pragma unroll
    for (int a = 0; a < 2; ++a)
#pragma unroll
        for (int b = 0; b < 2; ++b)
#pragma unroll
            for (int m = 0; m < 4; ++m)
#pragma unroll
                for (int n = 0; n < 2; ++n) acc[a][b][m][n] = (f32x4){0.f, 0.f, 0.f, 0.f};
    bf16x8 At[4][2], B0[2][2], B1[2][2];
    const char* cA = cur.a; const char* cB = cur.b;
    G_STAGE(G_SB(0, 0), cB, voffB); G_STAGE(G_SA(0, 0), cA, voffA); G_STAGE(G_SB(0, 1), cB + hstepB, voffB); G_STAGE(G_SA(0, 1), cA + hstepA, voffA);
    if (wr == 1) G_BAR;
    G_WAIT_V(4); G_BAR;
    G_STAGE(G_SB(1, 0), cB + kstep, voffB); G_STAGE(G_SA(1, 0), cA + kstep, voffA); G_STAGE(G_SB(1, 1), cB + hstepB + kstep, voffB);
    G_WAIT_V(6); G_BAR;
    for (;;) {
        const bool has_next = S.next(ui + 1, nxt);
        const char* nA = has_next ? nxt.a : cA; const char* nB = has_next ? nxt.b : cB;
        for (int t = 0; t < nt; t += 2) {
            const bool last = (t == nt - 2);
            const char* a1 = cA + (size_t)(t + 1) * kstep;
            const char* a2 = last ? nA : cA + (size_t)(t + 2) * kstep; const char* b2 = last ? nB : cB + (size_t)(t + 2) * kstep;
            const char* a3 = a2 + kstep; const char* b3 = b2 + kstep;
            G_LDB(B0, 0, 0); G_SCHED; G_LDA(At, 0, 0); G_STAGE(G_SA(1, 1), a1 + hstepA, voffA);
            G_WAIT_L(8); G_BAR; G_WAIT_L(0); G_MMA(0, 0, At, B0); G_BAR; G_SCHED;
            G_LDB(B1, 0, 1); G_STAGE(G_SB(0, 0), b2, voffB);
            G_BAR; G_WAIT_L(0); G_MMA(0, 1, At, B1); G_BAR;
            G_LDA(At, 0, 1); G_STAGE(G_SA(0, 0), a2, voffA);
            G_BAR; G_WAIT_L(0); G_MMA(1, 0, At, B0); G_BAR; G_SCHED;
            G_STAGE(G_SB(0, 1), b2 + hstepB, voffB);
            G_WAIT_V(6); G_BAR; G_MMA(1, 1, At, B1); G_BAR;
            G_LDB(B0, 1, 0); G_SCHED; G_LDA(At, 1, 0); G_STAGE(G_SA(0, 1), a2 + hstepA, voffA);
            G_WAIT_L(8); G_BAR; G_WAIT_L(0); G_MMA(0, 0, At, B0); G_BAR; G_SCHED;
            G_LDB(B1, 1, 1); G_STAGE(G_SB(1, 0), b3, voffB);
            G_BAR; G_WAIT_L(0); G_MMA(0, 1, At, B1); G_BAR;
            G_LDA(At, 1, 1); G_STAGE(G_SA(1, 0), a3, voffA);
            G_BAR; G_WAIT_L(0); G_MMA(1, 0, At, B0); G_BAR; G_SCHED;
            G_STAGE(G_SB(1, 1), b3 + hstepB, voffB);
            G_WAIT_V(6); G_BAR; G_MMA(1, 1, At, B1); G_BAR;
        }
        E(acc, cur, wr, wc, fr, fq);
        if (!has_next) break;
#pragma unroll
        for (int a = 0; a < 2; ++a)
#pragma unroll
            for (int b = 0; b < 2; ++b)
#pragma unroll
                for (int m = 0; m < 4; ++m)
#pragma unroll
                    for (int n = 0; n < 2; ++n) acc[a][b][m][n] = (f32x4){0.f, 0.f, 0.f, 0.f};
        cur = nxt; cA = nA; cB = nB; ++ui;
    }
    G_WAIT_V(0);
    if (wr == 0) G_BAR;
    G_BAR;
#undef G_SA
#undef G_SB
#undef G_STAGE
#undef G_LDA
#undef G_LDB
#undef G_MMA
#undef G_WAIT_V
#undef G_WAIT_L
#undef G_BAR
#undef G_SCHED
}

struct SchedLim {
    const u16* Ap; const u16* As; const u16* Bt; int lda, K, nN, G, c; int lim;
    __device__ __forceinline__ bool next(int i, Unit& u) const {
        int pm, pn; if (i >= lim || !tile_of((long)(i & 1) * G + c, 64, nN, pm, pn)) return false;
        u.pm = pm; u.pn = pn; u.sub = 0;
        u.a = (const char*)(Ap + (size_t)pm * 256 * lda);
        u.b = (const char*)(Bt + (size_t)pn * 256 * K); return true;
    }
};
struct SchedSimple {
    const u16* Ap; const u16* As; const u16* Bt; int lda, K, nN, G, c; int acol_per_pn;
    __device__ __forceinline__ bool next(int i, Unit& u) const {
        int pm, pn; if (!tile_of((long)i * G + c, 64, nN, pm, pn)) return false;
        u.pm = pm; u.pn = pn; u.sub = 0;
        u.a = (const char*)((pm < 64 ? Ap + (size_t)pm * 256 * lda : As) + (size_t)(pn >> 1) * acol_per_pn);
        u.b = (const char*)(Bt + (size_t)pn * 256 * K); return true;
    }
};
struct SchedMerge {
    B16 hn, oa, ob; const u16* Win; const u16* Waup; const u16* Wbup; int G, c;
    __device__ __forceinline__ bool next(int i, Unit& u) const {
        int pm, pn; if (!tile_of((long)(i >> 2) * G + c, 64, 4, pm, pn)) return false;
        const int sub = i & 3; u.pm = pm; u.pn = pn; u.sub = sub;
        const unsigned long long m1 = (sub == 1) ? ~0ull : 0ull, m3 = (sub == 3) ? ~0ull : 0ull, m0 = ~(m1 | m3);
        const u16* abp = (const u16*)(((unsigned long long)oa.p & m1) | ((unsigned long long)ob.p & m3) | ((unsigned long long)hn.p & m0));
        const u16* abs_ = (const u16*)(((unsigned long long)oa.s & m1) | ((unsigned long long)ob.s & m3) | ((unsigned long long)hn.s & m0));
        const u16* bb = (const u16*)(((unsigned long long)Waup & m1) | ((unsigned long long)Wbup & m3) | ((unsigned long long)(Win + (size_t)(sub == 0 ? 6144 : 7168) * DM) & m0));
        u.a = (const char*)(pm < 64 ? abp + (size_t)pm * 256 * DM : abs_);
        u.b = (const char*)(bb + (size_t)pn * 256 * DM); return true;
    }
};

struct EpiGU {
    static constexpr bool PERM = true; B16 act;
    __device__ __forceinline__ void operator()(const f32x4 (&acc)[2][2][4][2], const Unit& u, int wr, int wc, int fr, int fq) const {
        u16* base = (u.pm < 64 ? act.p + (size_t)u.pm * 256 * DFF : act.s) + u.pn * 128 + wc * 32 + 8 * fq;
#pragma unroll
        for (int ai = 0; ai < 2; ++ai)
#pragma unroll
            for (int m = 0; m < 4; ++m) {
                const int rt = ai * 128 + wr * 64 + m * 16 + fr; float o[8];
#pragma unroll
                for (int n = 0; n < 2; ++n)
#pragma unroll
                    for (int j = 0; j < 4; ++j) o[n * 4 + j] = silu(acc[ai][0][m][n][j]) * acc[ai][1][m][n][j];
                *(u32x4*)(base + (size_t)rt * DFF) = pack8(o);
            }
    }
};
template <bool R16> struct EpiResT {
    static constexpr bool PERM = true; const void* rp; u16* out; float scale;
    __device__ __forceinline__ void operator()(const f32x4 (&acc)[2][2][4][2], const Unit& u, int wr, int wc, int fr, int fq) const {
        const size_t o0 = (size_t)(u.pm * 256 + wr * 64 + fr) * DM + u.pn * 256 + wc * 32 + 8 * fq;
#pragma unroll
        for (int ai = 0; ai < 2; ++ai)
#pragma unroll
            for (int m = 0; m < 4; ++m) {
#pragma unroll
                for (int bj = 0; bj < 2; ++bj) { const size_t off = o0 + (size_t)(ai * 128 + m * 16) * DM + bj * 128;
                    f32x4 r0, r1;
                    if (R16) { const F8 rv = unpack8v(*(const u32x4*)((const u16*)rp + off)); r0 = rv.a; r1 = rv.b; }
                    else { r0 = *(const f32x4*)((const float*)rp + off); r1 = *(const f32x4*)((const float*)rp + off + 4); }
                    *(u32x4*)(out + off) = pack8v(r0 + scale * acc[ai][bj][m][0], r1 + scale * acc[ai][bj][m][1]); }
                asm volatile("" ::: "memory");
            }
    }
};
template <int MODE> __device__ __forceinline__ void ina_store(u16* base, const f32x4 (&acc)[2][2][4][2], const float* lbp) {
#pragma unroll
    for (int bj = 0; bj < 2; ++bj) {
        f32x4 l0 = (f32x4){0.f, 0.f, 0.f, 0.f}, l1 = l0;
        (void)lbp; (void)l0; (void)l1;
#pragma unroll
        for (int ai = 0; ai < 2; ++ai)
#pragma unroll
            for (int m = 0; m < 4; ++m) {
                u16* d = base + (size_t)(ai * 128 + m * 16) * DM + bj * 128;
                if (MODE == 1) *(u32x4*)d = pack8h(acc[ai][bj][m][0], acc[ai][bj][m][1]);
                else *(u32x4*)d = pack8v(acc[ai][bj][m][0], acc[ai][bj][m][1]);
            }
    }
}
struct EpiInA {
    static constexpr bool PERM = true; B16 qs, lf, v, gs; const float* lbv;
    __device__ __forceinline__ void operator()(const f32x4 (&acc)[2][2][4][2], const Unit& u, int wr, int wc, int fr, int fq) const {
        const int seg = u.pn >> 2, cs = (u.pn & 3) * 256 + wc * 32 + 8 * fq;
        const size_t ro = cs + (size_t)(wr * 64 + fr) * DM; const size_t po = (size_t)u.pm * 256 * DM; const bool pr = u.pm < 64;
        if (seg == 0) { u16* qp = qs.p; u16* qsm = qs.s; ina_store<0>((pr ? qp + po : qsm) + ro, acc, lbv); }
        else if (seg == 1) { u16* qp = lf.p; u16* qsm = lf.s; ina_store<1>((pr ? qp + po : qsm) + ro, acc, lbv + cs); }
        else if (seg == 2) { u16* qp = v.p; u16* qsm = v.s; ina_store<2>((pr ? qp + po : qsm) + ro, acc, lbv); }
        else { u16* qp = gs.p; u16* qsm = gs.s; ina_store<0>((pr ? qp + po : qsm) + ro, acc, lbv); }
    }
};
struct EpiNull { static constexpr bool PERM = true; float* sink;
    __device__ __forceinline__ void operator()(const f32x4 (&acc)[2][2][4][2], const Unit& u, int wr, int wc, int fr, int fq) const {
        float t = 0.f;
#pragma unroll
        for (int ai = 0; ai < 2; ++ai)
#pragma unroll
            for (int bj = 0; bj < 2; ++bj)
#pragma unroll
                for (int m = 0; m < 4; ++m)
#pragma unroll
                    for (int n = 0; n < 2; ++n) t += acc[ai][bj][m][n].x + acc[ai][bj][m][n].y + acc[ai][bj][m][n].z + acc[ai][bj][m][n].w;
        if (t == 12345.678f) sink[0] = t;
    }
};
struct EpiInBP {
    static constexpr bool PERM = true; u16* dst; int ldp;
    __device__ __forceinline__ void operator()(const f32x4 (&acc)[2][2][4][2], const Unit& u, int wr, int wc, int fr, int fq) const {
        const int seg = u.pn >> 2, cs = (u.pn & 3) * 256 + wc * 32 + 8 * fq;
        u16* base = dst + (size_t)u.pm * 256 * ldp + cs + (size_t)(wr * 64 + fr) * ldp;
        if (seg == 0) {
#pragma unroll
            for (int ai = 0; ai < 2; ++ai)
#pragma unroll
                for (int m = 0; m < 4; ++m)
#pragma unroll
                    for (int bj = 0; bj < 2; ++bj) *(u32x4*)(base + (size_t)(ai * 128 + m * 16) * ldp + bj * 128) = pack8v(acc[ai][bj][m][0], acc[ai][bj][m][1]);
        } else {
#pragma unroll
            for (int ai = 0; ai < 2; ++ai)
#pragma unroll
                for (int m = 0; m < 4; ++m)
#pragma unroll
                    for (int bj = 0; bj < 2; ++bj) *(u32x4*)(base + (size_t)(ai * 128 + m * 16) * ldp + bj * 128) = pack8v(gelu4(acc[ai][bj][m][0]), gelu4(acc[ai][bj][m][1]));
        }
    }
};
struct EpiInB {
    static constexpr bool PERM = true; B16 xr, yg;
    __device__ __forceinline__ void operator()(const f32x4 (&acc)[2][2][4][2], const Unit& u, int wr, int wc, int fr, int fq) const {
        const int seg = u.pn >> 2, cs = (u.pn & 3) * 256 + wc * 32 + 8 * fq;
        u16* base = (u.pm < 64 ? (seg == 0 ? +xr.p : +yg.p) + (size_t)u.pm * 256 * DM : (seg == 0 ? +xr.s : +yg.s)) + cs + (size_t)(wr * 64 + fr) * DM;
        if (seg == 0) {
#pragma unroll
            for (int ai = 0; ai < 2; ++ai)
#pragma unroll
                for (int m = 0; m < 4; ++m)
#pragma unroll
                    for (int bj = 0; bj < 2; ++bj) *(u32x4*)(base + (size_t)(ai * 128 + m * 16) * DM + bj * 128) = pack8v(acc[ai][bj][m][0], acc[ai][bj][m][1]);
        } else {
#pragma unroll
            for (int ai = 0; ai < 2; ++ai)
#pragma unroll
                for (int m = 0; m < 4; ++m)
#pragma unroll
                    for (int bj = 0; bj < 2; ++bj) *(u32x4*)(base + (size_t)(ai * 128 + m * 16) * DM + bj * 128) = pack8v(acc[ai][bj][m][0], acc[ai][bj][m][1]);
        }
    }
};
__device__ __forceinline__ f32x4 nexpm1_4(f32x4 x) { const f32x4 p = 1.f + x * (0.5f + x * (0.16666667f + x * (0.041666668f + x * (0.008333334f + x * 0.0013888889f)))); return -x * p; }
__device__ __forceinline__ f32x4 sqrt4(f32x4 v) { return (f32x4){sqrtf(fmaxf(v.x, 0.f)), sqrtf(fmaxf(v.y, 0.f)), sqrtf(fmaxf(v.z, 0.f)), sqrtf(fmaxf(v.w, 0.f))}; }
struct EpiBD {
    static constexpr bool PERM = true; B16 xc, bt; const float* ba; const float* bx; const float* lc;
    __device__ __forceinline__ void operator()(const f32x4 (&acc)[2][2][4][2], const Unit& u, int wr, int wc, int fr, int fq) const {
        const int ch = u.pn * 128 + wc * 32 + 8 * fq;
        u16* xb = (u.pm < 64 ? xc.p + (size_t)u.pm * 256 * DM : xc.s) + ch + (size_t)(wr * 64 + fr) * DM; u16* bb = (u.pm < 64 ? bt.p + (size_t)u.pm * 256 * DM : bt.s) + ch + (size_t)(wr * 64 + fr) * DM;
#pragma unroll
        for (int n = 0; n < 2; ++n) {
            const f32x4 cba = *(const f32x4*)(ba + ch + 4 * n), cbx = *(const f32x4*)(bx + ch + 4 * n), cl = *(const f32x4*)(lc + ch + 4 * n);
#pragma unroll
            for (int ai = 0; ai < 2; ++ai)
#pragma unroll
                for (int m = 0; m < 4; ++m) {
                    const size_t off = (size_t)(ai * 128 + m * 16) * DM + 4 * n;
                    const u32x2 xw = *(const u32x2*)(xb + off); const f32x4 xv = (f32x4){blo(xw.x), bhi(xw.x), blo(xw.y), bhi(xw.y)};
                    const f32x4 r = sig4(acc[ai][0][m][n] + cba), ig = sig4(acc[ai][1][m][n] + cbx);
                    const f32x4 la = r * cl; const f32x4 bo = sqrt4(nexpm1_4(2.f * la)) * ig * xv;
                    u32x2 o1, o2; o1.x = pk(la.x, la.y); o1.y = pk(la.z, la.w); o2.x = pk(bo.x, bo.y); o2.y = pk(bo.z, bo.w);
                    *(u32x2*)(xb + off) = o1; *(u32x2*)(bb + off) = o2;
                    if (m & 1) asm volatile("" ::: "memory");
                }
        }
    }
};
struct EpiMerge {
    static constexpr bool PERM = true; B16 gt, ta, mb;
    __device__ __forceinline__ void operator()(const f32x4 (&acc)[2][2][4][2], const Unit& u, int wr, int wc, int fr, int fq) const {
        const size_t ro = ((u.pm < 64) ? (size_t)u.pm * 256 * DM : 0) + u.pn * 256 + wc * 32 + 8 * fq + (size_t)(wr * 64 + fr) * DM;
        u16* g = (u.pm < 64 ? +gt.p : +gt.s) + ro; u16* t = (u.pm < 64 ? +ta.p : +ta.s) + ro; u16* mo = (u.pm < 64 ? +mb.p : +mb.s) + ro;
        const int sub = u.sub;
        if (sub == 0 || sub == 2) {
#pragma unroll
            for (int ai = 0; ai < 2; ++ai)
#pragma unroll
                for (int m = 0; m < 4; ++m)
#pragma unroll
                    for (int bj = 0; bj < 2; ++bj) *(u32x4*)(g + (size_t)(ai * 128 + m * 16) * DM + bj * 128) = pack8v(sig4(acc[ai][bj][m][0]), sig4(acc[ai][bj][m][1]));
        } else if (sub == 1) {
#pragma unroll
            for (int ai = 0; ai < 2; ++ai)
#pragma unroll
                for (int m = 0; m < 4; ++m)
#pragma unroll
                    for (int bj = 0; bj < 2; ++bj) { const size_t off = (size_t)(ai * 128 + m * 16) * DM + bj * 128; const F8 gv = unpack8v(*(const u32x4*)(g + off));
                        *(u32x4*)(t + off) = pack8v(gv.a * acc[ai][bj][m][0], gv.b * acc[ai][bj][m][1]); if (bj) asm volatile("" ::: "memory"); }
        } else {
#pragma unroll
            for (int ai = 0; ai < 2; ++ai)
#pragma unroll
                for (int m = 0; m < 4; ++m)
#pragma unroll
                    for (int bj = 0; bj < 2; ++bj) { const size_t off = (size_t)(ai * 128 + m * 16) * DM + bj * 128; const F8 gv = unpack8v(*(const u32x4*)(g + off)), tv = unpack8v(*(const u32x4*)(t + off));
                        *(u32x4*)(mo + off) = pack8v(tv.a + gv.a * acc[ai][bj][m][0], tv.b + gv.b * acc[ai][bj][m][1]); if (bj) asm volatile("" ::: "memory"); }
        }
    }
};

__device__ __forceinline__ void tconv_tile(const float* src, int N, int K, int kt, int nt, u16* dst, int mode, float* tile) {
    const int tid = TIDX;
    const int c4 = (tid & 15) * 4;
#pragma unroll
    for (int p = 0; p < 2; ++p) { const int r = (tid >> 4) + 32 * p; const f32x4 v = *(const f32x4*)(src + (size_t)(kt * 64 + r) * N + nt * 64 + c4);
        tile[r * 65 + c4] = v.x; tile[r * 65 + c4 + 1] = v.y; tile[r * 65 + c4 + 2] = v.z; tile[r * 65 + c4 + 3] = v.w; }
    __syncthreads();
    const int n = tid >> 3, k8 = (tid & 7) * 8; float f[8];
#pragma unroll
    for (int j = 0; j < 8; ++j) f[j] = tile[(k8 + j) * 65 + n];
    const int ng = nt * 64 + n; const int drow = mode == 0 ? ng : ((ng >> 7) * 256 + (mode == 2 ? 128 : 0) + (ng & 127));
    *(u32x4*)(dst + (size_t)drow * K + kt * 64 + k8) = pack8(f);
    __syncthreads();
}
__device__ __forceinline__ void conv_matrix(const float* src, int K, int N, u16* dst, int mode, int t, float* tile) {
    const int ntn = N / 64; tconv_tile(src, N, K, t / ntn, t % ntn, dst, mode, tile);
}
template <bool S16>
__device__ __forceinline__ void norm_rows(const void* sp, const void* ss, const float* gain, B16 dst) {
    const int lane = TIDX & 63, gw = blockIdx.x * 8 + (TIDX >> 6), nw = gridDim.x * 8;
    f32x4 g[4];
#pragma unroll
    for (int i = 0; i < 4; ++i) g[i] = *(const f32x4*)(gain + i * 256 + lane * 4);
    for (int row = gw; row < NTOK; row += nw) {
        f32x4 v[4]; float s = 0.f;
        if (S16) { const u16* src = row < TP ? (const u16*)sp + (size_t)row * DM : (const u16*)ss + (size_t)(row - TP) * DM;
#pragma unroll
            for (int i = 0; i < 4; ++i) v[i] = up4(*(const u32x2*)(src + i * 256 + lane * 4)); }
        else { const float* src = row < TP ? (const float*)sp + (size_t)row * DM : (const float*)ss + (size_t)(row - TP) * DM;
#pragma unroll
            for (int i = 0; i < 4; ++i) v[i] = *(const f32x4*)(src + i * 256 + lane * 4); }
#pragma unroll
        for (int i = 0; i < 4; ++i) s += v[i].x * v[i].x + v[i].y * v[i].y + v[i].z * v[i].z + v[i].w * v[i].w;
        s = wave_sum(s); const float rs = rsqrtf(s * (1.f / DM) + EPSV);
        u16* d = (row < TP ? dst.p + (size_t)row * DM : dst.s + (size_t)(row - TP) * DM);
#pragma unroll
        for (int i = 0; i < 4; ++i) { u32x2 w; w.x = pk(v[i].x * rs * g[i].x, v[i].y * rs * g[i].y); w.y = pk(v[i].z * rs * g[i].z, v[i].w * rs * g[i].w); *(u32x2*)(d + i * 256 + lane * 4) = w; }
    }
}
__device__ __forceinline__ void final_norm(const u16* x, const float* gain, float* yp, float* ys) {
    const int lane = TIDX & 63, gw = blockIdx.x * 8 + (TIDX >> 6), nw = gridDim.x * 8;
    f32x4 g[4];
#pragma unroll
    for (int i = 0; i < 4; ++i) g[i] = *(const f32x4*)(gain + i * 256 + lane * 4);
    for (int row = gw; row < NTOK; row += nw) {
        const u16* src = x + (size_t)row * DM;
        f32x4 v[4]; float s = 0.f;
#pragma unroll
        for (int i = 0; i < 4; ++i) { v[i] = up4(*(const u32x2*)(src + i * 256 + lane * 4)); s += v[i].x * v[i].x + v[i].y * v[i].y + v[i].z * v[i].z + v[i].w * v[i].w; }
        s = wave_sum(s); const float rs = rsqrtf(s * (1.f / DM) + EPSV);
        float* d = row < TP ? yp + (size_t)row * DM : ys + (size_t)(row - TP) * DM;
#pragma unroll
        for (int i = 0; i < 4; ++i) *(f32x4*)(d + i * 256 + lane * 4) = v[i] * rs * g[i];
    }
}

constexpr int L_BL = 0, L_TOT = 32768, L_RED = 34816, L_QE = 35328, L_KE = 52736, L_VT = 70144, L_AM = 88576, L_ST = 97792;
constexpr int QS_ = 136, VS_ = 72;

__device__ __forceinline__ void load_lf_chunk(const u16* lfp, int row0, int h, float* bL, const float* lbv) {
    const int tid = TIDX, r = tid >> 3, seg = tid & 7;
    float lb[16];
#pragma unroll
    for (int i = 0; i < 4; ++i) { const f32x4 t = *(const f32x4*)(lbv + h * 128 + seg * 16 + 4 * i); lb[4 * i] = t.x; lb[4 * i + 1] = t.y; lb[4 * i + 2] = t.z; lb[4 * i + 3] = t.w; }
    const u16* p = lfp + (size_t)(row0 + r) * DM + h * 128 + seg * 16;
    const u32x4 w0 = *(const u32x4*)p, w1 = *(const u32x4*)(p + 8);
    float* d = bL + r * 128 + seg * 16;
    const unsigned ws[8] = {w0.x, w0.y, w0.z, w0.w, w1.x, w1.y, w1.z, w1.w};
#pragma unroll
    for (int i = 0; i < 8; ++i) { const float p0 = h2f((u16)(ws[i] & 0xffffu)), p1 = h2f((u16)(ws[i] >> 16));
        d[2 * i] = __logf(lb[2 * i] + (1.f - lb[2 * i]) * sigm(p0)); d[2 * i + 1] = __logf(lb[2 * i + 1] + (1.f - lb[2 * i + 1]) * sigm(p1)); }
}
__device__ __forceinline__ void load_vT(const u16* vp, int row0, int h, u16* vT) {
    const int tid = TIDX, s = tid >> 3, seg = tid & 7;
    const u16* p = vp + (size_t)(row0 + s) * DM + h * 128 + seg * 16;
    const u32x4 w0 = *(const u32x4*)p, w1 = *(const u32x4*)(p + 8);
    const unsigned ws[8] = {w0.x, w0.y, w0.z, w0.w, w1.x, w1.y, w1.z, w1.w};
#pragma unroll
    for (int i = 0; i < 8; ++i) { vT[(seg * 16 + 2 * i) * VS_ + s] = (u16)(ws[i] & 0xffffu); vT[(seg * 16 + 2 * i + 1) * VS_ + s] = (u16)(ws[i] >> 16); }
}

__device__ __forceinline__ void hgrn_h1(const Params& P, unsigned char* sm) {
    float* bL = (float*)(sm + L_BL); float* tot = (float*)(sm + L_TOT); u16* kdT = (u16*)(sm + L_QE); u16* vT = (u16*)(sm + L_VT);
    const u16* lfp = (const u16*)(P.ws + WS_R1); const u16* vp = (const u16*)(P.ws + WS_R2);
    u16* Sb = (u16*)(P.out + O_HS); float* BLg = (float*)(P.ws + WS_BL);
    const int tid = TIDX, lane = tid & 63, w = tid >> 6, fr = lane & 15, fq = lane >> 4;
    for (int item = blockIdx.x; item < 2048; item += gridDim.x) {
        const int h = item & 7, c = (item >> 3) & 31, b = item >> 8; const int row0 = b * SEQ + c * 64;
        const int sidx = (b * 8 + h) * 32 + c;
        load_lf_chunk(lfp, row0, h, bL, (const float*)(P.ws + WS_LB)); load_vT(vp, row0, h, vT);
        __syncthreads();
        const int col = tid & 127, part = tid >> 7; float lf[16]; float run = 0.f;
#pragma unroll
        for (int i = 0; i < 16; ++i) { lf[i] = bL[(part * 16 + i) * 128 + col]; run += lf[i]; }
        tot[part * 128 + col] = run;
        __syncthreads();
        float off = 0.f, bl = 0.f;
#pragma unroll
        for (int p = 0; p < 4; ++p) { const float t = tot[p * 128 + col]; bl += t; if (p < part) off += t; }
        if (part == 0) BLg[(size_t)sidx * 128 + col] = bl;
        float bc = off;
#pragma unroll
        for (int i = 0; i < 16; ++i) { bc += lf[i]; const float kd = (1.f - __expf(lf[i])) * __expf(bl - bc); kdT[col * VS_ + part * 16 + i] = f2b(kd); }
        __syncthreads();
        bf16x8 av[2];
#pragma unroll
        for (int ks = 0; ks < 2; ++ks) av[ks] = *(const bf16x8*)(vT + (16 * w + fr) * VS_ + ks * 32 + 8 * fq);
        u16* so = Sb + (size_t)sidx * 16384 + (16 * w + fr) * 128 + 4 * fq;
#pragma unroll
        for (int nt = 0; nt < 8; ++nt) {
            f32x4 acc = (f32x4){0.f, 0.f, 0.f, 0.f};
#pragma unroll
            for (int ks = 0; ks < 2; ++ks) { const bf16x8 bk = *(const bf16x8*)(kdT + (16 * nt + fr) * VS_ + ks * 32 + 8 * fq); acc = __builtin_amdgcn_mfma_f32_16x16x32_bf16(bk, av[ks], acc, 0, 0, 0); }
            u32x2 o; o.x = pk(acc.x, acc.y); o.y = pk(acc.z, acc.w); *(u32x2*)(so + 16 * nt) = o;
        }
        __syncthreads();
    }
}
__device__ __forceinline__ void hgrn_h2(const Params& P) {
    u16* Sb = (u16*)(P.out + O_HS); const float* BLg = (const float*)(P.ws + WS_BL); float* hp = P.out + O_HP;
    for (int g = blockIdx.x * 512 + TIDX; g < 64 * 2048; g += gridDim.x * 512) {
        const int bh = g >> 11, e = (g & 2047) * 8, dv = e >> 7, dk = e & 127;
        float S[8];
#pragma unroll
        for (int j = 0; j < 8; ++j) S[j] = 0.f;
        u16* sp = Sb + (size_t)bh * 32 * 16384 + e; const float* blp = BLg + (size_t)bh * 32 * 128 + dk;
#pragma unroll 4
        for (int c = 0; c < 32; ++c) {
            const u32x4 lw = *(const u32x4*)(sp + (size_t)c * 16384); const f32x4 d0 = *(const f32x4*)(blp + c * 128), d1 = *(const f32x4*)(blp + c * 128 + 4);
            float sl[8]; unpack8(lw, sl);
            *(u32x4*)(sp + (size_t)c * 16384) = pack8(S);
            const float dd[8] = {d0.x, d0.y, d0.z, d0.w, d1.x, d1.y, d1.z, d1.w};
#pragma unroll
            for (int j = 0; j < 8; ++j) S[j] = __expf(dd[j]) * S[j] + sl[j];
        }
        float* o = hp + (size_t)bh * 16384 + dv;
#pragma unroll
        for (int j = 0; j < 8; ++j) o[(size_t)(dk + j) * 128] = S[j];
    }
}
__device__ __forceinline__ void hgrn_h3(const Params& P, unsigned char* sm, u16* dstp) {
    float* bL = (float*)(sm + L_BL); float* tot = (float*)(sm + L_TOT); float* red = (float*)(sm + L_RED);
    u16* qe = (u16*)(sm + L_QE); u16* ke = (u16*)(sm + L_KE); u16* vT = (u16*)(sm + L_VT); u16* Am = (u16*)(sm + L_AM); u16* ST = (u16*)(sm + L_ST);
    const u16* qsp = (const u16*)(P.ws + WS_R0); const u16* lfp = (const u16*)(P.ws + WS_R1); const u16* vp = (const u16*)(P.ws + WS_R2);
    u16* gsp = (u16*)(P.out + O_YP);
    const u16* Sb = (const u16*)(P.out + O_HS); const float* onorm = P.in[12];
    const int tid = TIDX, lane = tid & 63, w = tid >> 6, fr = lane & 15, fq = lane >> 4;
    for (int item = blockIdx.x; item < 2048; item += gridDim.x) {
        const int h = item & 7, c = (item >> 3) & 31, b = item >> 8; const int row0 = b * SEQ + c * 64;
        const int sidx = (b * 8 + h) * 32 + c;
        load_lf_chunk(lfp, row0, h, bL, (const float*)(P.ws + WS_LB)); load_vT(vp, row0, h, vT);
        { const u16* sp = Sb + (size_t)sidx * 16384;
#pragma unroll
          for (int p = 0; p < 4; ++p) { const int idx = tid + 512 * p, dv = idx >> 4, k8 = (idx & 15) * 8; *(u32x4*)(ST + dv * QS_ + k8) = *(const u32x4*)(sp + dv * 128 + k8); } }
        __syncthreads();
        const int col = tid & 127, part = tid >> 7; float lf[16]; float run = 0.f;
#pragma unroll
        for (int i = 0; i < 16; ++i) { lf[i] = bL[(part * 16 + i) * 128 + col]; run += lf[i]; }
        tot[part * 128 + col] = run;
        __syncthreads();
        float off = 0.f;
#pragma unroll
        for (int p = 0; p < 4; ++p) { const float t = tot[p * 128 + col]; if (p < part) off += t; }
        float bc = off; const u16* qp = qsp + (size_t)(row0 + part * 16) * DM + h * 128 + col;
#pragma unroll
        for (int i = 0; i < 16; ++i) { bc += lf[i]; const float q = silu(b2f(qp[(size_t)i * DM]));
            qe[(part * 16 + i) * QS_ + col] = f2b(q * __expf(bc)); ke[(part * 16 + i) * QS_ + col] = f2b((1.f - __expf(lf[i])) * __expf(-bc)); }
        __syncthreads();
        {
            const int mt = w & 3;
            bf16x8 aq[4];
#pragma unroll
            for (int ks = 0; ks < 4; ++ks) aq[ks] = *(const bf16x8*)(qe + (16 * mt + fr) * QS_ + ks * 32 + 8 * fq);
#pragma unroll
            for (int t = 0; t < 2; ++t) { const int nt = (w >> 2) * 2 + t; f32x4 acc = (f32x4){0.f, 0.f, 0.f, 0.f};
#pragma unroll
                for (int ks = 0; ks < 4; ++ks) { const bf16x8 bk = *(const bf16x8*)(ke + (16 * nt + fr) * QS_ + ks * 32 + 8 * fq); acc = __builtin_amdgcn_mfma_f32_16x16x32_bf16(bk, aq[ks], acc, 0, 0, 0); }
                const int cr = 16 * mt + fr, s0 = 16 * nt + 4 * fq;
                u32x2 o; o.x = pk(cr >= s0 ? acc.x : 0.f, cr >= s0 + 1 ? acc.y : 0.f); o.y = pk(cr >= s0 + 2 ? acc.z : 0.f, cr >= s0 + 3 ? acc.w : 0.f);
                *(u32x2*)(Am + cr * VS_ + s0) = o; }
        }
        __syncthreads();
        {
            const int mt = w & 3, nh = w >> 2;
            bf16x8 aq[4], aa[2];
#pragma unroll
            for (int ks = 0; ks < 4; ++ks) aq[ks] = *(const bf16x8*)(qe + (16 * mt + fr) * QS_ + ks * 32 + 8 * fq);
#pragma unroll
            for (int ks = 0; ks < 2; ++ks) aa[ks] = *(const bf16x8*)(Am + (16 * mt + fr) * VS_ + ks * 32 + 8 * fq);
            f32x4 acc[4]; float ssq = 0.f;
#pragma unroll
            for (int t = 0; t < 4; ++t) { const int dt = nh * 4 + t; acc[t] = (f32x4){0.f, 0.f, 0.f, 0.f};
#pragma unroll
                for (int ks = 0; ks < 4; ++ks) { const bf16x8 bk = *(const bf16x8*)(ST + (16 * dt + fr) * QS_ + ks * 32 + 8 * fq); acc[t] = __builtin_amdgcn_mfma_f32_16x16x32_bf16(bk, aq[ks], acc[t], 0, 0, 0); }
#pragma unroll
                for (int ks = 0; ks < 2; ++ks) { const bf16x8 bk = *(const bf16x8*)(vT + (16 * dt + fr) * VS_ + ks * 32 + 8 * fq); acc[t] = __builtin_amdgcn_mfma_f32_16x16x32_bf16(bk, aa[ks], acc[t], 0, 0, 0); }
                ssq += acc[t].x * acc[t].x + acc[t].y * acc[t].y + acc[t].z * acc[t].z + acc[t].w * acc[t].w; }
            ssq += __shfl_xor(ssq, 16, 64); ssq += __shfl_xor(ssq, 32, 64);
            if (fq == 0) red[(16 * mt + fr) * 2 + nh] = ssq;
            __syncthreads();
            const int cr = 16 * mt + fr; const float rinv = rsqrtf((red[cr * 2] + red[cr * 2 + 1]) * (1.f / 128.f) + EPSV);
            u16* gp = gsp + (size_t)(row0 + cr) * DM + h * 128;
#pragma unroll
            for (int t = 0; t < 4; ++t) { const int dv = 16 * (nh * 4 + t) + 4 * fq; const u32x2 gw = *(const u32x2*)(gp + dv); const f32x4 on = *(const f32x4*)(onorm + h * 128 + dv);
                u32x2 o; o.x = pk(acc[t].x * rinv * on.x * silu(blo(gw.x)), acc[t].y * rinv * on.y * silu(bhi(gw.x))); o.y = pk(acc[t].z * rinv * on.z * silu(blo(gw.y)), acc[t].w * rinv * on.w * silu(bhi(gw.y)));
                *(u32x2*)(dstp + (size_t)(row0 + cr) * DM + h * 128 + dv) = o; }
        }
        __syncthreads();
    }
}
__device__ __forceinline__ void hgrn_sample(const Params& P, unsigned char* sm, u16* gdst) {
    float* red = (float*)sm;
    float* sq = red + 16 * 128;
    float* sf = sq + 128; float* sk = sf + 128; float* sv = sk + 128; float* so = sv + 128; float* sr = so + 128;
    const u16* qss = (const u16*)(P.ws + WS_SIDE + 1 * SSLOT); const u16* lfs = (const u16*)(P.ws + WS_SIDE + 2 * SSLOT); const u16* vs = (const u16*)(P.ws + WS_SIDE + 3 * SSLOT);
    u16* gss = (u16*)(P.ws + WS_SIDE + 4 * SSLOT);
    const float* S0 = P.in[2]; float* Sn = P.out + O_HS; const float* onorm = P.in[12];
    const int tid = TIDX;
    for (int item = blockIdx.x; item < 1024; item += gridDim.x) {
        const int b = item >> 3, h = item & 7;
        if (tid < 128) { const int c = h * 128 + tid; const float lbc = ((const float*)(P.ws + WS_LB))[c]; const float f = lbc + (1.f - lbc) * sigm(h2f(lfs[(size_t)b * DM + c]));
            sq[tid] = silu(b2f(qss[(size_t)b * DM + c])); sf[tid] = f; sk[tid] = 1.f - f; sv[tid] = b2f(vs[(size_t)b * DM + c]); }
        __syncthreads();
        const int dv4 = (tid & 31) * 4, dkg = tid >> 5;
        const f32x4 vv = *(const f32x4*)(sv + dv4); f32x4 oacc = (f32x4){0.f, 0.f, 0.f, 0.f};
        const size_t base = ((size_t)(b * 8 + h)) * 16384;
#pragma unroll
        for (int i = 0; i < 8; ++i) { const int dk = dkg * 8 + i; const f32x4 s0 = *(const f32x4*)(S0 + base + dk * 128 + dv4);
            const f32x4 sn = sf[dk] * s0 + sk[dk] * vv; *(f32x4*)(Sn + base + dk * 128 + dv4) = sn; oacc += sq[dk] * sn; }
        *(f32x4*)(red + dkg * 128 + dv4) = oacc;
        __syncthreads();
        if (tid < 128) { float o = 0.f;
#pragma unroll
            for (int g = 0; g < 16; ++g) o += red[g * 128 + tid];
            so[tid] = o; const float s2 = wave_sum(o * o); if ((tid & 63) == 0) sr[tid >> 6] = s2; }
        __syncthreads();
        if (tid < 128) { const float rinv = rsqrtf((sr[0] + sr[1]) * (1.f / 128.f) + EPSV); const int c = h * 128 + tid;
            const float g = silu(b2f(gss[(size_t)b * DM + c])); gdst[(size_t)b * DM + c] = f2b(so[tid] * rinv * onorm[c] * g); }
        __syncthreads();
    }
}
__device__ __forceinline__ void conv_phase(const Params& P) {
    const u16* xrp = (const u16*)(P.ws + WS_R0); const u16* xrs = (const u16*)(P.ws + WS_SIDE + 5 * SSLOT);
    u16* xcp = (u16*)(P.ws + WS_R2); u16* xcs = (u16*)(P.ws + WS_SIDE + 7 * SSLOT);
    const float* cw = P.in[13]; const float* cb = P.in[14]; const float* sc = P.in[4];
    float* cpo = P.out + O_CP; float* cso = P.out + O_CS;
    const int tid = TIDX, ch = (tid & 127) * 8;
    float w0[8], w1[8], w2[8], w3[8], bb[8];
#pragma unroll
    for (int j = 0; j < 8; ++j) { w0[j] = cw[ch + j]; w1[j] = cw[1024 + ch + j]; w2[j] = cw[2048 + ch + j]; w3[j] = cw[3072 + ch + j]; bb[j] = cb[ch + j]; }
    for (int rg = blockIdx.x; rg < NTOK / 4; rg += gridDim.x) {
        const int row = rg * 4 + (tid >> 7);
        float x0[8], x1[8], x2[8], x3[8];
        if (row < TP) {
            const int t = row & (SEQ - 1); const u16* p = xrp + (size_t)row * DM + ch;
            unpack8(*(const u32x4*)p, x0);
            if (t >= 1) unpack8(*(const u32x4*)(p - DM), x1); else { for (int j = 0; j < 8; ++j) x1[j] = 0.f; }
            if (t >= 2) unpack8(*(const u32x4*)(p - 2 * DM), x2); else { for (int j = 0; j < 8; ++j) x2[j] = 0.f; }
            if (t >= 3) unpack8(*(const u32x4*)(p - 3 * DM), x3); else { for (int j = 0; j < 8; ++j) x3[j] = 0.f; }
            if (t >= SEQ - 3) { float* o = cpo + ((size_t)(row >> 11) * 3 + (t - (SEQ - 3))) * DM + ch; *(f32x4*)o = (f32x4){x0[0], x0[1], x0[2], x0[3]}; *(f32x4*)(o + 4) = (f32x4){x0[4], x0[5], x0[6], x0[7]}; }
        } else {
            const int b = row - TP; unpack8(*(const u32x4*)(xrs + (size_t)b * DM + ch), x0);
            const float* s = sc + (size_t)b * 3 * DM + ch;
#pragma unroll
            for (int j = 0; j < 8; ++j) { x3[j] = s[j]; x2[j] = s[DM + j]; x1[j] = s[2 * DM + j]; }
            float* o = cso + (size_t)b * 3 * DM + ch;
#pragma unroll
            for (int j = 0; j < 8; ++j) { o[j] = x2[j]; o[DM + j] = x1[j]; o[2 * DM + j] = x0[j]; }
        }
        float y[8];
#pragma unroll
        for (int j = 0; j < 8; ++j) y[j] = bb[j] + w3[j] * x0[j] + w2[j] * x1[j] + w1[j] * x2[j] + w0[j] * x3[j];
        u16* d = row < TP ? xcp + (size_t)row * DM + ch : xcs + (size_t)(row - TP) * DM + ch;
        *(u32x4*)d = pack8(y);
    }
}
__device__ __forceinline__ void lru_pass1(const Params& P) {
    const unsigned* la = (const unsigned*)(P.ws + WS_R2); const unsigned* bt = (const unsigned*)(P.ws + WS_R0); f32x4* agg = (f32x4*)(P.ws + WS_AGG);
    const int cp = TIDX;
    for (int item = blockIdx.x; item < 256; item += gridDim.x) {
        const size_t r0 = (size_t)item * 64;
        float P0 = 1.f, P1 = 1.f, H0 = 0.f, H1 = 0.f;
#pragma unroll 8
        for (int r = 0; r < 64; ++r) { const unsigned lw = la[(r0 + r) * 512 + cp], bw = bt[(r0 + r) * 512 + cp];
            const float a0 = __expf(blo(lw)), a1 = __expf(bhi(lw)); H0 = a0 * H0 + blo(bw); H1 = a1 * H1 + bhi(bw); P0 *= a0; P1 *= a1; }
        agg[(size_t)item * 512 + cp] = (f32x4){P0, H0, P1, H1};
    }
}
__device__ __forceinline__ void lru_pass2(const Params& P, unsigned* ydst, bool dummy) {
    const unsigned* la = (const unsigned*)(P.ws + WS_R2); const unsigned* bt = (const unsigned*)(P.ws + WS_R0); unsigned* yg = (unsigned*)(P.ws + WS_R1); const f32x4* agg = (const f32x4*)(P.ws + WS_AGG);
    float* lpo = P.out + O_LP;
    const int cp = TIDX;
    for (int item = blockIdx.x; item < 256; item += gridDim.x) {
        const int b = item >> 5, c = item & 31; const size_t r0 = (size_t)item * 64;
        float h0 = 0.f, h1 = 0.f;
        for (int cc = 0; cc < c; ++cc) { const f32x4 g = agg[(size_t)(b * 32 + cc) * 512 + cp]; h0 = g.x * h0 + g.y; h1 = g.z * h1 + g.w; }
#pragma unroll 8
        for (int r = 0; r < 64; ++r) { const size_t ix = (r0 + r) * 512 + cp; const unsigned lw = la[ix], bw = bt[ix], yw = yg[ix];
            h0 = __expf(blo(lw)) * h0 + blo(bw); h1 = __expf(bhi(lw)) * h1 + bhi(bw); ydst[ix] = pk(h0 * gelu_t(blo(yw)), h1 * gelu_t(bhi(yw))); }
        if (c == 31) { lpo[b * DM + 2 * cp] = h0; lpo[b * DM + 2 * cp + 1] = h1; }
    }
    if (dummy) return;
    const unsigned* las = (const unsigned*)(P.ws + WS_SIDE + 8 * SSLOT); const unsigned* bts = (const unsigned*)(P.ws + WS_SIDE + 5 * SSLOT); unsigned* ygs = (unsigned*)(P.ws + WS_SIDE + 6 * SSLOT);
    const float* hl = P.in[3]; float* lso = P.out + O_LS;
    for (int b = blockIdx.x; b < TS; b += gridDim.x) {
        const size_t ix = (size_t)b * 512 + cp; const unsigned lw = las[ix], bw = bts[ix], yw = ygs[ix];
        const float h0 = __expf(blo(lw)) * hl[b * DM + 2 * cp] + blo(bw), h1 = __expf(bhi(lw)) * hl[b * DM + 2 * cp + 1] + bhi(bw);
        ygs[ix] = pk(h0 * gelu_t(blo(yw)), h1 * gelu_t(bhi(yw))); lso[b * DM + 2 * cp] = h0; lso[b * DM + 2 * cp + 1] = h1;
    }
}


__device__ __forceinline__ f32x4 sk_acc(const u16* Ap, const u16* Bp, int K) {
    f32x4 acc = (f32x4){0.f, 0.f, 0.f, 0.f};
#pragma unroll
    for (int k0 = 0; k0 < 128; k0 += 32) { const bf16x8 a = *(const bf16x8*)(Ap + k0), b = *(const bf16x8*)(Bp + k0); acc = __builtin_amdgcn_mfma_f32_16x16x32_bf16(b, a, acc, 0, 0, 0); }
    return acc;
}
template <int KS, int RT, int CH>
__device__ __forceinline__ f32x4 sk_ks(const u16* A  , int lda, const u16* Brow, float* red, int w, int fr, int fq, int lane) {
    __builtin_amdgcn_sched_barrier(0);
    const int kb = w * KS * 32 + 8 * fq;
    f32x4 acc[RT];
#pragma unroll
    for (int mt = 0; mt < RT; ++mt) acc[mt] = (f32x4){0.f, 0.f, 0.f, 0.f};
    const u16* ap = A + (size_t)fr * lda + kb; const u16* bp = Brow + kb;
#pragma unroll
    for (int c0 = 0; c0 < KS; c0 += CH) {
        bf16x8 bfr[CH], afr[CH][RT];
#pragma unroll
        for (int s = 0; s < CH; ++s) if (c0 + s < KS) {
            bfr[s] = *(const bf16x8*)(bp + (c0 + s) * 32);
#pragma unroll
            for (int mt = 0; mt < RT; ++mt) afr[s][mt] = *(const bf16x8*)(ap + (size_t)(16 * mt) * lda + (c0 + s) * 32);
        }
#pragma unroll
        for (int s = 0; s < CH; ++s) if (c0 + s < KS) {
#pragma unroll
            for (int mt = 0; mt < RT; ++mt) acc[mt] = __builtin_amdgcn_mfma_f32_16x16x32_bf16(bfr[s], afr[s][mt], acc[mt], 0, 0, 0);
        }
        asm volatile("" ::: "memory");
    }
#pragma unroll
    for (int mt = 0; mt < RT; ++mt) *(f32x4*)(red + (size_t)((w * RT + mt) * 64 + lane) * 4) = acc[mt];
    __syncthreads();
    f32x4 r = (f32x4){0.f, 0.f, 0.f, 0.f};
    if (w < RT) {
#pragma unroll
        for (int ww = 0; ww < 8; ++ww) r += *(const f32x4*)(red + (size_t)((ww * RT + w) * 64 + lane) * 4);
    }
    __syncthreads();
    __builtin_amdgcn_sched_barrier(0);
    return r;
}
#define SK_SETUP const int tid = TIDX, lane = tid & 63, w = tid >> 6, fr = lane & 15, fq = lane >> 4;
#define SK_LOOP(ni) for (int it = (int)gridDim.x - 1 - (int)blockIdx.x; it < (ni); it += (int)gridDim.x)
__device__ __forceinline__ void sk_gu(const u16* hn_s, const u16* Wgu, u16* act_s, float* red) {
    SK_SETUP
    SK_LOOP(176) { const int f0 = it * 16, br = (f0 >> 7) * 256 + (f0 & 127), r = 16 * w + fr;
        const f32x4 g = sk_ks<4, 8, 4>(hn_s, DM, Wgu + (size_t)(br + fr) * DM, red, w, fr, fq, lane);
        const f32x4 u = sk_ks<4, 8, 4>(hn_s, DM, Wgu + (size_t)(br + 128 + fr) * DM, red, w, fr, fq, lane);
        *(u32x2*)(act_s + (size_t)r * DFF + f0 + 4 * fq) = pk4(silu4(g) * u); }
}
template <int KS, bool R16>
__device__ __forceinline__ void sk_res(const u16* a_s, const u16* Bt, const void* resid, u16* out, float scale, float* red) {
    SK_SETUP
    SK_LOOP(256) { const int n0 = (it >> 2) * 16, rg = it & 3, r = rg * 32 + 16 * w + fr;
        const f32x4 a = sk_ks<KS, 2, KS>(a_s + (size_t)(rg * 32) * (256 * KS), 256 * KS, Bt + (size_t)(n0 + fr) * (256 * KS), red, w, fr, fq, lane);
        if (w < 2) { const size_t off = (size_t)r * DM + n0 + 4 * fq;
            const f32x4 rv = R16 ? up4(*(const u32x2*)((const u16*)resid + off)) : *(const f32x4*)((const float*)resid + off);
            *(u32x2*)(out + off) = pk4(rv + scale * a); } }
}
__device__ __forceinline__ void sk_ina(const u16* hn_s, const u16* Win, u16* qs, u16* lf, u16* vv, u16* gs, const float* lbv, float* red) {
    SK_SETUP
    SK_LOOP(256) { const int n0 = it * 16, seg = n0 >> 10, c = (n0 & 1023) + 4 * fq, r = 16 * w + fr;
        const f32x4 a = sk_ks<4, 8, 4>(hn_s, DM, Win + (size_t)(n0 + fr) * DM, red, w, fr, fq, lane);
        if (seg == 0) *(u32x2*)(qs + (size_t)r * DM + c) = pk4(a);
        else if (seg == 1) { u32x2 o; o.x = pkh(a.x, a.y); o.y = pkh(a.z, a.w); *(u32x2*)(lf + (size_t)r * DM + c) = o; }
        else if (seg == 2) *(u32x2*)(vv + (size_t)r * DM + c) = pk4(a);
        else *(u32x2*)(gs + (size_t)r * DM + c) = pk4(a); }
}
__device__ __forceinline__ void sk_inb(const u16* hn_s, const u16* Win, u16* xr, u16* yg, float* red) {
    SK_SETUP
    SK_LOOP(256) { const int n0 = (it >> 1) * 16, rg = it & 1, seg = n0 >> 10, c = (n0 & 1023) + 4 * fq, r = rg * 64 + 16 * w + fr;
        const f32x4 a = sk_ks<4, 4, 4>(hn_s + (size_t)(rg * 64) * DM, DM, Win + (size_t)(4096 + n0 + fr) * DM, red, w, fr, fq, lane);
        if (w < 4) { if (seg == 0) *(u32x2*)(xr + (size_t)r * DM + c) = pk4(a); else *(u32x2*)(yg + (size_t)r * DM + c) = pk4(a); } }
}
__device__ __forceinline__ void sk_bd(const u16* xc_s, const u16* Wbd, const float* ba, const float* bx, const float* lc, u16* la_s, u16* bt_s) {
    SK_SETUP
    SK_LOOP(64) { const int ch0 = it * 16, n = ch0 >> 7, d0 = ch0 & 127, c = ch0 + 4 * fq, r = 16 * w + fr;
        const u16* ap = xc_s + (size_t)r * DM + n * 128 + 8 * fq;
        const f32x4 pa = sk_acc(ap, Wbd + ((size_t)(n * 256 + d0 + fr) * 256 + (n & 1) * 128) + 8 * fq, 128);
        const f32x4 px = sk_acc(ap, Wbd + ((size_t)(n * 256 + 128 + d0 + fr) * 256 + (n & 1) * 128) + 8 * fq, 128);
        const f32x4 rr = sig4(pa + *(const f32x4*)(ba + c)), ig = sig4(px + *(const f32x4*)(bx + c)); const f32x4 la = rr * *(const f32x4*)(lc + c);
        const f32x4 xv = up4(*(const u32x2*)(xc_s + (size_t)r * DM + c));
        *(u32x2*)(la_s + (size_t)r * DM + c) = pk4(la); *(u32x2*)(bt_s + (size_t)r * DM + c) = pk4(sqrt4(nexpm1_4(2.f * la)) * ig * xv); }
}
__device__ __forceinline__ void sk_merge(const u16* hn_s, const u16* oa_s, const u16* ob_s, const u16* Win, const u16* Waup, const u16* Wbup, u16* mb_s, float* red) {
    SK_SETUP
    SK_LOOP(256) { const int n0 = (it >> 2) * 16, rg = it & 3, r = rg * 32 + 16 * w + fr; const size_t bo = (size_t)(n0 + fr) * DM, ao = (size_t)(rg * 32) * DM;
        const f32x4 g1 = sk_ks<4, 2, 4>(hn_s + ao, DM, Win + (size_t)6144 * DM + bo, red, w, fr, fq, lane), a = sk_ks<4, 2, 4>(oa_s + ao, DM, Waup + bo, red, w, fr, fq, lane);
        const f32x4 g2 = sk_ks<4, 2, 4>(hn_s + ao, DM, Win + (size_t)7168 * DM + bo, red, w, fr, fq, lane), b = sk_ks<4, 2, 4>(ob_s + ao, DM, Wbup + bo, red, w, fr, fq, lane);
        if (w < 2) *(u32x2*)(mb_s + (size_t)r * DM + n0 + 4 * fq) = pk4(sig4(g1) * a + sig4(g2) * b); }
}

#define XB_TMO      128
#define XB_XCNT(j)  (256  + 64 * (j))
#define XB_XSUB(j)  (1280 + 64 * (j))
#define XB_XGEN(j)  (2304 + 64 * (j))
#define XB_TOP      3328
#define XB_TOPGEN   3392
#define XCD_BAR_WORDS 3456
#define XB_SPIN_CAP (1u << 18)
__device__ __forceinline__ unsigned xb_ld(unsigned* p)              { return __hip_atomic_load(p, __ATOMIC_RELAXED, __HIP_MEMORY_SCOPE_AGENT); }
__device__ __forceinline__ unsigned xb_add(unsigned* p, unsigned v) { return __hip_atomic_fetch_add(p, v, __ATOMIC_RELAXED, __HIP_MEMORY_SCOPE_AGENT); }
__device__ __forceinline__ unsigned xb_xcc_id() { return (unsigned)__builtin_amdgcn_s_getreg((3 << 11) | 20) & 0xFu; }
#define XB_SPIN(cond, bar) do { unsigned _sp = 0; while (cond) { __builtin_amdgcn_s_sleep(1); \
    if ((++_sp & 255u) == 0u) { if (xb_ld(&(bar)[XB_TMO])) break; if (_sp > XB_SPIN_CAP) { atomicAdd(&(bar)[XB_TMO], 1u); break; } } } } while (0)
struct XcdBarrier { unsigned* bar; unsigned x; volatile LAS unsigned* st; };
__device__ __forceinline__ XcdBarrier xcd_barrier_post(unsigned* bar, volatile LAS unsigned* st) {
    XcdBarrier b; b.bar = bar; b.x = xb_xcc_id(); b.st = st;
    if (threadIdx.x == 0) (void)xb_add(&bar[XB_XCNT(b.x)], 1u);
    return b;
}
__device__ __forceinline__ void xcd_barrier_complete(unsigned* bar, unsigned x, unsigned& nloc, unsigned& nx) {
    const unsigned G = gridDim.x * gridDim.y * gridDim.z;
    unsigned sum, cnt, mine, sp = 0u;
    for (;;) {
        sum = 0u; cnt = 0u; mine = 0u;
#pragma unroll
        for (unsigned j = 0; j < 16; ++j) { const unsigned c = xb_ld(&bar[XB_XCNT(j)]); sum += c; cnt += (c > 0u) ? 1u : 0u; mine = (j == x) ? c : mine; }
        if (sum == G) break;
        __builtin_amdgcn_s_sleep(1);
        if ((++sp & 255u) == 0u) { if (xb_ld(&bar[XB_TMO])) break; if (sp > XB_SPIN_CAP) { atomicAdd(&bar[XB_TMO], 1u); break; } }
    }
    nloc = mine > 0u ? mine : 1u; nx = cnt > 0u ? cnt : 1u;
}
__device__ __forceinline__ void xcd_barrier(const XcdBarrier& b) {
    asm volatile("s_waitcnt vmcnt(0)" ::: "memory");
    __syncthreads();
    if (threadIdx.x == 0) {
        unsigned* bar = b.bar;
        __builtin_amdgcn_s_waitcnt(0);
        unsigned nloc = b.st[0], nx = b.st[1];
        if (nloc == 0u) { xcd_barrier_complete(bar, b.x, nloc, nx); b.st[0] = nloc; b.st[1] = nx; }
        const unsigned old = xb_add(&bar[XB_XSUB(b.x)], 1u);
        const unsigned gen = old / nloc;
        if (old + 1u == (gen + 1u) * nloc) {
            __builtin_amdgcn_fence(__ATOMIC_RELEASE, "agent");
            asm volatile("s_waitcnt vmcnt(0)" ::: "memory");
            const unsigned og = xb_add(&bar[XB_TOP], 1u);
            const unsigned tg = og / nx;
            if (og + 1u == (tg + 1u) * nx) xb_add(&bar[XB_TOPGEN], 1u);
            else XB_SPIN(xb_ld(&bar[XB_TOPGEN]) == tg, bar);
            __builtin_amdgcn_fence(__ATOMIC_ACQUIRE, "agent");
            xb_add(&bar[XB_XGEN(b.x)], 1u);
            asm volatile("s_waitcnt vmcnt(0)" ::: "memory");
        } else {
            XB_SPIN(xb_ld(&bar[XB_XGEN(b.x)]) == gen, bar);
            __builtin_amdgcn_fence(__ATOMIC_ACQUIRE, "agent");
            asm volatile("s_waitcnt vmcnt(0)" ::: "memory");
        }
    }
    __syncthreads();
}

#define GSYNC() xcd_barrier(xbar)
#define GSYNC_CG() do { asm volatile("s_waitcnt vmcnt(0) lgkmcnt(0)" ::: "memory"); grid.sync(); } while (0)
#ifndef PROBE
#define PROBE 0
#endif
#ifndef STOP_AT
#define STOP_AT 99
#endif
__device__ __forceinline__ void dumpcp(const unsigned char* src, unsigned char* dst, size_t bytes) {
    for (size_t i = ((size_t)blockIdx.x * 512 + threadIdx.x) * 16; i < bytes; i += (size_t)gridDim.x * 512 * 16) *(u32x4*)(dst + i) = *(const u32x4*)(src + i);
}
#define STOPCHK(n) do { if (STOP_AT == (n)) { if ((n) == 4) { dumpcp(P.ws + WS_R0, (unsigned char*)(P.out + O_HS), 2 * SLOT); dumpcp(P.ws + WS_R2, (unsigned char*)P.out + SLOT, SLOT); }  if ((n) == 2 || (n) == 14) { DEF_PTRS final_norm(X1, P.in[27], P.out + O_YP, P.out + O_YS); } return; } } while (0)
#define DEF_PTRS \
    unsigned char* ws = opq(P.ws); unsigned char* ob = opq((unsigned char*)P.out); (void)ob; \
    u16* Wgu = (u16*)(ws + WS_WGU); u16* Wd = (u16*)(ws + WS_WD); u16* Win = (u16*)(ws + WS_WIN); u16* Wbd = (u16*)(ws + WS_WBD); \
    u16* Waup = (u16*)(ws + WS_WAUP); u16* Wbup = (u16*)(ws + WS_WBUP); u16* Wout = (u16*)(ws + WS_WOUT); \
    u16* X1 = (u16*)(ws + WS_X1); float* LBv = (float*)(ws + WS_LB); float* LCv = (float*)(ws + WS_LC); \
    const B16 HN = {(u16*)(ws + WS_HN), (u16*)(ws + WS_SIDE + 0 * SSLOT)}; \
    const B16 QS = {(u16*)(ws + WS_R0), (u16*)(ws + WS_SIDE + 1 * SSLOT)}; \
    const B16 LF = {(u16*)(ws + WS_R1), (u16*)(ws + WS_SIDE + 2 * SSLOT)}; \
    const B16 VV = {(u16*)(ws + WS_R2), (u16*)(ws + WS_SIDE + 3 * SSLOT)}; \
    const B16 GS = {(u16*)(ob + O_YP * 4), (u16*)(ws + WS_SIDE + 4 * SSLOT)}; \
    const B16 XR = {(u16*)(ws + WS_R0), (u16*)(ws + WS_SIDE + 5 * SSLOT)}; \
    const B16 YG = {(u16*)(ws + WS_R1), (u16*)(ws + WS_SIDE + 6 * SSLOT)}; \
    const B16 XC = {(u16*)(ws + WS_R2), (u16*)(ws + WS_SIDE + 7 * SSLOT)}; \
    const B16 TA = {(u16*)(ws + WS_R0), (u16*)(ws + WS_SIDE + 8 * SSLOT)}; \
    const B16 GT = {(u16*)(ws + WS_R2), (u16*)(ws + WS_SIDE + 9 * SSLOT)}; \
    const B16 MB = {(u16*)(ob + O_YP * 4) + (size_t)TP * DM, (u16*)(ws + WS_SIDE + 10 * SSLOT)}; \
    const B16 ACT = {(u16*)(ws + WS_R0), (u16*)(ws + WS_ACTS)}; \
    (void)Wgu; (void)Wd; (void)Win; (void)Wbd; (void)Waup; (void)Wbup; (void)Wout; (void)X1; (void)LBv; (void)LCv; \
    (void)HN; (void)QS; (void)LF; (void)VV; (void)GS; (void)XR; (void)YG; (void)XC; (void)TA; (void)GT; (void)MB; (void)ACT;

__global__ void __launch_bounds__(512, 2) mega(const float* i0, const float* i1, const float* i2, const float* i3, const float* i4, const float* i5, const float* i6, const float* i7, const float* i8, const float* i9, const float* i10, const float* i11, const float* i12, const float* i13, const float* i14, const float* i15, const float* i16, const float* i17, const float* i18, const float* i19, const float* i20, const float* i21, const float* i22, const float* i23, const float* i24, const float* i25, const float* i26, const float* i27, float* outp, unsigned char* wsp) {
    Params P;
    P.in[0] = i0; P.in[1] = i1; P.in[2] = i2; P.in[3] = i3; P.in[4] = i4; P.in[5] = i5; P.in[6] = i6; P.in[7] = i7; P.in[8] = i8; P.in[9] = i9; P.in[10] = i10; P.in[11] = i11; P.in[12] = i12; P.in[13] = i13; P.in[14] = i14; P.in[15] = i15; P.in[16] = i16; P.in[17] = i17; P.in[18] = i18; P.in[19] = i19; P.in[20] = i20; P.in[21] = i21; P.in[22] = i22; P.in[23] = i23; P.in[24] = i24; P.in[25] = i25; P.in[26] = i26; P.in[27] = i27;
    P.out = outp; P.ws = wsp;
    extern __shared__ __attribute__((aligned(16))) unsigned char shm[];
    cg::grid_group grid = cg::this_grid();
    LAS unsigned char* lds = (LAS unsigned char*)shm;
    const int G = gridDim.x, cblk = blockIdx.x;
    volatile LAS unsigned* xst = (volatile LAS unsigned*)(lds + (LDS_BYTES - 16));
    if (threadIdx.x == 0) { xst[0] = 0u; xst[1] = 0u; xst[2] = 0u; xst[3] = 0u; }
    __syncthreads();
    const XcdBarrier xbar = xcd_barrier_post((unsigned*)(P.ws + WS_BAR), xst);

    {
        DEF_PTRS
        float* tile = (float*)shm;
        for (int rep = 0; rep < (PROBE == 7 ? 2 : 1); ++rep)
        for (int t = cblk; t < 4928; t += G) {
            if (t < 704) conv_matrix(P.in[6], 1024, 2816, Wgu, 1, t, tile);
            else if (t < 1408) conv_matrix(P.in[7], 1024, 2816, Wgu, 2, t - 704, tile);
            else if (t < 2112) conv_matrix(P.in[8], 2816, 1024, Wd, 0, t - 1408, tile);
            else if (t < 4160) conv_matrix(P.in[10], 1024, 8192, Win, 0, t - 2112, tile);
            else if (t < 4416) conv_matrix(P.in[20], 1024, 1024, Waup, 0, t - 4160, tile);
            else if (t < 4672) conv_matrix(P.in[21], 1024, 1024, Wbup, 0, t - 4416, tile);
            else conv_matrix(P.in[22], 1024, 1024, Wout, 0, t - 4672, tile);
        }
        for (int idx = cblk * 512 + TIDX; idx < 8 * 256 * 256; idx += G * 512) {
            const int n = idx >> 16, row = (idx >> 8) & 255, kk = idx & 255, bj = row >> 7, d = row & 127;
            float v = 0.f; if ((kk >> 7) == (n & 1)) v = (bj ? P.in[17] : P.in[15])[(size_t)n * 16384 + (kk & 127) * 128 + d];
            Wbd[idx] = f2b(v);
        }
        if (PROBE == 12 || PROBE == 13) { unsigned char* dst = (PROBE == 12) ? (ws + WS_R2) : ((unsigned char*)P.out + SLOT);
            for (int rep = 0; rep < 4; ++rep) for (size_t i = ((size_t)cblk * 512 + TIDX) * 16; i < SLOT; i += (size_t)G * 512 * 16) *(u32x4*)(dst + i) = (u32x4){(unsigned)rep, 0u, 0u, 0u}; }
        if (cblk == 0) { for (int c = TIDX; c < 1024; c += 512) { LBv[c] = 1.f / (1.f + __expf(P.in[11][1024 + c] - P.in[11][c])); LCv[c] = -8.f * log1pf(__expf(-P.in[19][c])); } }
        norm_rows<false>(P.in[0], P.in[1], P.in[5], HN);
    }
    GSYNC_CG(); STOPCHK(0);
    { DEF_PTRS SchedSimple S{HN.p, HN.s, Wgu, DM, DM, 22, G, cblk, 0}; EpiGU E{ACT}; gemm_phase(lds, DM, DM, S, E); if (PROBE == 1) gemm_phase(lds, DM, DM, S, E); sk_gu(HN.s, Wgu, ACT.s, (float*)shm); if (PROBE == 9) sk_gu(HN.s, Wgu, ACT.s, (float*)shm); }
    GSYNC(); STOPCHK(1);
    { DEF_PTRS SchedSimple S{ACT.p, ACT.s, Wd, DFF, DFF, 4, G, cblk, 0}; EpiResT<false> E{P.in[0], X1, 0.5f}; gemm_phase(lds, DFF, DFF, S, E); sk_res<11, false>(ACT.s, Wd, P.in[1], X1 + (size_t)TP * DM, 0.5f, (float*)shm); }
    GSYNC(); STOPCHK(2);
    {
        DEF_PTRS
        float* tile = (float*)shm;
        for (int t = cblk; t < 2112; t += G) {
            if (t < 704) conv_matrix(P.in[24], 1024, 2816, Wgu, 1, t, tile);
            else if (t < 1408) conv_matrix(P.in[25], 1024, 2816, Wgu, 2, t - 704, tile);
            else conv_matrix(P.in[26], 2816, 1024, Wd, 0, t - 1408, tile);
        }
        norm_rows<true>(X1, X1 + (size_t)TP * DM, P.in[9], HN);
    }
    GSYNC(); STOPCHK(3);
    { DEF_PTRS SchedSimple S{HN.p, HN.s, Win, DM, DM, 16, G, cblk, 0}; EpiInA E{QS, LF, VV, GS, LBv}; gemm_phase(lds, DM, DM, S, E); if (PROBE == 11) gemm_phase(lds, DM, DM, S, E); sk_ina(HN.s, Win, QS.s, LF.s, VV.s, GS.s, LBv, (float*)shm); if (PROBE == 9) sk_ina(HN.s, Win, QS.s, LF.s, VV.s, GS.s, LBv, (float*)shm); }
    GSYNC(); STOPCHK(4);
    hgrn_h1(P, shm); if (PROBE == 3) hgrn_h1(P, shm);
    GSYNC(); STOPCHK(5);
    hgrn_h2(P);
    if (PROBE == 21) { GSYNC(); GSYNC(); GSYNC(); GSYNC(); }
    if (PROBE == 8) { GSYNC(); hgrn_h1(P, shm); GSYNC(); hgrn_h2(P); }
    GSYNC(); STOPCHK(6);
    if (PROBE == 18) hgrn_h3(P, shm, (u16*)(P.out + O_YP) + (size_t)TP * DM);
    hgrn_h3(P, shm, (u16*)(P.out + O_YP));
    GSYNC(); STOPCHK(7);
    { DEF_PTRS SchedSimple S{HN.p, HN.s, Win + (size_t)4096 * DM, DM, DM, 8, G, cblk, 0}; EpiInB E{XR, YG}; gemm_phase(lds, DM, DM, S, E); if (PROBE == 14) gemm_phase(lds, DM, DM, S, E); if (PROBE == 27 || PROBE == 28 || PROBE == 29) { SchedLim SL{HN.p, HN.s, Win + (size_t)4096 * DM, DM, DM, 8, G, cblk, PROBE == 27 ? 1 : (PROBE == 28 ? 2 : 4)}; EpiNull EN{(float*)(ws + WS_AGG)}; gemm_phase(lds, DM, DM, SL, EN); }
        if (PROBE == 25 || PROBE == 26) { SchedLim SL{HN.p, HN.s, Win + (size_t)4096 * DM, DM, DM, 8, G, cblk, PROBE == 25 ? 1 : 2}; EpiInBP EP{(u16*)(P.out + O_HS), 1024}; gemm_phase(lds, DM, DM, SL, EP); } if (PROBE == 23) { EpiInBP EP{(u16*)(P.out + O_HS), 1088}; gemm_phase(lds, DM, DM, S, EP); } if (PROBE == 24) { EpiInBP EP{(u16*)(P.out + O_HS), 1024}; gemm_phase(lds, DM, DM, S, EP); } if (PROBE == 15) { EpiNull EN{(float*)(ws + WS_AGG)}; gemm_phase(lds, DM, DM, S, EN); } sk_inb(HN.s, Win, XR.s, YG.s, (float*)shm); if (PROBE == 9) sk_inb(HN.s, Win, XR.s, YG.s, (float*)shm); }
    GSYNC(); STOPCHK(8);
    conv_phase(P); if (PROBE == 4) conv_phase(P); if (PROBE == 20) hgrn_sample(P, shm, (u16*)(P.ws + WS_SIDE + 10 * SSLOT)); hgrn_sample(P, shm, (u16*)(P.ws + WS_SIDE + 4 * SSLOT));
    GSYNC(); STOPCHK(9);
    { DEF_PTRS SchedSimple S{XC.p, XC.s, Wbd, DM, 256, 8, G, cblk, 256}; EpiBD E{XC, XR, P.in[16], P.in[18], LCv}; gemm_phase(lds, 256, DM, S, E); sk_bd(XC.s, Wbd, P.in[16], P.in[18], LCv, TA.s, XR.s); }
    GSYNC(); STOPCHK(10);
    lru_pass1(P); if (PROBE == 5) lru_pass1(P);
    GSYNC(); STOPCHK(11);
    if (PROBE == 19) lru_pass2(P, (unsigned*)((u16*)(P.out + O_YP) + (size_t)TP * DM), true);
    lru_pass2(P, (unsigned*)(P.ws + WS_R1), false);
    GSYNC(); STOPCHK(12);
    { DEF_PTRS SchedMerge S{HN, GS, YG, Win, Waup, Wbup, G, cblk}; EpiMerge E{GT, TA, MB}; gemm_phase(lds, DM, DM, S, E); if (PROBE == 10) gemm_phase(lds, DM, DM, S, E); sk_merge(HN.s, GS.s, YG.s, Win, Waup, Wbup, MB.s, (float*)shm); if (PROBE == 9) sk_merge(HN.s, GS.s, YG.s, Win, Waup, Wbup, MB.s, (float*)shm); }
    GSYNC(); STOPCHK(13);
    { DEF_PTRS SchedSimple S{MB.p, MB.s, Wout, DM, DM, 4, G, cblk, 0}; EpiResT<true> E{X1, X1, 1.0f}; gemm_phase(lds, DM, DM, S, E); sk_res<4, true>(MB.s, Wout, X1 + (size_t)TP * DM, X1 + (size_t)TP * DM, 1.0f, (float*)shm); }
    GSYNC(); STOPCHK(14);
    { DEF_PTRS norm_rows<true>(X1, X1 + (size_t)TP * DM, P.in[23], HN); }
    GSYNC(); STOPCHK(15);
    { DEF_PTRS SchedSimple S{HN.p, HN.s, Wgu, DM, DM, 22, G, cblk, 0}; EpiGU E{ACT}; gemm_phase(lds, DM, DM, S, E); sk_gu(HN.s, Wgu, ACT.s, (float*)shm); if (PROBE == 9) sk_gu(HN.s, Wgu, ACT.s, (float*)shm); }
    GSYNC(); STOPCHK(16);
    { DEF_PTRS SchedSimple S{ACT.p, ACT.s, Wd, DFF, DFF, 4, G, cblk, 0}; EpiResT<true> E{X1, X1, 0.5f}; gemm_phase(lds, DFF, DFF, S, E); sk_res<11, true>(ACT.s, Wd, X1 + (size_t)TP * DM, X1 + (size_t)TP * DM, 0.5f, (float*)shm); }
    GSYNC(); STOPCHK(17);
    { DEF_PTRS final_norm(X1, P.in[27], P.out + O_YP, P.out + O_YS); }
}

extern "C" void kernel_launch(void* const* d_in, const int* in_sizes, int n_in, void* d_out, int out_size, void* d_ws, size_t ws_size, hipStream_t stream) {
    static int grid = 0;
    if (grid == 0) {
        int dev = 0, cus = 0, per_cu = 0;
        if (n_in != 28 || ws_size < WS_END) { fprintf(stderr, "kernel_launch: unexpected n_in %d / ws_size %zu (need %zu)\n", n_in, ws_size, (size_t)WS_END); grid = -1; return; }
        (void)hipGetDevice(&dev); (void)hipDeviceGetAttribute(&cus, hipDeviceAttributeMultiprocessorCount, dev);
        if (hipFuncSetAttribute((const void*)mega, hipFuncAttributeMaxDynamicSharedMemorySize, LDS_BYTES) != hipSuccess) { fprintf(stderr, "kernel_launch: hipFuncSetAttribute failed\n"); grid = -1; return; }
        if (hipOccupancyMaxActiveBlocksPerMultiprocessor(&per_cu, (const void*)mega, 512, LDS_BYTES) != hipSuccess || per_cu < 1) { fprintf(stderr, "kernel_launch: occupancy query gave %d\n", per_cu); per_cu = 1; (void)hipGetLastError(); }
        grid = cus * 1;
    }
    if (grid < 0) return;
    const float* ins[28]; for (int i = 0; i < 28; ++i) ins[i] = (const float*)d_in[i];
    float* outp = (float*)d_out; unsigned char* wsp = (unsigned char*)d_ws;
    if (hipMemsetAsync((char*)d_ws + WS_BAR, 0, 16384, stream) != hipSuccess) { fprintf(stderr, "kernel_launch: memset failed\n"); return; }
    void* args[30]; for (int i = 0; i < 28; ++i) args[i] = (void*)&ins[i];
    args[28] = (void*)&outp; args[29] = (void*)&wsp;
    hipError_t e = hipLaunchCooperativeKernel((void*)mega, dim3(grid), dim3(512), args, LDS_BYTES, stream);
    if (e != hipSuccess) fprintf(stderr, "cooperative launch failed: %s (grid %d)\n", hipGetErrorString(e), grid);
}
```

```cpp
#include <hip/hip_runtime.h>
#include <hip/hip_cooperative_groups.h>
#include <cstdio>
namespace cg = cooperative_groups;

#define LAS __attribute__((address_space(3)))
typedef unsigned short u16;
typedef short bf16x8 __attribute__((ext_vector_type(8)));
typedef float f32x4 __attribute__((ext_vector_type(4)));
typedef unsigned u32x4 __attribute__((ext_vector_type(4)));
typedef unsigned u32x2 __attribute__((ext_vector_type(2)));

constexpr int TP = 16384, TS = 128, NTOK = TP + TS, DM = 1024, DFF = 2816, SEQ = 2048;
constexpr float EPSV = 1e-6f;
constexpr int LDS_BYTES = 147456;

constexpr size_t SLOT = (size_t)TP * DM * 2;
constexpr size_t SSLOT = (size_t)256 * DM * 2;
constexpr size_t WS_WGU = 0;
constexpr size_t WS_WD = WS_WGU + (size_t)5632 * 1024 * 2;
constexpr size_t WS_WIN = WS_WD + (size_t)1024 * 2816 * 2;
constexpr size_t WS_WBD = WS_WIN + (size_t)8192 * 1024 * 2;
constexpr size_t WS_WAUP = WS_WBD + (size_t)8 * 256 * 256 * 2;
constexpr size_t WS_WBUP = WS_WAUP + (size_t)1024 * 1024 * 2;
constexpr size_t WS_WOUT = WS_WBUP + (size_t)1024 * 1024 * 2;
constexpr size_t WS_X1 = WS_WOUT + (size_t)1024 * 1024 * 2;
constexpr size_t WS_HN = WS_X1 + (size_t)16640 * DM * 4;
constexpr size_t WS_R0 = WS_HN + SLOT;
constexpr size_t WS_R1 = WS_R0 + SLOT;
constexpr size_t WS_R2 = WS_R1 + SLOT;
constexpr size_t WS_SIDE = WS_R2 + SLOT;
constexpr size_t WS_ACTS = WS_SIDE + 11 * SSLOT;
constexpr size_t WS_BL = WS_ACTS + (size_t)256 * DFF * 2;
constexpr size_t WS_AGG = WS_BL + (size_t)2048 * 128 * 4;
constexpr size_t WS_LB = WS_AGG + (size_t)256 * 1024 * 8;
constexpr size_t WS_LC = WS_LB + 4096;
constexpr size_t WS_BAR = WS_LC + 4096;
constexpr size_t WS_END = WS_BAR + 16384;
static_assert(WS_END <= (size_t)268435456, "workspace too large");
constexpr size_t O_YP = 0, O_YS = 16777216, O_HP = 16908288, O_LP = 17956864, O_CP = 17965056, O_HS = 17989632, O_LS = 34766848, O_CS = 34897920;

struct Params { const float* in[28]; float* out; unsigned char* ws; };
struct B16 { u16* p; u16* s; };

typedef __bf16 bf16x2_t __attribute__((ext_vector_type(2)));
typedef float f32x2_t __attribute__((ext_vector_type(2)));
__device__ __forceinline__ unsigned pk(float lo, float hi) { const f32x2_t v = {lo, hi}; const bf16x2_t b = __builtin_convertvector(v, bf16x2_t); return __builtin_bit_cast(unsigned, b); }
__device__ __forceinline__ float blo(unsigned w) { return __uint_as_float(w << 16); }
__device__ __forceinline__ float bhi(unsigned w) { return __uint_as_float(w & 0xffff0000u); }
__device__ __forceinline__ float b2f(u16 b) { return __uint_as_float(((unsigned)b) << 16); }
__device__ __forceinline__ u16 f2b(float f) { return (u16)(pk(f, 0.f) & 0xffffu); }
__device__ __forceinline__ float sigm(float x) { return __builtin_amdgcn_rcpf(1.f + __builtin_amdgcn_exp2f(-1.4426950408889634f * x)); }
__device__ __forceinline__ float silu(float x) { return x * __builtin_amdgcn_rcpf(1.f + __builtin_amdgcn_exp2f(-1.4426950408889634f * x)); }
__device__ __forceinline__ float gelu_t(float x) { const float x2 = x * x; const float t = x2 * (-0.10294324f) + (-2.3022082f); return x * __builtin_amdgcn_rcpf(1.f + __builtin_amdgcn_exp2f(x * t)); }
__device__ __forceinline__ unsigned pkh(float lo, float hi) { const _Float16 a = (_Float16)lo, b = (_Float16)hi; return (unsigned)__builtin_bit_cast(u16, a) | ((unsigned)__builtin_bit_cast(u16, b) << 16); }
__device__ __forceinline__ float h2f(u16 h) { return (float)__builtin_bit_cast(_Float16, h); }
__device__ __forceinline__ u32x4 pack8(const float* o) { u32x4 r; r.x = pk(o[0], o[1]); r.y = pk(o[2], o[3]); r.z = pk(o[4], o[5]); r.w = pk(o[6], o[7]); return r; }
__device__ __forceinline__ void unpack8(u32x4 w, float* o) { o[0] = blo(w.x); o[1] = bhi(w.x); o[2] = blo(w.y); o[3] = bhi(w.y); o[4] = blo(w.z); o[5] = bhi(w.z); o[6] = blo(w.w); o[7] = bhi(w.w); }
template <class T> __device__ __forceinline__ T* asg(T* p) { return (T*)(__attribute__((address_space(1))) T*)p; }
__device__ __forceinline__ unsigned char* opq(unsigned char* p) { return p; }
__device__ __forceinline__ int opqv(int v) { asm volatile("" : "+v"(v)); return v; }
#define TIDX opqv((int)threadIdx.x)
struct F8 { f32x4 a, b; };
__device__ __forceinline__ F8 unpack8v(u32x4 w) { F8 r; r.a = (f32x4){blo(w.x), bhi(w.x), blo(w.y), bhi(w.y)}; r.b = (f32x4){blo(w.z), bhi(w.z), blo(w.w), bhi(w.w)}; return r; }
__device__ __forceinline__ u32x4 pack8v(f32x4 a, f32x4 b) { u32x4 r; r.x = pk(a.x, a.y); r.y = pk(a.z, a.w); r.z = pk(b.x, b.y); r.w = pk(b.z, b.w); return r; }
__device__ __forceinline__ u32x4 pack8h(f32x4 a, f32x4 b) { u32x4 r; r.x = pkh(a.x, a.y); r.y = pkh(a.z, a.w); r.z = pkh(b.x, b.y); r.w = pkh(b.z, b.w); return r; }
__device__ __forceinline__ f32x4 sig4(f32x4 v) { return (f32x4){sigm(v.x), sigm(v.y), sigm(v.z), sigm(v.w)}; }
__device__ __forceinline__ f32x4 silu4(f32x4 v) { return (f32x4){silu(v.x), silu(v.y), silu(v.z), silu(v.w)}; }
__device__ __forceinline__ f32x4 gelu4(f32x4 v) { return (f32x4){gelu_t(v.x), gelu_t(v.y), gelu_t(v.z), gelu_t(v.w)}; }
__device__ __forceinline__ f32x4 log4(f32x4 v) { return (f32x4){__logf(v.x), __logf(v.y), __logf(v.z), __logf(v.w)}; }
__device__ __forceinline__ u32x2 pk4(f32x4 v) { u32x2 o; o.x = pk(v.x, v.y); o.y = pk(v.z, v.w); return o; }
__device__ __forceinline__ f32x4 up4(u32x2 w) { return (f32x4){blo(w.x), bhi(w.x), blo(w.y), bhi(w.y)}; }
__device__ __forceinline__ float wave_sum(float v) {
#pragma unroll
    for (int o = 32; o >= 1; o >>= 1) v += __shfl_xor(v, o, 64);
    return v;
}

constexpr int BM = 256, BK = 64, HALF = 128, HTB = HALF * BK * 2;
__device__ __forceinline__ int lds_byte(int r, int c) { const int st = (r >> 4) * 2 + (c >> 5), rr = r & 15, cc = c & 31, ob = rr * 64 + cc * 2; return st * 1024 + (ob ^ (((ob >> 9) & 1) << 5)); }
__device__ __forceinline__ void stage_rc(int b, int& R, int& C) { const int st = b / 1024, sb = b % 1024, swz = sb ^ (((sb >> 9) & 1) << 5); R = (st >> 1) * 16 + swz / 64; C = (st & 1) * 32 + (swz % 64) / 2; }
__device__ __forceinline__ int perm32(int rho) { const int n = rho >> 4, i = rho & 15; return 8 * (i >> 2) + 4 * n + (i & 3); }

struct Unit { int pm, pn, sub; const char* a; const char* b; };

__device__ __forceinline__ bool tile_of(long L, int nM, int nN, int& pm, int& pn) {
    const int nwg = nM * nN; if (L >= nwg) return false;
    int wgid = (int)L; { const int q = nwg / 8, r = nwg % 8, xcd = wgid % 8, off = wgid / 8; wgid = (xcd < r ? xcd * (q + 1) : r * (q + 1) + (xcd - r) * q) + off; }
    const int nig = 8 * nN, gid = wgid / nig, fm = gid * 8, gsz = (nM - fm) < 8 ? (nM - fm) : 8;
    pm = fm + ((wgid % nig) % gsz); pn = (wgid % nig) / gsz; return true;
}

template <class Epi, class Sched>
__device__ __forceinline__ void gemm_phase(LAS unsigned char* lds, const int K, const int lda, const Sched& S, const Epi& E) {
    const int tid = TIDX, wid = __builtin_amdgcn_readfirstlane(tid >> 6), lane = tid & 63, wr = wid >> 2, wc = wid & 3, fr = lane & 15, fq = lane >> 4;
    const int nt = K / BK;
    unsigned voffA[2], voffB[2];
#pragma unroll
    for (int i = 0; i < 2; ++i) { int R, C; stage_rc(tid * 16 + i * 8192, R, C); const int Rb = Epi::PERM ? ((R & ~31) + perm32(R & 31)) : R;
        voffA[i] = (unsigned)(R * lda + C) * 2u; voffB[i] = (unsigned)(Rb * K + C) * 2u; }
    const size_t kstep = (size_t)(BK * 2);
    const size_t hstepA = (size_t)HALF * lda * 2, hstepB = (size_t)HALF * K * 2;
    const unsigned ldsw = (unsigned)wid * 1024u;
    const int aoff = lds_byte(wr * 64 + fr, fq * 8), boff = lds_byte(wc * 32 + fr, fq * 8);
#define G_SA(b, h) (((b) * 2 + (h)) * HTB)
#define G_SB(b, h) ((4 + (b) * 2 + (h)) * HTB)
#define G_STAGE(bufoff, gbase, voff) do { _Pragma("unroll") for (int _i = 0; _i < 2; ++_i) \
        __builtin_amdgcn_global_load_lds((const unsigned*)((const char*)(gbase) + (voff)[_i]), (LAS unsigned*)(lds + (bufoff) + ldsw + _i * 8192), 16, 0, 0); } while (0)
#define G_LDA(dst, b, h) do { _Pragma("unroll") for (int m = 0; m < 4; ++m) _Pragma("unroll") for (int k = 0; k < 2; ++k) dst[m][k] = *(const LAS bf16x8*)(lds + G_SA(b, h) + aoff + m * 2048 + k * 1024); } while (0)
#define G_LDB(dst, b, h) do { _Pragma("unroll") for (int n = 0; n < 2; ++n) _Pragma("unroll") for (int k = 0; k < 2; ++k) dst[n][k] = *(const LAS bf16x8*)(lds + G_SB(b, h) + boff + n * 2048 + k * 1024); } while (0)
#define G_MMA(ai, bj, At, Bt) do { __builtin_amdgcn_s_setprio(1); _Pragma("unroll") for (int m = 0; m < 4; ++m) _Pragma("unroll") for (int n = 0; n < 2; ++n) _Pragma("unroll") for (int k = 0; k < 2; ++k) \
        acc[ai][bj][m][n] = __builtin_amdgcn_mfma_f32_16x16x32_bf16(Bt[n][k], At[m][k], acc[ai][bj][m][n], 0, 0, 0); __builtin_amdgcn_s_setprio(0); } while (0)
#define G_WAIT_V(n) asm volatile("s_waitcnt vmcnt(" #n ")" ::: "memory")
#define G_WAIT_L(n) asm volatile("s_waitcnt lgkmcnt(" #n ")" ::: "memory")
#define G_BAR __builtin_amdgcn_s_barrier()
#define G_SCHED __builtin_amdgcn_sched_barrier(0)
    Unit cur, nxt; int ui = 0;
    if (!S.next(0, cur)) return;
    f32x4 acc[2][2][4][2];
#pragma unroll
    for (int a = 0; a < 2; ++a)
#pragma unroll
        for (int b = 0; b < 2; ++b)
#pragma unroll
            for (int m = 0; m < 4; ++m)
#pragma unroll
                for (int n = 0; n < 2; ++n) acc[a][b][m][n] = (f32x4){0.f, 0.f, 0.f, 0.f};
    bf16x8 At[4][2], B0[2][2], B1[2][2];
    const char* cA = cur.a; const char* cB = cur.b;
    G_STAGE(G_SB(0, 0), cB, voffB); G_STAGE(G_SA(0, 0), cA, voffA); G_STAGE(G_SB(0, 1), cB + hstepB, voffB); G_STAGE(G_SA(0, 1), cA + hstepA, voffA);
    if (wr == 1) G_BAR;
    G_WAIT_V(4); G_BAR;
    G_STAGE(G_SB(1, 0), cB + kstep, voffB); G_STAGE(G_SA(1, 0), cA + kstep, voffA); G_STAGE(G_SB(1, 1), cB + hstepB + kstep, voffB);
    G_WAIT_V(6); G_BAR;
    for (;;) {
        const bool has_next = S.next(ui + 1, nxt);
        const char* nA = has_next ? nxt.a : cA; const char* nB = has_next ? nxt.b : cB;
        for (int t = 0; t < nt; t += 2) {
            const bool last = (t == nt - 2);
            const char* a1 = cA + (size_t)(t + 1) * kstep;
            const char* a2 = last ? nA : cA + (size_t)(t + 2) * kstep; const char* b2 = last ? nB : cB + (size_t)(t + 2) * kstep;
            const char* a3 = a2 + kstep; const char* b3 = b2 + kstep;
            G_LDB(B0, 0, 0); G_SCHED; G_LDA(At, 0, 0); G_STAGE(G_SA(1, 1), a1 + hstepA, voffA);
            G_WAIT_L(8); G_BAR; G_WAIT_L(0); G_MMA(0, 0, At, B0); G_BAR; G_SCHED;
            G_LDB(B1, 0, 1); G_STAGE(G_SB(0, 0), b2, voffB);
            G_BAR; G_WAIT_L(0); G_MMA(0, 1, At, B1); G_BAR;
            G_LDA(At, 0, 1); G_STAGE(G_SA(0, 0), a2, voffA);
            G_BAR; G_WAIT_L(0); G_MMA(1, 0, At, B0); G_BAR; G_SCHED;
            G_STAGE(G_SB(0, 1), b2 + hstepB, voffB);
            G_WAIT_V(6); G_BAR; G_MMA(1, 1, At, B1); G_BAR;
            G_LDB(B0, 1, 0); G_SCHED; G_LDA(At, 1, 0); G_STAGE(G_SA(0, 1), a2 + hstepA, voffA);
            G_WAIT_L(8); G_BAR; G_WAIT_L(0); G_MMA(0, 0, At, B0); G_BAR; G_SCHED;
            G_LDB(B1, 1, 1); G_STAGE(G_SB(1, 0), b3, voffB);
            G_BAR; G_WAIT_L(0); G_MMA(0, 1, At, B1); G_BAR;
            G_LDA(At, 1, 1); G_STAGE(G_SA(1, 0), a3, voffA);
            G_BAR; G_WAIT_L(0); G_MMA(1, 0, At, B0); G_BAR; G_SCHED;
            G_STAGE(G_SB(1, 1), b3 + hstepB, voffB);
            G_WAIT_V(6); G_BAR; G_MMA(1, 1, At, B1); G_BAR;
        }
        E(acc, cur, wr, wc, fr, fq);
        if (!has_next) break;
#pragma unroll
        for (int a = 0; a < 2; ++a)
#pragma unroll
            for (int b = 0; b < 2; ++b)
#pragma unroll
                for (int m = 0; m < 4; ++m)
#pragma unroll
                    for (int n = 0; n < 2; ++n) acc[a][b][m][n] = (f32x4){0.f, 0.f, 0.f, 0.f};
        cur = nxt; cA = nA; cB = nB; ++ui;
    }
    G_WAIT_V(0);
    if (wr == 0) G_BAR;
    G_BAR;
#undef G_SA
#undef G_SB
#undef G_STAGE
#undef G_LDA
#undef G_LDB
#undef G_MMA
#undef G_WAIT_V
#undef G_WAIT_L
#undef G_BAR
#undef G_SCHED
}

struct SchedLim {
    const u16* Ap; const u16* As; const u16* Bt; int lda, K, nN, G, c; int lim;
    __device__ __forceinline__ bool next(int i, Unit& u) const {
        int pm, pn; if (i >= lim || !tile_of((long)(i & 1) * G + c, 64, nN, pm, pn)) return false;
        u.pm = pm; u.pn = pn; u.sub = 0;
        u.a = (const char*)(Ap + (size_t)pm * 256 * lda);
        u.b = (const char*)(Bt + (size_t)pn * 256 * K); return true;
    }
};
struct SchedSimple {
    const u16* Ap; const u16* As; const u16* Bt; int lda, K, nN, G, c; int acol_per_pn;
    __device__ __forceinline__ bool next(int i, Unit& u) const {
        int pm, pn; if (!tile_of((long)i * G + c, 64, nN, pm, pn)) return false;
        u.pm = pm; u.pn = pn; u.sub = 0;
        u.a = (const char*)((pm < 64 ? Ap + (size_t)pm * 256 * lda : As) + (size_t)(pn >> 1) * acol_per_pn);
        u.b = (const char*)(Bt + (size_t)pn * 256 * K); return true;
    }
};
struct SchedMerge {
    B16 hn, oa, ob; const u16* Win; const u16* Waup; const u16* Wbup; int G, c;
    __device__ __forceinline__ bool next(int i, Unit& u) const {
        int pm, pn; if (!tile_of((long)(i >> 2) * G + c, 64, 4, pm, pn)) return false;
        const int sub = i & 3; u.pm = pm; u.pn = pn; u.sub = sub;
        const unsigned long long m1 = (sub == 1) ? ~0ull : 0ull, m3 = (sub == 3) ? ~0ull : 0ull, m0 = ~(m1 | m3);
        const u16* abp = (const u16*)(((unsigned long long)oa.p & m1) | ((unsigned long long)ob.p & m3) | ((unsigned long long)hn.p & m0));
        const u16* abs_ = (const u16*)(((unsigned long long)oa.s & m1) | ((unsigned long long)ob.s & m3) | ((unsigned long long)hn.s & m0));
        const u16* bb = (const u16*)(((unsigned long long)Waup & m1) | ((unsigned long long)Wbup & m3) | ((unsigned long long)(Win + (size_t)(sub == 0 ? 6144 : 7168) * DM) & m0));
        u.a = (const char*)(pm < 64 ? abp + (size_t)pm * 256 * DM : abs_);
        u.b = (const char*)(bb + (size_t)pn * 256 * DM); return true;
    }
};

struct EpiGU {
    static constexpr bool PERM = true; B16 act;
    __device__ __forceinline__ void operator()(const f32x4 (&acc)[2][2][4][2], const Unit& u, int wr, int wc, int fr, int fq) const {
        u16* base = (u.pm < 64 ? act.p + (size_t)u.pm * 256 * DFF : act.s) + u.pn * 128 + wc * 32 + 8 * fq;
#pragma unroll
        for (int ai = 0; ai < 2; ++ai)
#pragma unroll
            for (int m = 0; m < 4; ++m) {
                const int rt = ai * 128 + wr * 64 + m * 16 + fr; float o[8];
#pragma unroll
                for (int n = 0; n < 2; ++n)
#pragma unroll
                    for (int j = 0; j < 4; ++j) o[n * 4 + j] = silu(acc[ai][0][m][n][j]) * acc[ai][1][m][n][j];
                *(u32x4*)(base + (size_t)rt * DFF) = pack8(o);
            }
    }
};
template <bool R16> struct EpiResT {
    static constexpr bool PERM = true; const void* rp; u16* out; float scale;
    __device__ __forceinline__ void operator()(const f32x4 (&acc)[2][2][4][2], const Unit& u, int wr, int wc, int fr, int fq) const {
        const size_t o0 = (size_t)(u.pm * 256 + wr * 64 + fr) * DM + u.pn * 256 + wc * 32 + 8 * fq;
#pragma unroll
        for (int ai = 0; ai < 2; ++ai)
#pragma unroll
            for (int m = 0; m < 4; ++m) {
#pragma unroll
                for (int bj = 0; bj < 2; ++bj) { const size_t off = o0 + (size_t)(ai * 128 + m * 16) * DM + bj * 128;
                    f32x4 r0, r1;
                    if (R16) { const F8 rv = unpack8v(*(const u32x4*)((const u16*)rp + off)); r0 = rv.a; r1 = rv.b; }
                    else { r0 = *(const f32x4*)((const float*)rp + off); r1 = *(const f32x4*)((const float*)rp + off + 4); }
                    *(u32x4*)(out + off) = pack8v(r0 + scale * acc[ai][bj][m][0], r1 + scale * acc[ai][bj][m][1]); }
                asm volatile("" ::: "memory");
            }
    }
};
template <int MODE> __device__ __forceinline__ void ina_store(u16* base, const f32x4 (&acc)[2][2][4][2], const float* lbp) {
#pragma unroll
    for (int bj = 0; bj < 2; ++bj) {
        f32x4 l0 = (f32x4){0.f, 0.f, 0.f, 0.f}, l1 = l0;
        (void)lbp; (void)l0; (void)l1;
#pragma unroll
        for (int ai = 0; ai < 2; ++ai)
#pragma unroll
            for (int m = 0; m < 4; ++m) {
                u16* d = base + (size_t)(ai * 128 + m * 16) * DM + bj * 128;
                if (MODE == 1) *(u32x4*)d = pack8h(acc[ai][bj][m][0], acc[ai][bj][m][1]);
                else *(u32x4*)d = pack8v(acc[ai][bj][m][0], acc[ai][bj][m][1]);
            }
    }
}
struct EpiInA {
    static constexpr bool PERM = true; B16 qs, lf, v, gs; const float* lbv;
    __device__ __forceinline__ void operator()(const f32x4 (&acc)[2][2][4][2], const Unit& u, int wr, int wc, int fr, int fq) const {
        const int seg = u.pn >> 2, cs = (u.pn & 3) * 256 + wc * 32 + 8 * fq;
        const size_t ro = cs + (size_t)(wr * 64 + fr) * DM; const size_t po = (size_t)u.pm * 256 * DM; const bool pr = u.pm < 64;
        if (seg == 0) { u16* qp = qs.p; u16* qsm = qs.s; ina_store<0>((pr ? qp + po : qsm) + ro, acc, lbv); }
        else if (seg == 1) { u16* qp = lf.p; u16* qsm = lf.s; ina_store<1>((pr ? qp + po : qsm) + ro, acc, lbv + cs); }
        else if (seg == 2) { u16* qp = v.p; u16* qsm = v.s; ina_store<2>((pr ? qp + po : qsm) + ro, acc, lbv); }
        else { u16* qp = gs.p; u16* qsm = gs.s; ina_store<0>((pr ? qp + po : qsm) + ro, acc, lbv); }
    }
};
struct EpiNull { static constexpr bool PERM = true; float* sink;
    __device__ __forceinline__ void operator()(const f32x4 (&acc)[2][2][4][2], const Unit& u, int wr, int wc, int fr, int fq) const {
        float t = 0.f;
#pragma unroll
        for (int ai = 0; ai < 2; ++ai)
#pragma unroll
            for (int bj = 0; bj < 2; ++bj)
#pragma unroll
                for (int m = 0; m < 4; ++m)
#pragma unroll
                    for (int n = 0; n < 2; ++n) t += acc[ai][bj][m][n].x + acc[ai][bj][m][n].y + acc[ai][bj][m][n].z + acc[ai][bj][m][n].w;
        if (t == 12345.678f) sink[0] = t;
    }
};
struct EpiInBP {
    static constexpr bool PERM = true; u16* dst; int ldp;
    __device__ __forceinline__ void operator()(const f32x4 (&acc)[2][2][4][2], const Unit& u, int wr, int wc, int fr, int fq) const {
        const int seg = u.pn >> 2, cs = (u.pn & 3) * 256 + wc * 32 + 8 * fq;
        u16* base = dst + (size_t)u.pm * 256 * ldp + cs + (size_t)(wr * 64 + fr) * ldp;
        if (seg == 0) {
#pragma unroll
            for (int ai = 0; ai < 2; ++ai)
#pragma unroll
                for (int m = 0; m < 4; ++m)
#pragma unroll
                    for (int bj = 0; bj < 2; ++bj) *(u32x4*)(base + (size_t)(ai * 128 + m * 16) * ldp + bj * 128) = pack8v(acc[ai][bj][m][0], acc[ai][bj][m][1]);
        } else {
#pragma unroll
            for (int ai = 0; ai < 2; ++ai)
#pragma unroll
                for (int m = 0; m < 4; ++m)
#pragma unroll
                    for (int bj = 0; bj < 2; ++bj) *(u32x4*)(base + (size_t)(ai * 128 + m * 16) * ldp + bj * 128) = pack8v(gelu4(acc[ai][bj][m][0]), gelu4(acc[ai][bj][m][1]));
        }
    }
};
struct EpiInB {
    static constexpr bool PERM = true; B16 xr, yg;
    __device__ __forceinline__ void operator()(const f32x4 (&acc)[2][2][4][2], const Unit& u, int wr, int wc, int fr, int fq) const {
        const int seg = u.pn >> 2, cs = (u.pn & 3) * 256 + wc * 32 + 8 * fq;
        u16* base = (u.pm < 64 ? (seg == 0 ? +xr.p : +yg.p) + (size_t)u.pm * 256 * DM : (seg == 0 ? +xr.s : +yg.s)) + cs + (size_t)(wr * 64 + fr) * DM;
        if (seg == 0) {
#pragma unroll
            for (int ai = 0; ai < 2; ++ai)
#pragma unroll
                for (int m = 0; m < 4; ++m)
#pragma unroll
                    for (int bj = 0; bj < 2; ++bj) *(u32x4*)(base + (size_t)(ai * 128 + m * 16) * DM + bj * 128) = pack8v(acc[ai][bj][m][0], acc[ai][bj][m][1]);
        } else {
#pragma unroll
            for (int ai = 0; ai < 2; ++ai)
#pragma unroll
                for (int m = 0; m < 4; ++m)
#pragma unroll
                    for (int bj = 0; bj < 2; ++bj) *(u32x4*)(base + (size_t)(ai * 128 + m * 16) * DM + bj * 128) = pack8v(acc[ai][bj][m][0], acc[ai][bj][m][1]);
        }
    }
};
__device__ __forceinline__ f32x4 nexpm1_4(f32x4 x) { const f32x4 p = 1.f + x * (0.5f + x * (0.16666667f + x * (0.041666668f + x * (0.008333334f + x * 0.0013888889f)))); return -x * p; }
__device__ __forceinline__ f32x4 sqrt4(f32x4 v) { return (f32x4){sqrtf(fmaxf(v.x, 0.f)), sqrtf(fmaxf(v.y, 0.f)), sqrtf(fmaxf(v.z, 0.f)), sqrtf(fmaxf(v.w, 0.f))}; }
struct EpiBD {
    static constexpr bool PERM = true; B16 xc, bt; const float* ba; const float* bx; const float* lc;
    __device__ __forceinline__ void operator()(const f32x4 (&acc)[2][2][4][2], const Unit& u, int wr, int wc, int fr, int fq) const {
        const int ch = u.pn * 128 + wc * 32 + 8 * fq;
        u16* xb = (u.pm < 64 ? xc.p + (size_t)u.pm * 256 * DM : xc.s) + ch + (size_t)(wr * 64 + fr) * DM; u16* bb = (u.pm < 64 ? bt.p + (size_t)u.pm * 256 * DM : bt.s) + ch + (size_t)(wr * 64 + fr) * DM;
#pragma unroll
        for (int n = 0; n < 2; ++n) {
            const f32x4 cba = *(const f32x4*)(ba + ch + 4 * n), cbx = *(const f32x4*)(bx + ch + 4 * n), cl = *(const f32x4*)(lc + ch + 4 * n);
#pragma unroll
            for (int ai = 0; ai < 2; ++ai)
#pragma unroll
                for (int m = 0; m < 4; ++m) {
                    const size_t off = (size_t)(ai * 128 + m * 16) * DM + 4 * n;
                    const u32x2 xw = *(const u32x2*)(xb + off); const f32x4 xv = (f32x4){blo(xw.x), bhi(xw.x), blo(xw.y), bhi(xw.y)};
                    const f32x4 r = sig4(acc[ai][0][m][n] + cba), ig = sig4(acc[ai][1][m][n] + cbx);
                    const f32x4 la = r * cl; const f32x4 bo = sqrt4(nexpm1_4(2.f * la)) * ig * xv;
                    u32x2 o1, o2; o1.x = pk(la.x, la.y); o1.y = pk(la.z, la.w); o2.x = pk(bo.x, bo.y); o2.y = pk(bo.z, bo.w);
                    *(u32x2*)(xb + off) = o1; *(u32x2*)(bb + off) = o2;
                    if (m & 1) asm volatile("" ::: "memory");
                }
        }
    }
};
struct EpiMerge {
    static constexpr bool PERM = true; B16 gt, ta, mb;
    __device__ __forceinline__ void operator()(const f32x4 (&acc)[2][2][4][2], const Unit& u, int wr, int wc, int fr, int fq) const {
        const size_t ro = ((u.pm < 64) ? (size_t)u.pm * 256 * DM : 0) + u.pn * 256 + wc * 32 + 8 * fq + (size_t)(wr * 64 + fr) * DM;
        u16* g = (u.pm < 64 ? +gt.p : +gt.s) + ro; u16* t = (u.pm < 64 ? +ta.p : +ta.s) + ro; u16* mo = (u.pm < 64 ? +mb.p : +mb.s) + ro;
        const int sub = u.sub;
        if (sub == 0 || sub == 2) {
#pragma unroll
            for (int ai = 0; ai < 2; ++ai)
#pragma unroll
                for (int m = 0; m < 4; ++m)
#pragma unroll
                    for (int bj = 0; bj < 2; ++bj) *(u32x4*)(g + (size_t)(ai * 128 + m * 16) * DM + bj * 128) = pack8v(sig4(acc[ai][bj][m][0]), sig4(acc[ai][bj][m][1]));
        } else if (sub == 1) {
#pragma unroll
            for (int ai = 0; ai < 2; ++ai)
#pragma unroll
                for (int m = 0; m < 4; ++m)
#pragma unroll
                    for (int bj = 0; bj < 2; ++bj) { const size_t off = (size_t)(ai * 128 + m * 16) * DM + bj * 128; const F8 gv = unpack8v(*(const u32x4*)(g + off));
                        *(u32x4*)(t + off) = pack8v(gv.a * acc[ai][bj][m][0], gv.b * acc[ai][bj][m][1]); if (bj) asm volatile("" ::: "memory"); }
        } else {
#pragma unroll
            for (int ai = 0; ai < 2; ++ai)
#pragma unroll
                for (int m = 0; m < 4; ++m)
#pragma unroll
                    for (int bj = 0; bj < 2; ++bj) { const size_t off = (size_t)(ai * 128 + m * 16) * DM + bj * 128; const F8 gv = unpack8v(*(const u32x4*)(g + off)), tv = unpack8v(*(const u32x4*)(t + off));
                        *(u32x4*)(mo + off) = pack8v(tv.a + gv.a * acc[ai][bj][m][0], tv.b + gv.b * acc[ai][bj][m][1]); if (bj) asm volatile("" ::: "memory"); }
        }
    }
};

__device__ __forceinline__ void tconv_tile(const float* src, int N, int K, int kt, int nt, u16* dst, int mode, float* tile) {
    const int tid = TIDX;
    const int c4 = (tid & 15) * 4;
#pragma unroll
    for (int p = 0; p < 2; ++p) { const int r = (tid >> 4) + 32 * p; const f32x4 v = *(const f32x4*)(src + (size_t)(kt * 64 + r) * N + nt * 64 + c4);
        tile[r * 65 + c4] = v.x; tile[r * 65 + c4 + 1] = v.y; tile[r * 65 + c4 + 2] = v.z; tile[r * 65 + c4 + 3] = v.w; }
    __syncthreads();
    const int n = tid >> 3, k8 = (tid & 7) * 8; float f[8];
#pragma unroll
    for (int j = 0; j < 8; ++j) f[j] = tile[(k8 + j) * 65 + n];
    const int ng = nt * 64 + n; const int drow = mode == 0 ? ng : ((ng >> 7) * 256 + (mode == 2 ? 128 : 0) + (ng & 127));
    *(u32x4*)(dst + (size_t)drow * K + kt * 64 + k8) = pack8(f);
    __syncthreads();
}
__device__ __forceinline__ void conv_matrix(const float* src, int K, int N, u16* dst, int mode, int t, float* tile) {
    const int ntn = N / 64; tconv_tile(src, N, K, t / ntn, t % ntn, dst, mode, tile);
}
template <bool S16>
__device__ __forceinline__ void norm_rows(const void* sp, const void* ss, const float* gain, B16 dst) {
    const int lane = TIDX & 63, gw = blockIdx.x * 8 + (TIDX >> 6), nw = gridDim.x * 8;
    f32x4 g[4];
#pragma unroll
    for (int i = 0; i < 4; ++i) g[i] = *(const f32x4*)(gain + i * 256 + lane * 4);
    for (int row = gw; row < NTOK; row += nw) {
        f32x4 v[4]; float s = 0.f;
        if (S16) { const u16* src = row < TP ? (const u16*)sp + (size_t)row * DM : (const u16*)ss + (size_t)(row - TP) * DM;
#pragma unroll
            for (int i = 0; i < 4; ++i) v[i] = up4(*(const u32x2*)(src + i * 256 + lane * 4)); }
        else { const float* src = row < TP ? (const float*)sp + (size_t)row * DM : (const float*)ss + (size_t)(row - TP) * DM;
#pragma unroll
            for (int i = 0; i < 4; ++i) v[i] = *(const f32x4*)(src + i * 256 + lane * 4); }
#pragma unroll
        for (int i = 0; i < 4; ++i) s += v[i].x * v[i].x + v[i].y * v[i].y + v[i].z * v[i].z + v[i].w * v[i].w;
        s = wave_sum(s); const float rs = rsqrtf(s * (1.f / DM) + EPSV);
        u16* d = (row < TP ? dst.p + (size_t)row * DM : dst.s + (size_t)(row - TP) * DM);
#pragma unroll
        for (int i = 0; i < 4; ++i) { u32x2 w; w.x = pk(v[i].x * rs * g[i].x, v[i].y * rs * g[i].y); w.y = pk(v[i].z * rs * g[i].z, v[i].w * rs * g[i].w); *(u32x2*)(d + i * 256 + lane * 4) = w; }
    }
}
__device__ __forceinline__ void final_norm(const u16* x, const float* gain, float* yp, float* ys) {
    const int lane = TIDX & 63, gw = blockIdx.x * 8 + (TIDX >> 6), nw = gridDim.x * 8;
    f32x4 g[4];
#pragma unroll
    for (int i = 0; i < 4; ++i) g[i] = *(const f32x4*)(gain + i * 256 + lane * 4);
    for (int row = gw; row < NTOK; row += nw) {
        const u16* src = x + (size_t)row * DM;
        f32x4 v[4]; float s = 0.f;
#pragma unroll
        for (int i = 0; i < 4; ++i) { v[i] = up4(*(const u32x2*)(src + i * 256 + lane * 4)); s += v[i].x * v[i].x + v[i].y * v[i].y + v[i].z * v[i].z + v[i].w * v[i].w; }
        s = wave_sum(s); const float rs = rsqrtf(s * (1.f / DM) + EPSV);
        float* d = row < TP ? yp + (size_t)row * DM : ys + (size_t)(row - TP) * DM;
#pragma unroll
        for (int i = 0; i < 4; ++i) *(f32x4*)(d + i * 256 + lane * 4) = v[i] * rs * g[i];
    }
}

constexpr int L_BL = 0, L_TOT = 32768, L_RED = 34816, L_QE = 35328, L_KE = 52736, L_VT = 70144, L_AM = 88576, L_ST = 97792;
constexpr int QS_ = 136, VS_ = 72;

struct Pre2 { u32x4 a, b; };
__device__ __forceinline__ Pre2 issue_rowseg(const u16* base, int row0, int h) {
    const int tid = TIDX, r = tid >> 3, seg = tid & 7;
    const u16* p = base + (size_t)(row0 + r) * DM + h * 128 + seg * 16;
    Pre2 o; o.a = *(const u32x4*)p; o.b = *(const u32x4*)(p + 8); return o;
}
__device__ __forceinline__ void commit_lf(const Pre2& pr, int h, float* bL, const float* lbv) {
    const int tid = TIDX, r = tid >> 3, seg = tid & 7;
    float lb[16];
#pragma unroll
    for (int i = 0; i < 4; ++i) { const f32x4 t = *(const f32x4*)(lbv + h * 128 + seg * 16 + 4 * i); lb[4 * i] = t.x; lb[4 * i + 1] = t.y; lb[4 * i + 2] = t.z; lb[4 * i + 3] = t.w; }
    float* d = bL + r * 128 + seg * 16;
    const unsigned ws[8] = {pr.a.x, pr.a.y, pr.a.z, pr.a.w, pr.b.x, pr.b.y, pr.b.z, pr.b.w};
#pragma unroll
    for (int i = 0; i < 8; ++i) { const float p0 = h2f((u16)(ws[i] & 0xffffu)), p1 = h2f((u16)(ws[i] >> 16));
        d[2 * i] = __logf(lb[2 * i] + (1.f - lb[2 * i]) * sigm(p0)); d[2 * i + 1] = __logf(lb[2 * i + 1] + (1.f - lb[2 * i + 1]) * sigm(p1)); }
}
__device__ __forceinline__ void commit_vT(const Pre2& pr, u16* vT) {
    const int tid = TIDX, sI = tid >> 3, seg = tid & 7;
    const unsigned ws[8] = {pr.a.x, pr.a.y, pr.a.z, pr.a.w, pr.b.x, pr.b.y, pr.b.z, pr.b.w};
#pragma unroll
    for (int i = 0; i < 8; ++i) { vT[(seg * 16 + 2 * i) * VS_ + sI] = (u16)(ws[i] & 0xffffu); vT[(seg * 16 + 2 * i + 1) * VS_ + sI] = (u16)(ws[i] >> 16); }
}
__device__ __forceinline__ void commit_rows(const Pre2& pr, u16* dst  ) {
    const int tid = TIDX, r = tid >> 3, seg = tid & 7;
    *(u32x4*)(dst + r * QS_ + seg * 16) = pr.a; *(u32x4*)(dst + r * QS_ + seg * 16 + 8) = pr.b;
}

__device__ __forceinline__ void hgrn_h1(const Params& P, unsigned char* sm) {
    float* bL = (float*)(sm + L_BL); float* tot = (float*)(sm + L_TOT); u16* kdT = (u16*)(sm + L_QE); u16* vT = (u16*)(sm + L_VT);
    const u16* lfp = (const u16*)(P.ws + WS_R1); const u16* vp = (const u16*)(P.ws + WS_R2);
    u16* Sb = (u16*)(P.out + O_HS); float* BLg = (float*)(P.ws + WS_BL);
    const int tid = TIDX, lane = tid & 63, w = tid >> 6, fr = lane & 15, fq = lane >> 4;
    Pre2 plf, pv;
    { const int it0 = blockIdx.x; if (it0 < 2048) { const int h0 = it0 & 7, c0 = (it0 >> 3) & 31, b0 = it0 >> 8; plf = issue_rowseg(lfp, b0 * SEQ + c0 * 64, h0); pv = issue_rowseg(vp, b0 * SEQ + c0 * 64, h0); } }
    for (int item = blockIdx.x; item < 2048; item += gridDim.x) {
        const int h = item & 7, c = (item >> 3) & 31, b = item >> 8; const int row0 = b * SEQ + c * 64;
        const int sidx = (b * 8 + h) * 32 + c;
        commit_lf(plf, h, bL, (const float*)(P.ws + WS_LB)); commit_vT(pv, vT);
        __syncthreads();
        { const int nit = item + (int)gridDim.x; if (nit < 2048) { const int nh = nit & 7, nc = (nit >> 3) & 31, nb = nit >> 8; const int nrow0 = nb * SEQ + nc * 64; plf = issue_rowseg(lfp, nrow0, nh); pv = issue_rowseg(vp, nrow0, nh); } }
        const int col = tid & 127, part = tid >> 7; float lf[16]; float run = 0.f;
#pragma unroll
        for (int i = 0; i < 16; ++i) { lf[i] = bL[(part * 16 + i) * 128 + col]; run += lf[i]; }
        tot[part * 128 + col] = run;
        __syncthreads();
        float off = 0.f, bl = 0.f;
#pragma unroll
        for (int p = 0; p < 4; ++p) { const float t = tot[p * 128 + col]; bl += t; if (p < part) off += t; }
        if (part == 0) BLg[(size_t)sidx * 128 + col] = bl;
        float bc = off;
#pragma unroll
        for (int i = 0; i < 16; ++i) { bc += lf[i]; const float kd = (1.f - __expf(lf[i])) * __expf(bl - bc); kdT[col * VS_ + part * 16 + i] = f2b(kd); }
        __syncthreads();
        bf16x8 av[2];
#pragma unroll
        for (int ks = 0; ks < 2; ++ks) av[ks] = *(const bf16x8*)(vT + (16 * w + fr) * VS_ + ks * 32 + 8 * fq);
        u16* so = Sb + (size_t)sidx * 16384 + (16 * w + fr) * 128 + 4 * fq;
#pragma unroll
        for (int nt = 0; nt < 8; ++nt) {
            f32x4 acc = (f32x4){0.f, 0.f, 0.f, 0.f};
#pragma unroll
            for (int ks = 0; ks < 2; ++ks) { const bf16x8 bk = *(const bf16x8*)(kdT + (16 * nt + fr) * VS_ + ks * 32 + 8 * fq); acc = __builtin_amdgcn_mfma_f32_16x16x32_bf16(bk, av[ks], acc, 0, 0, 0); }
            u32x2 o; o.x = pk(acc.x, acc.y); o.y = pk(acc.z, acc.w); *(u32x2*)(so + 16 * nt) = o;
        }
        __syncthreads();
    }
}
__device__ __forceinline__ void hgrn_h2(const Params& P) {
    u16* Sb = (u16*)(P.out + O_HS); const float* BLg = (const float*)(P.ws + WS_BL); float* hp = P.out + O_HP;
    for (int g = blockIdx.x * 512 + TIDX; g < 64 * 2048; g += gridDim.x * 512) {
        const int bh = g >> 11, e = (g & 2047) * 8, dv = e >> 7, dk = e & 127;
        float S[8];
#pragma unroll
        for (int j = 0; j < 8; ++j) S[j] = 0.f;
        u16* sp = Sb + (size_t)bh * 32 * 16384 + e; const float* blp = BLg + (size_t)bh * 32 * 128 + dk;
#pragma unroll 4
        for (int c = 0; c < 32; ++c) {
            const u32x4 lw = *(const u32x4*)(sp + (size_t)c * 16384); const f32x4 d0 = *(const f32x4*)(blp + c * 128), d1 = *(const f32x4*)(blp + c * 128 + 4);
            float sl[8]; unpack8(lw, sl);
            *(u32x4*)(sp + (size_t)c * 16384) = pack8(S);
            const float dd[8] = {d0.x, d0.y, d0.z, d0.w, d1.x, d1.y, d1.z, d1.w};
#pragma unroll
            for (int j = 0; j < 8; ++j) S[j] = __expf(dd[j]) * S[j] + sl[j];
        }
        float* o = hp + (size_t)bh * 16384 + dv;
#pragma unroll
        for (int j = 0; j < 8; ++j) o[(size_t)(dk + j) * 128] = S[j];
    }
}
__device__ __forceinline__ void hgrn_h3(const Params& P, unsigned char* sm, u16* dstp) {
    float* bL = (float*)(sm + L_BL); float* tot = (float*)(sm + L_TOT); float* red = (float*)(sm + L_RED);
    u16* qe = (u16*)(sm + L_QE); u16* ke = (u16*)(sm + L_KE); u16* vT = (u16*)(sm + L_VT); u16* Am = (u16*)(sm + L_AM); u16* ST = (u16*)(sm + L_ST);
    const u16* qsp = (const u16*)(P.ws + WS_R0); const u16* lfp = (const u16*)(P.ws + WS_R1); const u16* vp = (const u16*)(P.ws + WS_R2);
    u16* gsp = (u16*)(P.out + O_YP);
    const u16* Sb = (const u16*)(P.out + O_HS); const float* onorm = P.in[12];
    const int tid = TIDX, lane = tid & 63, w = tid >> 6, fr = lane & 15, fq = lane >> 4;
    Pre2 plf, pv, pq; u32x4 pS[4];
    { const int it0 = blockIdx.x; if (it0 < 2048) { const int h0 = it0 & 7, c0 = (it0 >> 3) & 31, b0 = it0 >> 8; const int r00 = b0 * SEQ + c0 * 64;
        plf = issue_rowseg(lfp, r00, h0); pv = issue_rowseg(vp, r00, h0); pq = issue_rowseg(qsp, r00, h0);
        const u16* sp = Sb + (size_t)((b0 * 8 + h0) * 32 + c0) * 16384;
#pragma unroll
        for (int p = 0; p < 4; ++p) { const int idx = tid + 512 * p, dv = idx >> 4, k8 = (idx & 15) * 8; pS[p] = *(const u32x4*)(sp + dv * 128 + k8); } } }
    for (int item = blockIdx.x; item < 2048; item += gridDim.x) {
        const int h = item & 7, c = (item >> 3) & 31, b = item >> 8; const int row0 = b * SEQ + c * 64;
        const int sidx = (b * 8 + h) * 32 + c; (void)sidx;
        commit_lf(plf, h, bL, (const float*)(P.ws + WS_LB)); commit_vT(pv, vT); commit_rows(pq, qe);
#pragma unroll
        for (int p = 0; p < 4; ++p) { const int idx = tid + 512 * p, dv = idx >> 4, k8 = (idx & 15) * 8; *(u32x4*)(ST + dv * QS_ + k8) = pS[p]; }
        __syncthreads();
        { const int nit = item + (int)gridDim.x; if (nit < 2048) { const int nh = nit & 7, nc = (nit >> 3) & 31, nb = nit >> 8; const int nrow0 = nb * SEQ + nc * 64;
            plf = issue_rowseg(lfp, nrow0, nh); pv = issue_rowseg(vp, nrow0, nh); pq = issue_rowseg(qsp, nrow0, nh);
            const u16* sp = Sb + (size_t)((nb * 8 + nh) * 32 + nc) * 16384;
#pragma unroll
            for (int p = 0; p < 4; ++p) { const int idx = tid + 512 * p, dv = idx >> 4, k8 = (idx & 15) * 8; pS[p] = *(const u32x4*)(sp + dv * 128 + k8); } } }
        const int col = tid & 127, part = tid >> 7; float lf[16]; float run = 0.f;
#pragma unroll
        for (int i = 0; i < 16; ++i) { lf[i] = bL[(part * 16 + i) * 128 + col]; run += lf[i]; }
        tot[part * 128 + col] = run;
        __syncthreads();
        float off = 0.f;
#pragma unroll
        for (int p = 0; p < 4; ++p) { const float t = tot[p * 128 + col]; if (p < part) off += t; }
        float bc = off;
#pragma unroll
        for (int i = 0; i < 16; ++i) { bc += lf[i]; const float q = silu(b2f(qe[(part * 16 + i) * QS_ + col]));
            qe[(part * 16 + i) * QS_ + col] = f2b(q * __expf(bc)); ke[(part * 16 + i) * QS_ + col] = f2b((1.f - __expf(lf[i])) * __expf(-bc)); }
        __syncthreads();
        {
            const int mt = w & 3;
            bf16x8 aq[4];
#pragma unroll
            for (int ks = 0; ks < 4; ++ks) aq[ks] = *(const bf16x8*)(qe + (16 * mt + fr) * QS_ + ks * 32 + 8 * fq);
#pragma unroll
            for (int t = 0; t < 2; ++t) { const int nt = (w >> 2) * 2 + t; f32x4 acc = (f32x4){0.f, 0.f, 0.f, 0.f};
#pragma unroll
                for (int ks = 0; ks < 4; ++ks) { const bf16x8 bk = *(const bf16x8*)(ke + (16 * nt + fr) * QS_ + ks * 32 + 8 * fq); acc = __builtin_amdgcn_mfma_f32_16x16x32_bf16(bk, aq[ks], acc, 0, 0, 0); }
                const int cr = 16 * mt + fr, s0 = 16 * nt + 4 * fq;
                u32x2 o; o.x = pk(cr >= s0 ? acc.x : 0.f, cr >= s0 + 1 ? acc.y : 0.f); o.y = pk(cr >= s0 + 2 ? acc.z : 0.f, cr >= s0 + 3 ? acc.w : 0.f);
                *(u32x2*)(Am + cr * VS_ + s0) = o; }
        }
        __syncthreads();
        {
            const int mt = w & 3, nh = w >> 2;
            bf16x8 aq[4], aa[2];
#pragma unroll
            for (int ks = 0; ks < 4; ++ks) aq[ks] = *(const bf16x8*)(qe + (16 * mt + fr) * QS_ + ks * 32 + 8 * fq);
#pragma unroll
            for (int ks = 0; ks < 2; ++ks) aa[ks] = *(const bf16x8*)(Am + (16 * mt + fr) * VS_ + ks * 32 + 8 * fq);
            f32x4 acc[4]; float ssq = 0.f;
#pragma unroll
            for (int t = 0; t < 4; ++t) { const int dt = nh * 4 + t; acc[t] = (f32x4){0.f, 0.f, 0.f, 0.f};
#pragma unroll
                for (int ks = 0; ks < 4; ++ks) { const bf16x8 bk = *(const bf16x8*)(ST + (16 * dt + fr) * QS_ + ks * 32 + 8 * fq); acc[t] = __builtin_amdgcn_mfma_f32_16x16x32_bf16(bk, aq[ks], acc[t], 0, 0, 0); }
#pragma unroll
                for (int ks = 0; ks < 2; ++ks) { const bf16x8 bk = *(const bf16x8*)(vT + (16 * dt + fr) * VS_ + ks * 32 + 8 * fq); acc[t] = __builtin_amdgcn_mfma_f32_16x16x32_bf16(bk, aa[ks], acc[t], 0, 0, 0); }
                ssq += acc[t].x * acc[t].x + acc[t].y * acc[t].y + acc[t].z * acc[t].z + acc[t].w * acc[t].w; }
            ssq += __shfl_xor(ssq, 16, 64); ssq += __shfl_xor(ssq, 32, 64);
            if (fq == 0) red[(16 * mt + fr) * 2 + nh] = ssq;
            __syncthreads();
            const int cr = 16 * mt + fr; const float rinv = rsqrtf((red[cr * 2] + red[cr * 2 + 1]) * (1.f / 128.f) + EPSV);
            u16* gp = gsp + (size_t)(row0 + cr) * DM + h * 128;
#pragma unroll
            for (int t = 0; t < 4; ++t) { const int dv = 16 * (nh * 4 + t) + 4 * fq; const u32x2 gw = *(const u32x2*)(gp + dv); const f32x4 on = *(const f32x4*)(onorm + h * 128 + dv);
                u32x2 o; o.x = pk(acc[t].x * rinv * on.x * silu(blo(gw.x)), acc[t].y * rinv * on.y * silu(bhi(gw.x))); o.y = pk(acc[t].z * rinv * on.z * silu(blo(gw.y)), acc[t].w * rinv * on.w * silu(bhi(gw.y)));
                *(u32x2*)(dstp + (size_t)(row0 + cr) * DM + h * 128 + dv) = o; }
        }
        __syncthreads();
    }
}
__device__ __forceinline__ void hgrn_sample(const Params& P, unsigned char* sm, u16* gdst) {
    float* red = (float*)sm;
    float* sq = red + 16 * 128;
    float* sf = sq + 128; float* sk = sf + 128; float* sv = sk + 128; float* so = sv + 128; float* sr = so + 128;
    const u16* qss = (const u16*)(P.ws + WS_SIDE + 1 * SSLOT); const u16* lfs = (const u16*)(P.ws + WS_SIDE + 2 * SSLOT); const u16* vs = (const u16*)(P.ws + WS_SIDE + 3 * SSLOT);
    u16* gss = (u16*)(P.ws + WS_SIDE + 4 * SSLOT);
    const float* S0 = P.in[2]; float* Sn = P.out + O_HS; const float* onorm = P.in[12];
    const int tid = TIDX;
    for (int item = blockIdx.x; item < 1024; item += gridDim.x) {
        const int b = item >> 3, h = item & 7;
        if (tid < 128) { const int c = h * 128 + tid; const float lbc = ((const float*)(P.ws + WS_LB))[c]; const float f = lbc + (1.f - lbc) * sigm(h2f(lfs[(size_t)b * DM + c]));
            sq[tid] = silu(b2f(qss[(size_t)b * DM + c])); sf[tid] = f; sk[tid] = 1.f - f; sv[tid] = b2f(vs[(size_t)b * DM + c]); }
        __syncthreads();
        const int dv4 = (tid & 31) * 4, dkg = tid >> 5;
        const f32x4 vv = *(const f32x4*)(sv + dv4); f32x4 oacc = (f32x4){0.f, 0.f, 0.f, 0.f};
        const size_t base = ((size_t)(b * 8 + h)) * 16384;
#pragma unroll
        for (int i = 0; i < 8; ++i) { const int dk = dkg * 8 + i; const f32x4 s0 = *(const f32x4*)(S0 + base + dk * 128 + dv4);
            const f32x4 sn = sf[dk] * s0 + sk[dk] * vv; *(f32x4*)(Sn + base + dk * 128 + dv4) = sn; oacc += sq[dk] * sn; }
        *(f32x4*)(red + dkg * 128 + dv4) = oacc;
        __syncthreads();
        if (tid < 128) { float o = 0.f;
#pragma unroll
            for (int g = 0; g < 16; ++g) o += red[g * 128 + tid];
            so[tid] = o; const float s2 = wave_sum(o * o); if ((tid & 63) == 0) sr[tid >> 6] = s2; }
        __syncthreads();
        if (tid < 128) { const float rinv = rsqrtf((sr[0] + sr[1]) * (1.f / 128.f) + EPSV); const int c = h * 128 + tid;
            const float g = silu(b2f(gss[(size_t)b * DM + c])); gdst[(size_t)b * DM + c] = f2b(so[tid] * rinv * onorm[c] * g); }
        __syncthreads();
    }
}
__device__ __forceinline__ void conv_phase(const Params& P) {
    const u16* xrp = (const u16*)(P.ws + WS_R0); const u16* xrs = (const u16*)(P.ws + WS_SIDE + 5 * SSLOT);
    u16* xcp = (u16*)(P.ws + WS_R2); u16* xcs = (u16*)(P.ws + WS_SIDE + 7 * SSLOT);
    const float* cw = P.in[13]; const float* cb = P.in[14]; const float* sc = P.in[4];
    float* cpo = P.out + O_CP; float* cso = P.out + O_CS;
    const int tid = TIDX, ch = (tid & 127) * 8;
    float w0[8], w1[8], w2[8], w3[8], bb[8];
#pragma unroll
    for (int j = 0; j < 8; ++j) { w0[j] = cw[ch + j]; w1[j] = cw[1024 + ch + j]; w2[j] = cw[2048 + ch + j]; w3[j] = cw[3072 + ch + j]; bb[j] = cb[ch + j]; }
    for (int rg = blockIdx.x; rg < NTOK / 4; rg += gridDim.x) {
        const int row = rg * 4 + (tid >> 7);
        float x0[8], x1[8], x2[8], x3[8];
        if (row < TP) {
            const int t = row & (SEQ - 1); const u16* p = xrp + (size_t)row * DM + ch;
            unpack8(*(const u32x4*)p, x0);
            if (t >= 1) unpack8(*(const u32x4*)(p - DM), x1); else { for (int j = 0; j < 8; ++j) x1[j] = 0.f; }
            if (t >= 2) unpack8(*(const u32x4*)(p - 2 * DM), x2); else { for (int j = 0; j < 8; ++j) x2[j] = 0.f; }
            if (t >= 3) unpack8(*(const u32x4*)(p - 3 * DM), x3); else { for (int j = 0; j < 8; ++j) x3[j] = 0.f; }
            if (t >= SEQ - 3) { float* o = cpo + ((size_t)(row >> 11) * 3 + (t - (SEQ - 3))) * DM + ch; *(f32x4*)o = (f32x4){x0[0], x0[1], x0[2], x0[3]}; *(f32x4*)(o + 4) = (f32x4){x0[4], x0[5], x0[6], x0[7]}; }
        } else {
            const int b = row - TP; unpack8(*(const u32x4*)(xrs + (size_t)b * DM + ch), x0);
            const float* s = sc + (size_t)b * 3 * DM + ch;
#pragma unroll
            for (int j = 0; j < 8; ++j) { x3[j] = s[j]; x2[j] = s[DM + j]; x1[j] = s[2 * DM + j]; }
            float* o = cso + (size_t)b * 3 * DM + ch;
#pragma unroll
            for (int j = 0; j < 8; ++j) { o[j] = x2[j]; o[DM + j] = x1[j]; o[2 * DM + j] = x0[j]; }
        }
        float y[8];
#pragma unroll
        for (int j = 0; j < 8; ++j) y[j] = bb[j] + w3[j] * x0[j] + w2[j] * x1[j] + w1[j] * x2[j] + w0[j] * x3[j];
        u16* d = row < TP ? xcp + (size_t)row * DM + ch : xcs + (size_t)(row - TP) * DM + ch;
        *(u32x4*)d = pack8(y);
    }
}
__device__ __forceinline__ void lru_pass1(const Params& P) {
    const unsigned* la = (const unsigned*)(P.ws + WS_R2); const unsigned* bt = (const unsigned*)(P.ws + WS_R0); f32x4* agg = (f32x4*)(P.ws + WS_AGG);
    const int cp = TIDX;
    for (int item = blockIdx.x; item < 256; item += gridDim.x) {
        const size_t r0 = (size_t)item * 64;
        float P0 = 1.f, P1 = 1.f, H0 = 0.f, H1 = 0.f;
#pragma unroll 8
        for (int r = 0; r < 64; ++r) { const unsigned lw = la[(r0 + r) * 512 + cp], bw = bt[(r0 + r) * 512 + cp];
            const float a0 = __expf(blo(lw)), a1 = __expf(bhi(lw)); H0 = a0 * H0 + blo(bw); H1 = a1 * H1 + bhi(bw); P0 *= a0; P1 *= a1; }
        agg[(size_t)item * 512 + cp] = (f32x4){P0, H0, P1, H1};
    }
}
__device__ __forceinline__ void lru_pass2(const Params& P, unsigned* ydst, bool dummy) {
    const unsigned* la = (const unsigned*)(P.ws + WS_R2); const unsigned* bt = (const unsigned*)(P.ws + WS_R0); unsigned* yg = (unsigned*)(P.ws + WS_R1); const f32x4* agg = (const f32x4*)(P.ws + WS_AGG);
    float* lpo = P.out + O_LP;
    const int cp = TIDX;
    for (int item = blockIdx.x; item < 256; item += gridDim.x) {
        const int b = item >> 5, c = item & 31; const size_t r0 = (size_t)item * 64;
        float h0 = 0.f, h1 = 0.f;
        for (int cc = 0; cc < c; ++cc) { const f32x4 g = agg[(size_t)(b * 32 + cc) * 512 + cp]; h0 = g.x * h0 + g.y; h1 = g.z * h1 + g.w; }
#pragma unroll 8
        for (int r = 0; r < 64; ++r) { const size_t ix = (r0 + r) * 512 + cp; const unsigned lw = la[ix], bw = bt[ix], yw = yg[ix];
            h0 = __expf(blo(lw)) * h0 + blo(bw); h1 = __expf(bhi(lw)) * h1 + bhi(bw); ydst[ix] = pk(h0 * gelu_t(blo(yw)), h1 * gelu_t(bhi(yw))); }
        if (c == 31) { lpo[b * DM + 2 * cp] = h0; lpo[b * DM + 2 * cp + 1] = h1; }
    }
    if (dummy) return;
    const unsigned* las = (const unsigned*)(P.ws + WS_SIDE + 8 * SSLOT); const unsigned* bts = (const unsigned*)(P.ws + WS_SIDE + 5 * SSLOT); unsigned* ygs = (unsigned*)(P.ws + WS_SIDE + 6 * SSLOT);
    const float* hl = P.in[3]; float* lso = P.out + O_LS;
    for (int b = blockIdx.x; b < TS; b += gridDim.x) {
        const size_t ix = (size_t)b * 512 + cp; const unsigned lw = las[ix], bw = bts[ix], yw = ygs[ix];
        const float h0 = __expf(blo(lw)) * hl[b * DM + 2 * cp] + blo(bw), h1 = __expf(bhi(lw)) * hl[b * DM + 2 * cp + 1] + bhi(bw);
        ygs[ix] = pk(h0 * gelu_t(blo(yw)), h1 * gelu_t(bhi(yw))); lso[b * DM + 2 * cp] = h0; lso[b * DM + 2 * cp + 1] = h1;
    }
}


__device__ __forceinline__ f32x4 sk_acc(const u16* Ap, const u16* Bp, int K) {
    f32x4 acc = (f32x4){0.f, 0.f, 0.f, 0.f};
#pragma unroll
    for (int k0 = 0; k0 < 128; k0 += 32) { const bf16x8 a = *(const bf16x8*)(Ap + k0), b = *(const bf16x8*)(Bp + k0); acc = __builtin_amdgcn_mfma_f32_16x16x32_bf16(b, a, acc, 0, 0, 0); }
    return acc;
}
template <int KS> __device__ __forceinline__ void sk_loadA(bf16x8 (&afr)[KS], const u16* Arow0, int lda, int w, int fr, int fq) {
    const u16* ap = Arow0 + (size_t)fr * lda + w * KS * 32 + 8 * fq;
#pragma unroll
    for (int s = 0; s < KS; ++s) afr[s] = *(const bf16x8*)(ap + s * 32);
}
#define SK3_SETUP const int tid = TIDX, lane = tid & 63, w = tid >> 6, fr = lane & 15, fq = lane >> 4;
#define SK3_ITEMS for (int it = (int)blockIdx.x; it < 256; it += (int)gridDim.x)
#define SK3_RED(v, NV) (red + (size_t)(((w) * (NV) + (v)) * 64 + lane) * 4)
#define SK3_GET(ww, v, NV) (*(const f32x4*)(red + (size_t)(((ww) * (NV) + (v)) * 64 + lane) * 4))
template <int KS, int NV, class BP>
__device__ __forceinline__ void sk_parts(const bf16x8 (&afr)[KS], const BP& Bp, float* red, int w, int fq, int lane) {
    bf16x8 b[NV][KS];
#pragma unroll
    for (int v = 0; v < NV; ++v) { const u16* bp = Bp(v);
        if (bp) {
#pragma unroll
            for (int s = 0; s < KS; ++s) b[v][s] = *(const bf16x8*)(bp + w * KS * 32 + 8 * fq + s * 32);
        } else {
#pragma unroll
            for (int s = 0; s < KS; ++s) b[v][s] = (bf16x8){0, 0, 0, 0, 0, 0, 0, 0};
        } }
#pragma unroll
    for (int v = 0; v < NV; ++v) { f32x4 acc = (f32x4){0.f, 0.f, 0.f, 0.f};
#pragma unroll
        for (int s = 0; s < KS; ++s) acc = __builtin_amdgcn_mfma_f32_16x16x32_bf16(b[v][s], afr[s], acc, 0, 0, 0);
        *(f32x4*)SK3_RED(v, NV) = acc; }
}
__device__ __forceinline__ f32x4 sk_sum(const float* red, int v, int NV, int lane) {
    f32x4 r = (f32x4){0.f, 0.f, 0.f, 0.f};
#pragma unroll
    for (int ww = 0; ww < 8; ++ww) r += *(const f32x4*)(red + (size_t)((ww * NV + v) * 64 + lane) * 4);
    return r;
}
__device__ __forceinline__ void sk_gu(const u16* hn_s, const u16* Wgu, u16* act_s, float* red) {
    SK3_SETUP
    SK3_ITEMS { const int rt = it & 7, cr = it >> 3, r = rt * 16 + fr;
        bf16x8 afr[4]; sk_loadA<4>(afr, hn_s + (size_t)(rt * 16) * DM, DM, w, fr, fq);
        for (int bt = 0; bt < 2; ++bt) {
            auto Bp = [&](int v) -> const u16* { const int sl = cr + 32 * (4 * bt + (v >> 1)); if (sl >= 176) return nullptr; const int f0 = sl * 16, br = (f0 >> 7) * 256 + (f0 & 127) + (v & 1) * 128; return Wgu + (size_t)(br + fr) * DM; };
            sk_parts<4, 8>(afr, Bp, red, w, fq, lane);
            __syncthreads();
            if (w < 4) { const int sl = cr + 32 * (4 * bt + w); if (sl < 176) { const f32x4 g = sk_sum(red, 2 * w, 8, lane), u = sk_sum(red, 2 * w + 1, 8, lane);
                *(u32x2*)(act_s + (size_t)r * DFF + sl * 16 + 4 * fq) = pk4(silu4(g) * u); } }
            __syncthreads();
        } }
}
template <int KS, bool R16>
__device__ __forceinline__ void sk_res(const u16* a_s, const u16* Bt, const void* resid, u16* out, float scale, float* red) {
    SK3_SETUP
    SK3_ITEMS { const int rt = it & 7, cr = it >> 3, r = rt * 16 + fr;
        bf16x8 afr[KS]; sk_loadA<KS>(afr, a_s + (size_t)(rt * 16) * (256 * KS), 256 * KS, w, fr, fq);
        auto Bp = [&](int v) -> const u16* { return Bt + (size_t)((cr * 2 + v) * 16 + fr) * (256 * KS); };
        sk_parts<KS, 2>(afr, Bp, red, w, fq, lane);
        __syncthreads();
        if (w < 2) { const f32x4 a = sk_sum(red, w, 2, lane); const size_t off = (size_t)r * DM + (cr * 2 + w) * 16 + 4 * fq;
            const f32x4 rv = R16 ? up4(*(const u32x2*)((const u16*)resid + off)) : *(const f32x4*)((const float*)resid + off);
            *(u32x2*)(out + off) = pk4(rv + scale * a); }
        __syncthreads(); }
}
__device__ __forceinline__ void sk_ina(const u16* hn_s, const u16* Win, u16* qs, u16* lf, u16* vv, u16* gs, const float* lbv, float* red) {
    SK3_SETUP
    SK3_ITEMS { const int rt = it & 7, cr = it >> 3, r = rt * 16 + fr;
        bf16x8 afr[4]; sk_loadA<4>(afr, hn_s + (size_t)(rt * 16) * DM, DM, w, fr, fq);
        auto Bp = [&](int v) -> const u16* { return Win + (size_t)((cr * 8 + v) * 16 + fr) * DM; };
        sk_parts<4, 8>(afr, Bp, red, w, fq, lane);
        __syncthreads();
        { const f32x4 a = sk_sum(red, w, 8, lane); const int n0 = (cr * 8 + w) * 16, seg = n0 >> 10, c = (n0 & 1023) + 4 * fq;
          if (seg == 1) { u32x2 o; o.x = pkh(a.x, a.y); o.y = pkh(a.z, a.w); *(u32x2*)(lf + (size_t)r * DM + c) = o; }
          else { u16* d = seg == 0 ? qs : (seg == 2 ? vv : gs); *(u32x2*)(d + (size_t)r * DM + c) = pk4(a); } }
        __syncthreads(); }
}
__device__ __forceinline__ void sk_inb(const u16* hn_s, const u16* Win, u16* xr, u16* yg, float* red) {
    SK3_SETUP
    SK3_ITEMS { const int rt = it & 7, cr = it >> 3, r = rt * 16 + fr;
        bf16x8 afr[4]; sk_loadA<4>(afr, hn_s + (size_t)(rt * 16) * DM, DM, w, fr, fq);
        auto Bp = [&](int v) -> const u16* { return Win + (size_t)(4096 + (cr * 4 + v) * 16 + fr) * DM; };
        sk_parts<4, 4>(afr, Bp, red, w, fq, lane);
        __syncthreads();
        if (w < 4) { const f32x4 a = sk_sum(red, w, 4, lane); const int n0 = (cr * 4 + w) * 16, seg = n0 >> 10, c = (n0 & 1023) + 4 * fq;
            *(u32x2*)((seg == 0 ? xr : yg) + (size_t)r * DM + c) = pk4(a); }
        __syncthreads(); }
}
__device__ __forceinline__ void sk_merge(const u16* hn_s, const u16* oa_s, const u16* ob_s, const u16* Win, const u16* Waup, const u16* Wbup, u16* mb_s, float* red) {
    SK3_SETUP
    SK3_ITEMS { const int rt = it & 7, cr = it >> 3, r = rt * 16 + fr;
        bf16x8 ah[4], aa[4], ab[4];
        sk_loadA<4>(ah, hn_s + (size_t)(rt * 16) * DM, DM, w, fr, fq); sk_loadA<4>(aa, oa_s + (size_t)(rt * 16) * DM, DM, w, fr, fq); sk_loadA<4>(ab, ob_s + (size_t)(rt * 16) * DM, DM, w, fr, fq);
        auto Bg = [&](int v) -> const u16* { return Win + (size_t)((v < 2 ? 6144 : 7168) + (cr * 2 + (v & 1)) * 16 + fr) * DM; };
        auto Ba = [&](int v) -> const u16* { return Waup + (size_t)((cr * 2 + v) * 16 + fr) * DM; };
        auto Bb = [&](int v) -> const u16* { return Wbup + (size_t)((cr * 2 + v) * 16 + fr) * DM; };
        sk_parts<4, 4>(ah, Bg, red, w, fq, lane);
        sk_parts<4, 2>(aa, Ba, red + 4 * 8 * 256, w, fq, lane);
        sk_parts<4, 2>(ab, Bb, red + 6 * 8 * 256, w, fq, lane);
        __syncthreads();
        if (w < 2) { const f32x4 g1 = sk_sum(red, w, 4, lane), g2 = sk_sum(red, 2 + w, 4, lane), a = sk_sum(red + 4 * 8 * 256, w, 2, lane), b = sk_sum(red + 6 * 8 * 256, w, 2, lane);
            *(u32x2*)(mb_s + (size_t)r * DM + (cr * 2 + w) * 16 + 4 * fq) = pk4(sig4(g1) * a + sig4(g2) * b); }
        __syncthreads(); }
}
#define SK_SETUP const int tid = TIDX, lane = tid & 63, w = tid >> 6, fr = lane & 15, fq = lane >> 4;
#define SK_LOOP(ni) for (int it = (int)gridDim.x - 1 - (int)blockIdx.x; it < (ni); it += (int)gridDim.x)
__device__ __forceinline__ void sk_bd(const u16* xc_s, const u16* Wbd, const float* ba, const float* bx, const float* lc, u16* la_s, u16* bt_s) {
    SK_SETUP
    SK_LOOP(64) { const int ch0 = it * 16, n = ch0 >> 7, d0 = ch0 & 127, c = ch0 + 4 * fq, r = 16 * w + fr;
        const u16* ap = xc_s + (size_t)r * DM + n * 128 + 8 * fq;
        const f32x4 pa = sk_acc(ap, Wbd + ((size_t)(n * 256 + d0 + fr) * 256 + (n & 1) * 128) + 8 * fq, 128);
        const f32x4 px = sk_acc(ap, Wbd + ((size_t)(n * 256 + 128 + d0 + fr) * 256 + (n & 1) * 128) + 8 * fq, 128);
        const f32x4 rr = sig4(pa + *(const f32x4*)(ba + c)), ig = sig4(px + *(const f32x4*)(bx + c)); const f32x4 la = rr * *(const f32x4*)(lc + c);
        const f32x4 xv = up4(*(const u32x2*)(xc_s + (size_t)r * DM + c));
        *(u32x2*)(la_s + (size_t)r * DM + c) = pk4(la); *(u32x2*)(bt_s + (size_t)r * DM + c) = pk4(sqrt4(nexpm1_4(2.f * la)) * ig * xv); }
}

#define XB_TMO      128
#define XB_XCNT(j)  (256  + 64 * (j))
#define XB_XSUB(j)  (1280 + 64 * (j))
#define XB_XGEN(j)  (2304 + 64 * (j))
#define XB_TOP      3328
#define XB_TOPGEN   3392
#define XCD_BAR_WORDS 3456
#define XB_SPIN_CAP (1u << 18)
__device__ __forceinline__ unsigned xb_ld(unsigned* p)              { return __hip_atomic_load(p, __ATOMIC_RELAXED, __HIP_MEMORY_SCOPE_AGENT); }
__device__ __forceinline__ unsigned xb_add(unsigned* p, unsigned v) { return __hip_atomic_fetch_add(p, v, __ATOMIC_RELAXED, __HIP_MEMORY_SCOPE_AGENT); }
__device__ __forceinline__ unsigned xb_xcc_id() { return (unsigned)__builtin_amdgcn_s_getreg((3 << 11) | 20) & 0xFu; }
#define XB_SPIN(cond, bar) do { unsigned _sp = 0; while (cond) { __builtin_amdgcn_s_sleep(1); \
    if ((++_sp & 255u) == 0u) { if (xb_ld(&(bar)[XB_TMO])) break; if (_sp > XB_SPIN_CAP) { atomicAdd(&(bar)[XB_TMO], 1u); break; } } } } while (0)
struct XcdBarrier { unsigned* bar; unsigned x; volatile LAS unsigned* st; };
__device__ __forceinline__ XcdBarrier xcd_barrier_post(unsigned* bar, volatile LAS unsigned* st) {
    XcdBarrier b; b.bar = bar; b.x = xb_xcc_id(); b.st = st;
    if (threadIdx.x == 0) (void)xb_add(&bar[XB_XCNT(b.x)], 1u);
    return b;
}
__device__ __forceinline__ void xcd_barrier_complete(unsigned* bar, unsigned x, unsigned& nloc, unsigned& nx) {
    const unsigned G = gridDim.x * gridDim.y * gridDim.z;
    unsigned sum, cnt, mine, sp = 0u;
    for (;;) {
        sum = 0u; cnt = 0u; mine = 0u;
#pragma unroll
        for (unsigned j = 0; j < 16; ++j) { const unsigned c = xb_ld(&bar[XB_XCNT(j)]); sum += c; cnt += (c > 0u) ? 1u : 0u; mine = (j == x) ? c : mine; }
        if (sum == G) break;
        __builtin_amdgcn_s_sleep(1);
        if ((++sp & 255u) == 0u) { if (xb_ld(&bar[XB_TMO])) break; if (sp > XB_SPIN_CAP) { atomicAdd(&bar[XB_TMO], 1u); break; } }
    }
    nloc = mine > 0u ? mine : 1u; nx = cnt > 0u ? cnt : 1u;
}
__device__ __noinline__ void xcd_barrier(const XcdBarrier b) {
    asm volatile("s_waitcnt vmcnt(0)" ::: "memory");
    __syncthreads();
    if (threadIdx.x == 0) {
        unsigned* bar = b.bar;
        __builtin_amdgcn_s_waitcnt(0);
        unsigned nloc = b.st[0], nx = b.st[1];
        if (nloc == 0u) { xcd_barrier_complete(bar, b.x, nloc, nx); b.st[0] = nloc; b.st[1] = nx; }
        const unsigned old = xb_add(&bar[XB_XSUB(b.x)], 1u);
        const unsigned gen = old / nloc;
        if (old + 1u == (gen + 1u) * nloc) {
            __builtin_amdgcn_fence(__ATOMIC_RELEASE, "agent");
            asm volatile("s_waitcnt vmcnt(0)" ::: "memory");
            const unsigned og = xb_add(&bar[XB_TOP], 1u);
            const unsigned tg = og / nx;
            if (og + 1u == (tg + 1u) * nx) xb_add(&bar[XB_TOPGEN], 1u);
            else XB_SPIN(xb_ld(&bar[XB_TOPGEN]) == tg, bar);
            __builtin_amdgcn_fence(__ATOMIC_ACQUIRE, "agent");
            xb_add(&bar[XB_XGEN(b.x)], 1u);
            asm volatile("s_waitcnt vmcnt(0)" ::: "memory");
        } else {
            XB_SPIN(xb_ld(&bar[XB_XGEN(b.x)]) == gen, bar);
            __builtin_amdgcn_fence(__ATOMIC_ACQUIRE, "agent");
            asm volatile("s_waitcnt vmcnt(0)" ::: "memory");
        }
    }
    __syncthreads();
}

#define GSYNC() xcd_barrier(xbar)
#define GSYNC_CG() do { asm volatile("s_waitcnt vmcnt(0) lgkmcnt(0)" ::: "memory"); grid.sync(); } while (0)
#ifndef PROBE
#define PROBE 0
#endif
#ifndef STOP_AT
#define STOP_AT 99
#endif
__device__ __forceinline__ void dumpcp(const unsigned char* src, unsigned char* dst, size_t bytes) {
    for (size_t i = ((size_t)blockIdx.x * 512 + threadIdx.x) * 16; i < bytes; i += (size_t)gridDim.x * 512 * 16) *(u32x4*)(dst + i) = *(const u32x4*)(src + i);
}
#define STOPCHK(n) do { if (STOP_AT == (n)) { if ((n) == 4) { dumpcp(P.ws + WS_R0, (unsigned char*)(P.out + O_HS), 2 * SLOT); dumpcp(P.ws + WS_R2, (unsigned char*)P.out + SLOT, SLOT); }  if ((n) == 2 || (n) == 14) { DEF_PTRS final_norm(X1, P.in[27], P.out + O_YP, P.out + O_YS); } return; } } while (0)
#define DEF_PTRS \
    unsigned char* ws = opq(P.ws); unsigned char* ob = opq((unsigned char*)P.out); (void)ob; \
    u16* Wgu = (u16*)(ws + WS_WGU); u16* Wd = (u16*)(ws + WS_WD); u16* Win = (u16*)(ws + WS_WIN); u16* Wbd = (u16*)(ws + WS_WBD); \
    u16* Waup = (u16*)(ws + WS_WAUP); u16* Wbup = (u16*)(ws + WS_WBUP); u16* Wout = (u16*)(ws + WS_WOUT); \
    u16* X1 = (u16*)(ws + WS_X1); float* LBv = (float*)(ws + WS_LB); float* LCv = (float*)(ws + WS_LC); \
    const B16 HN = {(u16*)(ws + WS_HN), (u16*)(ws + WS_SIDE + 0 * SSLOT)}; \
    const B16 QS = {(u16*)(ws + WS_R0), (u16*)(ws + WS_SIDE + 1 * SSLOT)}; \
    const B16 LF = {(u16*)(ws + WS_R1), (u16*)(ws + WS_SIDE + 2 * SSLOT)}; \
    const B16 VV = {(u16*)(ws + WS_R2), (u16*)(ws + WS_SIDE + 3 * SSLOT)}; \
    const B16 GS = {(u16*)(ob + O_YP * 4), (u16*)(ws + WS_SIDE + 4 * SSLOT)}; \
    const B16 XR = {(u16*)(ws + WS_R0), (u16*)(ws + WS_SIDE + 5 * SSLOT)}; \
    const B16 YG = {(u16*)(ws + WS_R1), (u16*)(ws + WS_SIDE + 6 * SSLOT)}; \
    const B16 XC = {(u16*)(ws + WS_R2), (u16*)(ws + WS_SIDE + 7 * SSLOT)}; \
    const B16 TA = {(u16*)(ws + WS_R0), (u16*)(ws + WS_SIDE + 8 * SSLOT)}; \
    const B16 GT = {(u16*)(ws + WS_R2), (u16*)(ws + WS_SIDE + 9 * SSLOT)}; \
    const B16 MB = {(u16*)(ob + O_YP * 4) + (size_t)TP * DM, (u16*)(ws + WS_SIDE + 10 * SSLOT)}; \
    const B16 ACT = {(u16*)(ws + WS_R0), (u16*)(ws + WS_ACTS)}; \
    (void)Wgu; (void)Wd; (void)Win; (void)Wbd; (void)Waup; (void)Wbup; (void)Wout; (void)X1; (void)LBv; (void)LCv; \
    (void)HN; (void)QS; (void)LF; (void)VV; (void)GS; (void)XR; (void)YG; (void)XC; (void)TA; (void)GT; (void)MB; (void)ACT;

__global__ void __launch_bounds__(512, 2) mega(const float* i0, const float* i1, const float* i2, const float* i3, const float* i4, const float* i5, const float* i6, const float* i7, const float* i8, const float* i9, const float* i10, const float* i11, const float* i12, const float* i13, const float* i14, const float* i15, const float* i16, const float* i17, const float* i18, const float* i19, const float* i20, const float* i21, const float* i22, const float* i23, const float* i24, const float* i25, const float* i26, const float* i27, float* outp, unsigned char* wsp) {
    Params P;
    P.in[0] = i0; P.in[1] = i1; P.in[2] = i2; P.in[3] = i3; P.in[4] = i4; P.in[5] = i5; P.in[6] = i6; P.in[7] = i7; P.in[8] = i8; P.in[9] = i9; P.in[10] = i10; P.in[11] = i11; P.in[12] = i12; P.in[13] = i13; P.in[14] = i14; P.in[15] = i15; P.in[16] = i16; P.in[17] = i17; P.in[18] = i18; P.in[19] = i19; P.in[20] = i20; P.in[21] = i21; P.in[22] = i22; P.in[23] = i23; P.in[24] = i24; P.in[25] = i25; P.in[26] = i26; P.in[27] = i27;
    P.out = outp; P.ws = wsp;
    extern __shared__ __attribute__((aligned(16))) unsigned char shm[];
    cg::grid_group grid = cg::this_grid();
    LAS unsigned char* lds = (LAS unsigned char*)shm;
    const int G = gridDim.x, cblk = blockIdx.x;
    volatile LAS unsigned* xst = (volatile LAS unsigned*)(lds + (LDS_BYTES - 16));
    if (threadIdx.x == 0) { xst[0] = 0u; xst[1] = 0u; xst[2] = 0u; xst[3] = 0u; }
    __syncthreads();
    const XcdBarrier xbar = xcd_barrier_post((unsigned*)(P.ws + WS_BAR), xst);

    {
        DEF_PTRS
        float* tile = (float*)shm;
#pragma unroll 1
        for (int t = cblk; t < 4928; t += G) {
            const float* src; u16* dst; int K, N, mode, tt;
            if (t < 704) { src = P.in[6]; dst = Wgu; K = 1024; N = 2816; mode = 1; tt = t; }
            else if (t < 1408) { src = P.in[7]; dst = Wgu; K = 1024; N = 2816; mode = 2; tt = t - 704; }
            else if (t < 2112) { src = P.in[8]; dst = Wd; K = 2816; N = 1024; mode = 0; tt = t - 1408; }
            else if (t < 4160) { src = P.in[10]; dst = Win; K = 1024; N = 8192; mode = 0; tt = t - 2112; }
            else if (t < 4416) { src = P.in[20]; dst = Waup; K = 1024; N = 1024; mode = 0; tt = t - 4160; }
            else if (t < 4672) { src = P.in[21]; dst = Wbup; K = 1024; N = 1024; mode = 0; tt = t - 4416; }
            else { src = P.in[22]; dst = Wout; K = 1024; N = 1024; mode = 0; tt = t - 4672; }
            conv_matrix(src, K, N, dst, mode, tt, tile);
        }
        for (int idx = cblk * 512 + TIDX; idx < 8 * 256 * 256; idx += G * 512) {
            const int n = idx >> 16, row = (idx >> 8) & 255, kk = idx & 255, bj = row >> 7, d = row & 127;
            float v = 0.f; if ((kk >> 7) == (n & 1)) v = (bj ? P.in[17] : P.in[15])[(size_t)n * 16384 + (kk & 127) * 128 + d];
            Wbd[idx] = f2b(v);
        }
        if (PROBE == 12 || PROBE == 13) { unsigned char* dst = (PROBE == 12) ? (ws + WS_R2) : ((unsigned char*)P.out + SLOT);
            for (int rep = 0; rep < 4; ++rep) for (size_t i = ((size_t)cblk * 512 + TIDX) * 16; i < SLOT; i += (size_t)G * 512 * 16) *(u32x4*)(dst + i) = (u32x4){(unsigned)rep, 0u, 0u, 0u}; }
        if (cblk == 0) { for (int c = TIDX; c < 1024; c += 512) { LBv[c] = 1.f / (1.f + __expf(P.in[11][1024 + c] - P.in[11][c])); LCv[c] = -8.f * log1pf(__expf(-P.in[19][c])); } }
        norm_rows<false>(P.in[0], P.in[1], P.in[5], HN);
    }
    GSYNC_CG(); STOPCHK(0);
    { DEF_PTRS SchedSimple S{HN.p, HN.s, Wgu, DM, DM, 22, G, cblk, 0}; EpiGU E{ACT}; gemm_phase(lds, DM, DM, S, E); if (PROBE == 1) gemm_phase(lds, DM, DM, S, E); sk_gu(HN.s, Wgu, ACT.s, (float*)shm); if (PROBE == 9) sk_gu(HN.s, Wgu, ACT.s, (float*)shm); }
    GSYNC(); STOPCHK(1);
    { DEF_PTRS SchedSimple S{ACT.p, ACT.s, Wd, DFF, DFF, 4, G, cblk, 0}; EpiResT<false> E{P.in[0], X1, 0.5f}; gemm_phase(lds, DFF, DFF, S, E); sk_res<11, false>(ACT.s, Wd, P.in[1], X1 + (size_t)TP * DM, 0.5f, (float*)shm); }
    GSYNC(); STOPCHK(2);
    {
        DEF_PTRS
        float* tile = (float*)shm;
#pragma unroll 1
        for (int t = cblk; t < 2112; t += G) {
            const float* src; u16* dst; int K, N, mode, tt;
            if (t < 704) { src = P.in[24]; dst = Wgu; K = 1024; N = 2816; mode = 1; tt = t; }
            else if (t < 1408) { src = P.in[25]; dst = Wgu; K = 1024; N = 2816; mode = 2; tt = t - 704; }
            else { src = P.in[26]; dst = Wd; K = 2816; N = 1024; mode = 0; tt = t - 1408; }
            conv_matrix(src, K, N, dst, mode, tt, tile);
        }
        norm_rows<true>(X1, X1 + (size_t)TP * DM, P.in[9], HN);
    }
    GSYNC(); STOPCHK(3);
    { DEF_PTRS SchedSimple S{HN.p, HN.s, Win, DM, DM, 16, G, cblk, 0}; EpiInA E{QS, LF, VV, GS, LBv}; gemm_phase(lds, DM, DM, S, E); if (PROBE == 11) gemm_phase(lds, DM, DM, S, E); sk_ina(HN.s, Win, QS.s, LF.s, VV.s, GS.s, LBv, (float*)shm); if (PROBE == 9) sk_ina(HN.s, Win, QS.s, LF.s, VV.s, GS.s, LBv, (float*)shm); }
    GSYNC(); STOPCHK(4);
    hgrn_h1(P, shm); if (PROBE == 3) hgrn_h1(P, shm);
    GSYNC(); STOPCHK(5);
    hgrn_h2(P);
    if (PROBE == 21) { GSYNC(); GSYNC(); GSYNC(); GSYNC(); }
    if (PROBE == 8) { GSYNC(); hgrn_h1(P, shm); GSYNC(); hgrn_h2(P); }
    GSYNC(); STOPCHK(6);
    if (PROBE == 18) hgrn_h3(P, shm, (u16*)(P.out + O_YP) + (size_t)TP * DM);
    hgrn_h3(P, shm, (u16*)(P.out + O_YP));
    GSYNC(); STOPCHK(7);
    { DEF_PTRS SchedSimple S{HN.p, HN.s, Win + (size_t)4096 * DM, DM, DM, 8, G, cblk, 0}; EpiInB E{XR, YG}; gemm_phase(lds, DM, DM, S, E); if (PROBE == 14) gemm_phase(lds, DM, DM, S, E); if (PROBE == 27 || PROBE == 28 || PROBE == 29) { SchedLim SL{HN.p, HN.s, Win + (size_t)4096 * DM, DM, DM, 8, G, cblk, PROBE == 27 ? 1 : (PROBE == 28 ? 2 : 4)}; EpiNull EN{(float*)(ws + WS_AGG)}; gemm_phase(lds, DM, DM, SL, EN); }
        if (PROBE == 25 || PROBE == 26) { SchedLim SL{HN.p, HN.s, Win + (size_t)4096 * DM, DM, DM, 8, G, cblk, PROBE == 25 ? 1 : 2}; EpiInBP EP{(u16*)(P.out + O_HS), 1024}; gemm_phase(lds, DM, DM, SL, EP); } if (PROBE == 23) { EpiInBP EP{(u16*)(P.out + O_HS), 1088}; gemm_phase(lds, DM, DM, S, EP); } if (PROBE == 24) { EpiInBP EP{(u16*)(P.out + O_HS), 1024}; gemm_phase(lds, DM, DM, S, EP); } if (PROBE == 15) { EpiNull EN{(float*)(ws + WS_AGG)}; gemm_phase(lds, DM, DM, S, EN); } { const int nrep = (PROBE == 30) ? 9 : 1;
#pragma unroll 1
          for (int rep = 0; rep < nrep; ++rep) sk_inb(HN.s, Win, XR.s, YG.s, (float*)shm); } if (PROBE == 9) sk_inb(HN.s, Win, XR.s, YG.s, (float*)shm); }
    GSYNC(); STOPCHK(8);
    conv_phase(P); if (PROBE == 4) conv_phase(P); if (PROBE == 20) hgrn_sample(P, shm, (u16*)(P.ws + WS_SIDE + 10 * SSLOT)); hgrn_sample(P, shm, (u16*)(P.ws + WS_SIDE + 4 * SSLOT));
    GSYNC(); STOPCHK(9);
    { DEF_PTRS SchedSimple S{XC.p, XC.s, Wbd, DM, 256, 8, G, cblk, 256}; EpiBD E{XC, XR, P.in[16], P.in[18], LCv}; gemm_phase(lds, 256, DM, S, E); sk_bd(XC.s, Wbd, P.in[16], P.in[18], LCv, TA.s, XR.s); }
    GSYNC(); STOPCHK(10);
    lru_pass1(P); if (PROBE == 5) lru_pass1(P);
    GSYNC(); STOPCHK(11);
    if (PROBE == 19) lru_pass2(P, (unsigned*)((u16*)(P.out + O_YP) + (size_t)TP * DM), true);
    lru_pass2(P, (unsigned*)(P.ws + WS_R1), false);
    GSYNC(); STOPCHK(12);
    { DEF_PTRS SchedMerge S{HN, GS, YG, Win, Waup, Wbup, G, cblk}; EpiMerge E{GT, TA, MB}; gemm_phase(lds, DM, DM, S, E); if (PROBE == 10) gemm_phase(lds, DM, DM, S, E); sk_merge(HN.s, GS.s, YG.s, Win, Waup, Wbup, MB.s, (float*)shm); if (PROBE == 9) sk_merge(HN.s, GS.s, YG.s, Win, Waup, Wbup, MB.s, (float*)shm); }
    GSYNC(); STOPCHK(13);
    { DEF_PTRS SchedSimple S{MB.p, MB.s, Wout, DM, DM, 4, G, cblk, 0}; EpiResT<true> E{X1, X1, 1.0f}; gemm_phase(lds, DM, DM, S, E); sk_res<4, true>(MB.s, Wout, X1 + (size_t)TP * DM, X1 + (size_t)TP * DM, 1.0f, (float*)shm); }
    GSYNC(); STOPCHK(14);
    { DEF_PTRS norm_rows<true>(X1, X1 + (size_t)TP * DM, P.in[23], HN); }
    GSYNC(); STOPCHK(15);
    { DEF_PTRS SchedSimple S{HN.p, HN.s, Wgu, DM, DM, 22, G, cblk, 0}; EpiGU E{ACT}; gemm_phase(lds, DM, DM, S, E); sk_gu(HN.s, Wgu, ACT.s, (float*)shm); if (PROBE == 9) sk_gu(HN.s, Wgu, ACT.s, (float*)shm); }
    GSYNC(); STOPCHK(16);
    { DEF_PTRS SchedSimple S{ACT.p, ACT.s, Wd, DFF, DFF, 4, G, cblk, 0}; EpiResT<true> E{X1, X1, 0.5f}; gemm_phase(lds, DFF, DFF, S, E); sk_res<11, true>(ACT.s, Wd, X1 + (size_t)TP * DM, X1 + (size_t)TP * DM, 0.5f, (float*)shm); }
    GSYNC(); STOPCHK(17);
    { DEF_PTRS final_norm(X1, P.in[27], P.out + O_YP, P.out + O_YS); }
}

extern "C" void kernel_launch(void* const* d_in, const int* in_sizes, int n_in, void* d_out, int out_size, void* d_ws, size_t ws_size, hipStream_t stream) {
    static int grid = 0;
    if (grid == 0) {
        int dev = 0, cus = 0, per_cu = 0;
        if (n_in != 28 || ws_size < WS_END) { fprintf(stderr, "kernel_launch: unexpected n_in %d / ws_size %zu (need %zu)\n", n_in, ws_size, (size_t)WS_END); grid = -1; return; }
        (void)hipGetDevice(&dev); (void)hipDeviceGetAttribute(&cus, hipDeviceAttributeMultiprocessorCount, dev);
        if (hipFuncSetAttribute((const void*)mega, hipFuncAttributeMaxDynamicSharedMemorySize, LDS_BYTES) != hipSuccess) { fprintf(stderr, "kernel_launch: hipFuncSetAttribute failed\n"); grid = -1; return; }
        if (hipOccupancyMaxActiveBlocksPerMultiprocessor(&per_cu, (const void*)mega, 512, LDS_BYTES) != hipSuccess || per_cu < 1) { fprintf(stderr, "kernel_launch: occupancy query gave %d\n", per_cu); per_cu = 1; (void)hipGetLastError(); }
        grid = cus * 1;
    }
    if (grid < 0) return;
    const float* ins[28]; for (int i = 0; i < 28; ++i) ins[i] = (const float*)d_in[i];
    float* outp = (float*)d_out; unsigned char* wsp = (unsigned char*)d_ws;
    if (hipMemsetAsync((char*)d_ws + WS_BAR, 0, 16384, stream) != hipSuccess) { fprintf(stderr, "kernel_launch: memset failed\n"); return; }
    void* args[30]; for (int i = 0; i < 28; ++i) args[i] = (void*)&ins[i];
    args[28] = (void*)&outp; args[29] = (void*)&wsp;
    hipError_t e = hipLaunchCooperativeKernel((void*)mega, dim3(grid), dim3(512), args, LDS_BYTES, stream);
    if (e != hipSuccess) fprintf(stderr, "cooperative launch failed: %s (grid %d)\n", hipGetErrorString(e), grid);
}
```
